# Optimizing an MI355X kernel written in HIP

```python
import math
import jax, jax.numpy as jnp
from jax import lax
import numpy as np

D_MODEL = 2048
BATCH = 2
SEQ = 8192
DEPTH = 2

N_EVEN = (DEPTH + 1) // 2
N_ODD = DEPTH // 2
EPS = 1e-6

CONV_WIDTH = D_MODEL // 2
CONV_K = 3
HG_HEAD_DIM = 128
HG_HEADS = (D_MODEL // 2) // HG_HEAD_DIM
HG_WIDTH = HG_HEADS * HG_HEAD_DIM
HG_CHUNK = 64
IN_EVEN = 3 * CONV_WIDTH + 4 * HG_WIDTH
MIX_EVEN = CONV_WIDTH + HG_WIDTH
S5_WIDTH = D_MODEL
S5_GROUP = 16
S5_GROUPS = S5_WIDTH // S5_GROUP
S5_STATE = 64
S5_CHUNK_MAX = 1024
DT_MIN = 1e-3
DT_MAX = 1e-1
MOE_GROUPS = 4
MOE_EXPERTS_PER_GROUP = 8
MOE_EXPERTS = MOE_GROUPS * MOE_EXPERTS_PER_GROUP
MOE_TOPK = 2
MOE_FF = D_MODEL // 2
MOE_ROWS = 256

kernel_name = "hybrid_conv_hgrn2_s5_hmoe"


def rmsnorm(x, g):
    xf = x.astype(jnp.float32)
    y = xf * lax.rsqrt(jnp.mean(xf * xf, axis=-1, keepdims=True) + EPS)
    return (y * g.astype(jnp.float32)).astype(x.dtype)


def short_conv(u, w):
    c = u.shape[-1]
    return lax.conv_general_dilated(
        u, w.astype(u.dtype)[:, None, :], window_strides=(1,),
        padding=[(CONV_K - 1, 0)], dimension_numbers=('NWC', 'WIO', 'NWC'),
        feature_group_count=c)


def hgrn2_mix(q, f_logit, v, g, lb, norm_g):
    bsz, s, _ = q.shape
    n = s // HG_CHUNK
    f32 = jnp.float32
    f = lb + (1.0 - lb) * jax.nn.sigmoid(f_logit.astype(f32))
    log_f = jnp.log(f)
    k = 1.0 - f

    def to_chunks(t):
        return t.astype(f32).reshape(bsz, n, HG_CHUNK, HG_HEADS, HG_HEAD_DIM).transpose(1, 0, 3, 2, 4)

    qc, kc, vc, lc = to_chunks(q), to_chunks(k), to_chunks(v), to_chunks(log_f)
    causal = jnp.tril(jnp.ones((HG_CHUNK, HG_CHUNK), dtype=bool))
    mid = HG_CHUNK // 2

    def step(state, inp):
        qb, kb, vb, lgb = inp
        b = jnp.cumsum(lgb, axis=2)
        ref = b[:, :, mid - 1:mid]
        b_last = b[:, :, -1:]
        o_inter = jnp.einsum('bhck,bhkv->bhcv', qb * jnp.exp(b), state)
        scores = jnp.einsum('bhck,bhsk->bhcs', qb * jnp.exp(b - ref), kb * jnp.exp(ref - b))
        scores = jnp.where(causal, scores, 0.0)
        o_intra = jnp.einsum('bhcs,bhsv->bhcv', scores, vb)
        new_state = (jnp.exp(b_last[:, :, 0])[..., None] * state
                     + jnp.einsum('bhsk,bhsv->bhkv', kb * jnp.exp(b_last - b), vb))
        return new_state, o_inter + o_intra

    s0 = jnp.zeros((bsz, HG_HEADS, HG_HEAD_DIM, HG_HEAD_DIM), f32)
    _, o = lax.scan(step, s0, (qc, kc, vc, lc))
    o = o.transpose(1, 0, 3, 2, 4).reshape(bsz, s, HG_HEADS, HG_HEAD_DIM)
    o = o * lax.rsqrt(jnp.mean(o * o, axis=-1, keepdims=True) + EPS) * norm_g.astype(f32)
    o = o.reshape(bsz, s, HG_WIDTH) * jax.nn.silu(g.astype(f32))
    return o.astype(q.dtype)


def _complex_affine_combine(e1, e2):
    a1r, a1i, b1r, b1i = e1
    a2r, a2i, b2r, b2i = e2
    return (a2r * a1r - a2i * a1i,
            a2r * a1i + a2i * a1r,
            a2r * b1r - a2i * b1i + b2r,
            a2r * b1i + a2i * b1r + b2i)


def s5_mix(u, lam_re, lam_im, log_dt, b_re, b_im, c_re, c_im, d_skip):
    bsz, s, _ = u.shape
    f32 = jnp.float32
    L = math.gcd(s, S5_CHUNK_MAX)
    n = s // L
    dt = jnp.exp(log_dt.astype(f32))[:, None]
    lr = lam_re.astype(f32)
    li = lam_im.astype(f32)
    mag = jnp.exp(lr * dt)
    ar = mag * jnp.cos(li * dt)
    ai = mag * jnp.sin(li * dt)
    den = lr * lr + li * li
    cr = ((ar - 1.0) * lr + ai * li) / den
    ci = (ai * lr - (ar - 1.0) * li) / den
    bb_re = cr[..., None] * b_re.astype(f32) - ci[..., None] * b_im.astype(f32)
    bb_im = cr[..., None] * b_im.astype(f32) + ci[..., None] * b_re.astype(f32)
    cre = c_re.astype(f32)
    cim = c_im.astype(f32)
    a_r = jnp.broadcast_to(ar, (bsz, L, S5_GROUPS, S5_STATE))
    a_i = jnp.broadcast_to(ai, (bsz, L, S5_GROUPS, S5_STATE))
    uc = u.astype(f32).reshape(bsz, n, L, S5_GROUPS, S5_GROUP).transpose(1, 0, 2, 3, 4)

    def step(carry, ub):
        hr0, hi0 = carry
        xr = jnp.einsum('blgc,gpc->blgp', ub, bb_re)
        xi = jnp.einsum('blgc,gpc->blgp', ub, bb_im)
        pr, pi, hr, hi = lax.associative_scan(_complex_affine_combine, (a_r, a_i, xr, xi), axis=1)
        hr = hr + pr * hr0[:, None] - pi * hi0[:, None]
        hi = hi + pr * hi0[:, None] + pi * hr0[:, None]
        y = jnp.einsum('blgp,gcp->blgc', hr, cre) - jnp.einsum('blgp,gcp->blgc', hi, cim)
        return (hr[:, -1], hi[:, -1]), y

    h0 = jnp.zeros((bsz, S5_GROUPS, S5_STATE), f32)
    _, y = lax.scan(step, (h0, h0), uc)
    y = y.transpose(1, 0, 2, 3, 4).reshape(bsz, s, S5_WIDTH)
    y = y + d_skip.astype(f32) * u.astype(f32)
    return y.astype(u.dtype)


def hier_moe(h, w_coarse, b_coarse, w_fine, b_fine, w_gate, w_up, w_down):
    bsz, s, d = h.shape
    x = h.reshape(-1, d)
    t = x.shape[0]
    f32 = jnp.float32
    p_coarse = jax.nn.softmax((x @ w_coarse + b_coarse).astype(f32), axis=-1)
    p_top, grp = lax.top_k(p_coarse, 1)
    fine = (x @ w_fine + b_fine).astype(f32).reshape(t, MOE_GROUPS, MOE_EXPERTS_PER_GROUP)
    fine_sel = fine[jnp.arange(t), grp[:, 0]]
    top_val, top_idx = lax.top_k(fine_sel, MOE_TOPK)
    gates = p_top * jax.nn.softmax(top_val, axis=-1)
    experts = grp * MOE_EXPERTS_PER_GROUP + top_idx
    n_assign = t * MOE_TOPK
    e_flat = experts.reshape(-1)
    tok = jnp.repeat(jnp.arange(t, dtype=jnp.int32), MOE_TOPK)
    w_flat = gates.reshape(-1)
    order = jnp.argsort(e_flat)
    e_s = e_flat[order]
    tok_s = tok[order]
    w_s = w_flat[order]
    counts = jnp.bincount(e_flat, length=MOE_EXPERTS)
    starts = jnp.cumsum(counts) - counts
    padded = (counts + MOE_ROWS - 1) // MOE_ROWS * MOE_ROWS
    pend = jnp.cumsum(padded)
    pstart = pend - padded
    dest = pstart[e_s] + jnp.arange(n_assign) - starts[e_s]
    n_groups = -(-n_assign // MOE_ROWS) + MOE_EXPERTS
    total = n_groups * MOE_ROWS
    buf_tok = jnp.full((total,), t, dtype=jnp.int32).at[dest].set(tok_s)
    buf_w = jnp.zeros((total,), f32).at[dest].set(w_s)
    grp_expert = jnp.minimum(
        jnp.searchsorted(pend, jnp.arange(n_groups) * MOE_ROWS, side='right'), MOE_EXPERTS - 1)
    x_pad = jnp.concatenate([x, jnp.zeros((1, d), x.dtype)], axis=0)
    xb = x_pad[buf_tok].reshape(n_groups, MOE_ROWS, d)

    def expert_rows(args):
        xm, e = args
        hid = jax.nn.silu(xm @ w_gate[e]) * (xm @ w_up[e])
        return hid @ w_down[e]

    yb = lax.map(expert_rows, (xb, grp_expert)).reshape(total, d)
    y = jnp.zeros((t + 1, d), f32).at[buf_tok].add(yb.astype(f32) * buf_w[:, None])[:t]
    return y.astype(h.dtype).reshape(bsz, s, d)


def setup_inputs(seed: int = 0) -> dict:
    key = jax.random.key(seed)
    ks = jax.random.split(key, 26)
    nrm = jax.random.normal
    f32 = jnp.float32
    D = D_MODEL
    x = nrm(ks[0], (BATCH, SEQ, D), f32)
    g_mix = 1.0 + 0.01 * nrm(ks[1], (DEPTH, D), f32)
    g_ffn = 1.0 + 0.01 * nrm(ks[2], (DEPTH, D), f32)
    g_final = 1.0 + 0.01 * nrm(ks[3], (D,), f32)
    w_in_even = nrm(ks[4], (N_EVEN, D, IN_EVEN), f32) * D ** -0.5
    conv_w = nrm(ks[5], (N_EVEN, CONV_K, CONV_WIDTH), f32) * CONV_K ** -0.5
    hg_lower_bound = 0.1 * nrm(ks[6], (N_EVEN + 1, HG_WIDTH), f32)
    hg_norm_g = 1.0 + 0.01 * nrm(ks[7], (N_EVEN, HG_HEAD_DIM), f32)
    w_out_even = nrm(ks[8], (N_EVEN, MIX_EVEN, D), f32) * MIX_EVEN ** -0.5
    s5_lambda_re = -0.5 + 0.01 * nrm(ks[9], (N_ODD, S5_GROUPS, S5_STATE), f32)
    s5_lambda_im = (jnp.pi * jnp.arange(S5_STATE, dtype=f32)
                    + 0.01 * nrm(ks[10], (N_ODD, S5_GROUPS, S5_STATE), f32))
    s5_log_dt = jax.random.uniform(ks[11], (N_ODD, S5_GROUPS), f32,
                                   minval=math.log(DT_MIN), maxval=math.log(DT_MAX))
    s5_b_re = nrm(ks[12], (N_ODD, S5_GROUPS, S5_STATE, S5_GROUP), f32) * (2 * S5_GROUP) ** -0.5
    s5_b_im = nrm(ks[13], (N_ODD, S5_GROUPS, S5_STATE, S5_GROUP), f32) * (2 * S5_GROUP) ** -0.5
    s5_c_re = nrm(ks[14], (N_ODD, S5_GROUPS, S5_GROUP, S5_STATE), f32) * S5_STATE ** -0.5
    s5_c_im = nrm(ks[15], (N_ODD, S5_GROUPS, S5_GROUP, S5_STATE), f32) * S5_STATE ** -0.5
    s5_d = nrm(ks[16], (N_ODD, S5_WIDTH), f32)
    w_glu = nrm(ks[17], (N_ODD, S5_WIDTH, 2 * D), f32) * S5_WIDTH ** -0.5
    moe_w_coarse = nrm(ks[18], (DEPTH, D, MOE_GROUPS), f32) * D ** -0.5
    moe_b_coarse = 0.01 * nrm(ks[19], (DEPTH, MOE_GROUPS), f32)
    moe_w_fine = nrm(ks[20], (DEPTH, D, MOE_EXPERTS), f32) * D ** -0.5
    moe_b_fine = 0.01 * nrm(ks[21], (DEPTH, MOE_EXPERTS), f32)
    moe_w_gate = nrm(ks[22], (DEPTH, MOE_EXPERTS, D, MOE_FF), f32) * D ** -0.5
    moe_w_up = nrm(ks[23], (DEPTH, MOE_EXPERTS, D, MOE_FF), f32) * D ** -0.5
    moe_w_down = nrm(ks[24], (DEPTH, MOE_EXPERTS, MOE_FF, D), f32) * MOE_FF ** -0.5
    return {"x": x, "g_mix": g_mix, "g_ffn": g_ffn, "g_final": g_final,
            "w_in_even": w_in_even, "conv_w": conv_w, "hg_lower_bound": hg_lower_bound,
            "hg_norm_g": hg_norm_g, "w_out_even": w_out_even,
            "s5_lambda_re": s5_lambda_re, "s5_lambda_im": s5_lambda_im, "s5_log_dt": s5_log_dt,
            "s5_b_re": s5_b_re, "s5_b_im": s5_b_im, "s5_c_re": s5_c_re, "s5_c_im": s5_c_im,
            "s5_d": s5_d, "w_glu": w_glu,
            "moe_w_coarse": moe_w_coarse, "moe_b_coarse": moe_b_coarse,
            "moe_w_fine": moe_w_fine, "moe_b_fine": moe_b_fine,
            "moe_w_gate": moe_w_gate, "moe_w_up": moe_w_up, "moe_w_down": moe_w_down}


def reference(x, g_mix, g_ffn, g_final, w_in_even, conv_w, hg_lower_bound, hg_norm_g,
              w_out_even, s5_lambda_re, s5_lambda_im, s5_log_dt, s5_b_re, s5_b_im,
              s5_c_re, s5_c_im, s5_d, w_glu, moe_w_coarse, moe_b_coarse, moe_w_fine,
              moe_b_fine, moe_w_gate, moe_w_up, moe_w_down):
    lb_all = jnp.cumsum(jax.nn.softmax(hg_lower_bound.astype(jnp.float32), axis=0), axis=0)
    for layer in range(DEPTH):
        j = layer // 2
        h = rmsnorm(x, g_mix[layer])
        if layer % 2 == 0:
            z = h @ w_in_even[j]
            a_b, a_c, a_h, q, f_logit, v, g = jnp.split(z, 7, axis=-1)
            y_a = a_b * short_conv(a_c * a_h, conv_w[j])
            y_b = hgrn2_mix(q, f_logit, v, g, lb_all[j], hg_norm_g[j])
            mix = jnp.concatenate([y_a, y_b], axis=-1) @ w_out_even[j]
        else:
            y = s5_mix(h, s5_lambda_re[j], s5_lambda_im[j], s5_log_dt[j], s5_b_re[j],
                       s5_b_im[j], s5_c_re[j], s5_c_im[j], s5_d[j])
            zg = jax.nn.gelu(y) @ w_glu[j]
            mix = zg[..., :D_MODEL] * jax.nn.sigmoid(zg[..., D_MODEL:])
        x = x + mix
        x = x + hier_moe(rmsnorm(x, g_ffn[layer]), moe_w_coarse[layer], moe_b_coarse[layer],
                         moe_w_fine[layer], moe_b_fine[layer], moe_w_gate[layer],
                         moe_w_up[layer], moe_w_down[layer])
    return rmsnorm(x, g_final)
```

```cpp
#include <hip/hip_runtime.h>
#include <cstdio>
#include <cstdint>

#ifndef N_LAUNCH_MODE
#define N_LAUNCH_MODE 1
#endif
#ifndef NAIVE_GEMM
#define NAIVE_GEMM 0
#endif

#ifndef S5_MFMA
#define S5_MFMA 1
#endif
#ifndef HG_MFMA
#define HG_MFMA 1
#endif
#ifndef S5_MERGE
#define S5_MERGE 1
#endif
#ifndef SKIP_X2
#define SKIP_X2 1
#endif
#ifndef PROBE_DUP
#define PROBE_DUP 0
#endif
#define LAS __attribute__((address_space(3)))
typedef unsigned short bf16;
typedef short bf16x8 __attribute__((ext_vector_type(8)));
typedef float f32x4 __attribute__((ext_vector_type(4)));
typedef float f32x2 __attribute__((ext_vector_type(2)));
typedef float f32x16 __attribute__((ext_vector_type(16)));
typedef unsigned u32x4 __attribute__((ext_vector_type(4)));
typedef unsigned u32x2 __attribute__((ext_vector_type(2)));

constexpr int T_ = 16384, SEQ = 8192, D_ = 2048, NIN = 7168, FF = 1024, NE = 32, CAP = 16384, HSLOT = 40960;
constexpr int NCH = 128;
constexpr float EPS = 1e-6f;
constexpr int NTHR = 512, NWAVE = 8;

constexpr size_t MiB = 1u << 20;
constexpr size_t WS_CTL = 0, CTL_BYTES = 1 * MiB;
constexpr size_t WS_WIN = 1 * MiB;
constexpr size_t WS_WOUT = 29 * MiB;
constexpr size_t WS_WGLU = 37 * MiB;
constexpr size_t WS_WGU = 53 * MiB;
constexpr size_t WS_WD = 565 * MiB;
constexpr size_t WS_HB = 821 * MiB;
constexpr size_t WS_YCAT = 885 * MiB;
constexpr size_t WS_XA = 949 * MiB;
constexpr size_t WS_XB = 1077 * MiB;
constexpr size_t WS_Z = 1205 * MiB;
constexpr size_t WS_KV = 1429 * MiB;
constexpr size_t WS_HID = 1557 * MiB;
constexpr size_t WS_ROWL = 1637 * MiB;
constexpr size_t WS_TOKG = 1641 * MiB;
constexpr size_t WS_TOKR = 1641 * MiB + 262144;
constexpr size_t WS_HGDEC = 1642 * MiB;
constexpr size_t WS_LB = 1643 * MiB;
constexpr size_t WS_S5A = 1643 * MiB + 65536;
constexpr size_t WS_S5B = 1644 * MiB;
constexpr size_t WS_S5L = 1645 * MiB;
constexpr size_t WS_WR = 1661 * MiB;
constexpr size_t WS_S5R = 1662 * MiB;
constexpr size_t WS_S5WST = 1666 * MiB;
constexpr size_t WS_S5WC = 1682 * MiB;
constexpr size_t WS_S5ZERO = 1698 * MiB;
constexpr size_t WS_S5A32 = 1698 * MiB + 524288;
constexpr size_t WS_S5LOC = 1699 * MiB;
constexpr size_t WS_S5HIN = 1731 * MiB;
constexpr size_t WS_SIN = 1747 * MiB;
constexpr size_t WS_ROWL16 = 1811 * MiB;
constexpr size_t WS_END = 1827 * MiB;

constexpr int CW_BAR = 4096;
constexpr int CW_CNT = 8192;

constexpr int LDS_BYTES = 163840;
constexpr int CONV_OFF = 131072;
constexpr int LIST_OFF = 131072;
constexpr int MISC_OFF = 155648;

__device__ __forceinline__ float bf2f(bf16 b) { return __uint_as_float(((unsigned)b) << 16); }
typedef __bf16 bf16x2_t __attribute__((ext_vector_type(2)));
__device__ __forceinline__ unsigned pk2(float lo, float hi) { const f32x2 v = {lo, hi}; return __builtin_bit_cast(unsigned, __builtin_convertvector(v, bf16x2_t)); }
__device__ __forceinline__ bf16 f2bf(float f) { return __builtin_bit_cast(bf16, (__bf16)f); }
__device__ __forceinline__ float sigmoidf_(float x) { return __builtin_amdgcn_rcpf(1.0f + __builtin_amdgcn_exp2f(-1.4426950408889634f * x)); }
__device__ __forceinline__ float siluf_(float x) { return x * __builtin_amdgcn_rcpf(1.0f + __builtin_amdgcn_exp2f(-1.4426950408889634f * x)); }
__device__ __forceinline__ float gelu_tanh(float x) { const float t = x * x; const float p = __builtin_fmaf(t, -0.10294324f, -2.3022082f); return x * __builtin_amdgcn_rcpf(1.0f + __builtin_amdgcn_exp2f(x * p)); }
__device__ __forceinline__ void unpack8(const u32x4 w, float (&o)[8]) {
    o[0] = __uint_as_float(w.x << 16); o[1] = __uint_as_float(w.x & 0xffff0000u); o[2] = __uint_as_float(w.y << 16); o[3] = __uint_as_float(w.y & 0xffff0000u);
    o[4] = __uint_as_float(w.z << 16); o[5] = __uint_as_float(w.z & 0xffff0000u); o[6] = __uint_as_float(w.w << 16); o[7] = __uint_as_float(w.w & 0xffff0000u);
}
__device__ __forceinline__ u32x4 pack8(const float (&v)[8]) { u32x4 w; w.x = pk2(v[0], v[1]); w.y = pk2(v[2], v[3]); w.z = pk2(v[4], v[5]); w.w = pk2(v[6], v[7]); return w; }
__host__ __device__ __forceinline__ int perm32(int rho) { const int n = rho >> 4, i = rho & 15; return 8 * (i >> 2) + 4 * n + (i & 3); }
__device__ __forceinline__ int lane_id() { unsigned z = 0u; asm volatile("" : "+v"(z)); return (int)__builtin_amdgcn_mbcnt_hi(~0u, __builtin_amdgcn_mbcnt_lo(~0u, z)); }
__device__ __forceinline__ float wave_sum(float v) {
#pragma unroll
    for (int o = 32; o >= 1; o >>= 1) v += __shfl_xor(v, o);
    return v;
}

#define XB_TMO      128
#define XB_XCNT(j)  (256  + 64 * (j))
#define XB_XSUB(j)  (1280 + 64 * (j))
#define XB_XGEN(j)  (2304 + 64 * (j))
#define XB_TOP      3328
#define XB_TOPGEN   3392
#define XCD_BAR_WORDS 3456
#define XB_SPIN_CAP (1u << 24)
__device__ __forceinline__ unsigned xb_ld(unsigned* p)              { return __hip_atomic_load(p, __ATOMIC_RELAXED, __HIP_MEMORY_SCOPE_AGENT); }
__device__ __forceinline__ unsigned xb_add(unsigned* p, unsigned v) { return __hip_atomic_fetch_add(p, v, __ATOMIC_RELAXED, __HIP_MEMORY_SCOPE_AGENT); }
__device__ __forceinline__ unsigned xb_xcc_id() { return (unsigned)__builtin_amdgcn_s_getreg((3 << 11) | 20) & 0xFu; }
#define XB_SPIN(cond, bar) do { unsigned _sp = 0; while (cond) { __builtin_amdgcn_s_sleep(1); \
    if ((++_sp & 255u) == 0u) { if (xb_ld(&(bar)[XB_TMO])) break; if (_sp > XB_SPIN_CAP) { atomicAdd(&(bar)[XB_TMO], 1u); break; } } } } while (0)
struct XcdBarrier { unsigned* bar; unsigned x; volatile LAS unsigned* st; };
__device__ __forceinline__ XcdBarrier xcd_barrier_post(unsigned* bar, volatile LAS unsigned* st, bool t0) {
    XcdBarrier b; b.bar = bar; b.x = xb_xcc_id(); b.st = st;
    if (t0) (void)xb_add(&bar[XB_XCNT(b.x)], 1u);
    return b;
}
__device__ __forceinline__ void xcd_barrier_complete(unsigned* bar, unsigned x, unsigned& nloc, unsigned& nx) {
    const unsigned G = gridDim.x * gridDim.y * gridDim.z;
    unsigned sum, cnt, mine, sp = 0u;
    for (;;) {
        sum = 0u; cnt = 0u; mine = 0u;
#pragma unroll
        for (unsigned j = 0; j < 16; ++j) { const unsigned c = xb_ld(&bar[XB_XCNT(j)]); sum += c; cnt += (c > 0u) ? 1u : 0u; mine = (j == x) ? c : mine; }
        if (sum == G) break;
        __builtin_amdgcn_s_sleep(1);
        if ((++sp & 255u) == 0u) { if (xb_ld(&bar[XB_TMO])) break; if (sp > XB_SPIN_CAP) { atomicAdd(&bar[XB_TMO], 1u); break; } }
    }
    nloc = mine > 0u ? mine : 1u; nx = cnt > 0u ? cnt : 1u;
}
__device__ __forceinline__ void xcd_barrier(const XcdBarrier& b, bool t0) {
    asm volatile("s_waitcnt vmcnt(0)" ::: "memory");
    __syncthreads();
    if (t0) {
        unsigned* bar = b.bar;
        __builtin_amdgcn_s_waitcnt(0);
        unsigned nloc = b.st[0], nx = b.st[1];
        if (nloc == 0u) { xcd_barrier_complete(bar, b.x, nloc, nx); b.st[0] = nloc; b.st[1] = nx; }
        const unsigned old = xb_add(&bar[XB_XSUB(b.x)], 1u);
        const unsigned gen = old / nloc;
        if (old + 1u == (gen + 1u) * nloc) {
            __builtin_amdgcn_fence(__ATOMIC_RELEASE, "agent");
            asm volatile("s_waitcnt vmcnt(0)" ::: "memory");
            const unsigned og = xb_add(&bar[XB_TOP], 1u);
            const unsigned tg = og / nx;
            if (og + 1u == (tg + 1u) * nx) xb_add(&bar[XB_TOPGEN], 1u);
            else XB_SPIN(xb_ld(&bar[XB_TOPGEN]) == tg, bar);
            __builtin_amdgcn_fence(__ATOMIC_ACQUIRE, "agent");
            xb_add(&bar[XB_XGEN(b.x)], 1u);
            asm volatile("s_waitcnt vmcnt(0)" ::: "memory");
        } else {
            XB_SPIN(xb_ld(&bar[XB_XGEN(b.x)]) == gen, bar);
            __builtin_amdgcn_fence(__ATOMIC_ACQUIRE, "agent");
            asm volatile("s_waitcnt vmcnt(0)" ::: "memory");
        }
    }
    __syncthreads();
}

namespace pg {
constexpr int BM = 256, BK = 64, HALF = 128, HTB = HALF * BK * 2, STAGE_BYTES = 8 * HTB, NXCD = 8, WGM = 8;
__host__ __device__ __forceinline__ int lds_byte(int r, int c) { const int st = (r >> 4) * 2 + (c >> 5), rr = r & 15, cc = c & 31, ob = rr * 64 + cc * 2; return st * 1024 + (ob ^ (((ob >> 9) & 1) << 5)); }
__host__ __device__ __forceinline__ void stage_rc(int b, int& R, int& C) { const int st = b / 1024, sb = b % 1024, swz = sb ^ (((sb >> 9) & 1) << 5); R = (st >> 1) * 16 + swz / 64; C = (st & 1) * 32 + (swz % 64) / 2; }

struct Unit { unsigned oA, oB, oA2, oB2; int hB, pm, pn, e, nvalid, lbuf; };

struct DenseSched {
    static constexpr bool GATHER = false, SEG2 = false, LIST = false, HALFN = false; static constexpr int KSB = 32768;
    const char* A; const char* B; const char* A2; const char* B2; int nt1, nt2, nM, nN, nwg, G, c, i0, i1;
    int pitchA, pitchB, hA, hA2, hB2; unsigned usB;
    __device__ __forceinline__ void init(const bf16* A_, const bf16* B_, int M, int N, int K_, int G_, int c_) { A = (const char*)A_; B = (const char*)B_; A2 = A; B2 = B; nt1 = K_ / BK; nt2 = 0; nM = M / BM; nN = N / BM; nwg = nM * nN; G = G_; c = c_; pitchA = K_ * 2; pitchB = 128; usB = 256u * (unsigned)K_ * 2u; hA = 128 * pitchA; hA2 = 0; hB2 = 0; i0 = 0; i1 = 1 << 20; }
    __device__ __forceinline__ unsigned voffA(int R, int C) const { return (unsigned)(R * pitchA + C * 2); }
    __device__ __forceinline__ unsigned voffB(int R, int C) const { return (unsigned)(R * pitchB + C * 2); }
    __device__ __forceinline__ unsigned voffA2(int, int) const { return 0u; }
    __device__ __forceinline__ unsigned voffB2(int, int) const { return 0u; }
    __device__ __forceinline__ bool next(int i, Unit& u) const {
        if (i0 + i >= i1) return false;
        const long L = (long)(i0 + i) * G + c; if (L >= nwg) return false;
        int wgid = (int)L; { const int q = nwg / NXCD, r = nwg % NXCD, xcd = wgid % NXCD, off = wgid / NXCD; wgid = (xcd < r ? xcd * (q + 1) : r * (q + 1) + (xcd - r) * q) + off; }
        const int nig = WGM * nN, gid = wgid / nig, fm = gid * WGM, gsz = (nM - fm) < WGM ? (nM - fm) : WGM;
        u.pm = fm + ((wgid % nig) % gsz); u.pn = (wgid % nig) / gsz; u.e = 0; u.nvalid = 256;
        u.oA = (unsigned)u.pm * 256u * (unsigned)pitchA; u.oB = (unsigned)u.pn * usB; u.oA2 = 0u; u.oB2 = 0u; u.hB = 128 * pitchB; return true;
    }
    __device__ __forceinline__ unsigned grow(const Unit&, int) const { return 0u; }
    __device__ __forceinline__ void list_issue(const Unit&, LAS unsigned char*, int, int, int) const {}
};

template <bool GATHER_> struct MoeSched {
    static constexpr bool GATHER = GATHER_, SEG2 = false, LIST = true, HALFN = false; static constexpr int KSB = 32768;
    const u32x4* rowl16;
    const char* A; const char* B; const char* A2; const char* B2; int nt1, nt2, nN, nwg, G, c, i0, i1; int pitchA, pitchB, hA, hA2, hB2; unsigned expStrideB, usB;
    const LAS int* tile0; const LAS int* cnt; const LAS unsigned char* tileExp; const int* rowl;
    __device__ __forceinline__ unsigned voffA(int R, int C) const { return (unsigned)(R * pitchA + C * 2); }
    __device__ __forceinline__ unsigned voffB(int R, int C) const { return (unsigned)(R * pitchB + C * 2); }
    __device__ __forceinline__ unsigned voffA2(int, int) const { return 0u; }
    __device__ __forceinline__ unsigned voffB2(int, int) const { return 0u; }
    __device__ __forceinline__ bool next(int i, Unit& u) const {
        if (i0 + i >= i1) return false;
        const long L = (long)(i0 + i) * G + c; if (L >= nwg) return false;
        int wgid = (int)L; { const int q = nwg / NXCD, xcd = wgid % NXCD, off = wgid / NXCD; wgid = xcd * q + off; }
        const int rt = wgid / nN, nt = wgid % nN;
        const int e = __builtin_amdgcn_readfirstlane((int)tileExp[rt]);
        const int lt = rt - __builtin_amdgcn_readfirstlane(tile0[e]);
        const int ce = __builtin_amdgcn_readfirstlane(cnt[e]);
        u.pm = rt; u.pn = nt; u.e = e; u.nvalid = ce - lt * 256;
        u.oA = GATHER ? 0u : (unsigned)rt * 256u * (unsigned)pitchA;
        u.oB = (unsigned)e * expStrideB + (unsigned)nt * usB; u.oA2 = 0u; u.oB2 = 0u; u.hB = 128 * pitchB; return true;
    }
    __device__ __forceinline__ void list_issue(const Unit& u, LAS unsigned char* lds, int buf, int wid, int lane) const {
        if (wid < 4) { const u32x4* src = rowl16 + (size_t)u.e * CAP + (size_t)(u.pm - tile0[u.e]) * 256 + wid * 64 + lane;
            __builtin_amdgcn_global_load_lds((const unsigned*)src, (LAS unsigned*)(lds + LIST_OFF + buf * 4096 + wid * 1024), 16, 0, 0); }
    }
    __device__ __forceinline__ unsigned grow_l(const Unit& u, const LAS unsigned char* lds, int buf, int r) const {
        const int v = *(const LAS int*)(lds + LIST_OFF + buf * 4096 + r * 16);
        const int tok = r < u.nvalid ? (v >> 1) : 0;
        return (unsigned)tok * (unsigned)pitchA;
    }
};

struct NoHook { __device__ __forceinline__ void operator()(int) const {} };
template <class Epi, class Sched, class Hook = NoHook>
__device__ __forceinline__ void gemm_phase_w(LAS unsigned char* lds, const Sched& S, const Epi& E, int wave_id, const Hook& HK = Hook()) {
    constexpr bool GATHER = Sched::GATHER, SEG2 = Sched::SEG2, LIST = Sched::LIST, HALFN = Sched::HALFN;
    const int lane = lane_id(), wid = wave_id, tid = wid * 64 + lane, wr = wid >> 2, wc = wid & 3, fr = lane & 15, fq = lane >> 4;
    const int nt1 = S.nt1, nt = S.nt1 + S.nt2;
    int R0, C0, R1, C1; stage_rc(tid * 16, R0, C0); stage_rc(tid * 16 + 8192, R1, C1);
    const unsigned voffA_0 = S.voffA(R0, C0), voffA_1 = S.voffA(R1, C1), voffB_0 = S.voffB(R0, C0), voffB_1 = S.voffB(R1, C1);
    const unsigned voffA2_0 = SEG2 ? S.voffA2(R0, C0) : 0u, voffA2_1 = SEG2 ? S.voffA2(R1, C1) : 0u, voffB2_0 = SEG2 ? S.voffB2(R0, C0) : 0u, voffB2_1 = SEG2 ? S.voffB2(R1, C1) : 0u;
    const int hA = S.hA, hA2 = S.hA2, hB2 = S.hB2;
    const unsigned ldsw = (unsigned)wid * 1024u;
    const int aoff = lds_byte(wr * 64 + fr, fq * 8), boff = lds_byte(wc * 32 + fr, fq * 8);
    unsigned gcur_00 = 0u, gcur_01 = 0u, gcur_10 = 0u, gcur_11 = 0u, gnxt_00 = 0u, gnxt_01 = 0u, gnxt_10 = 0u, gnxt_11 = 0u;
#define PG_SA(b, h) (((b) * 2 + (h)) * HTB)
#define PG_SB(b, h) ((4 + (b) * 2 + (h)) * HTB)
#define PG_GLDS(gp, bufoff, _i) __builtin_amdgcn_global_load_lds((const unsigned*)(gp), (LAS unsigned*)(lds + (bufoff) + ldsw + (_i) * 8192), 16, 0, 0)
#define PG_STAGE_B(bufoff, oB_, oB2_, hB_, kt, h, S2) do { \
        const char* _b = (S2) ? S.B2 + (long)(int)((oB2_) + (unsigned)(((kt) - nt1) * 128 + (h) * hB2)) : S.B + (long)(int)((oB_) + (unsigned)((kt) * S.KSB + (h) * (hB_))); \
        PG_GLDS(_b + ((S2) ? voffB2_0 : voffB_0), bufoff, 0); PG_GLDS(_b + ((S2) ? voffB2_1 : voffB_1), bufoff, 1); } while (0)
#define PG_STAGE_A(bufoff, oA_, oA2_, kt, h, GV, S2) do { \
        const char* _b = (S2) ? S.A2 + (size_t)((oA2_) + (unsigned)(((kt) - nt1) * 128 + (h) * hA2)) : S.A + (size_t)((oA_) + (unsigned)((kt) * 128 + (GATHER ? 0 : (h) * hA))); \
        if constexpr (GATHER) { PG_GLDS(_b + (GV##_##h##0), bufoff, 0); PG_GLDS(_b + (GV##_##h##1), bufoff, 1); } \
        else { PG_GLDS(_b + ((S2) ? voffA2_0 : voffA_0), bufoff, 0); PG_GLDS(_b + ((S2) ? voffA2_1 : voffA_1), bufoff, 1); } } while (0)
#define PG_SB_CUR(bufoff, kt, h, S2) PG_STAGE_B(bufoff, cur.oB, cur.oB2, cur.hB, kt, h, S2)
#define PG_SA_CUR(bufoff, kt, h, S2) PG_STAGE_A(bufoff, cur.oA, cur.oA2, kt, h, gcur, S2)
#define PG_SB_SEL(bufoff, kt, h, S2) PG_STAGE_B(bufoff, s_oB, s_oB2, s_hB, kt, h, S2)
#define PG_SA_SEL(bufoff, kt, h, S2) PG_STAGE_A(bufoff, s_oA, s_oA2, kt, h, gsel, S2)
#define PG_LDA(dst, b, h) do { _Pragma("unroll") for (int m = 0; m < 4; ++m) _Pragma("unroll") for (int k = 0; k < 2; ++k) dst[m][k] = *(const LAS bf16x8*)(lds + PG_SA(b, h) + aoff + m * 2048 + k * 1024); } while (0)
#define PG_LDB(dst, b, h) do { _Pragma("unroll") for (int n = 0; n < 2; ++n) _Pragma("unroll") for (int k = 0; k < 2; ++k) dst[n][k] = *(const LAS bf16x8*)(lds + PG_SB(b, h) + boff + n * 2048 + k * 1024); } while (0)
#define PG_MMA(ai, bj, At, Bt) do { __builtin_amdgcn_s_setprio(1); _Pragma("unroll") for (int m = 0; m < 4; ++m) _Pragma("unroll") for (int n = 0; n < 2; ++n) _Pragma("unroll") for (int k = 0; k < 2; ++k) \
        acc[ai][bj][m][n] = __builtin_amdgcn_mfma_f32_16x16x32_bf16(Bt[n][k], At[m][k], acc[ai][bj][m][n], 0, 0, 0); __builtin_amdgcn_s_setprio(0); } while (0)
#define PG_WAIT_V(n) asm volatile("s_waitcnt vmcnt(" #n ")" ::: "memory")
#define PG_WAIT_L(n) asm volatile("s_waitcnt lgkmcnt(" #n ")" ::: "memory")
#define PG_BAR __builtin_amdgcn_s_barrier()
#define PG_SCHED __builtin_amdgcn_sched_barrier(0)
    Unit cur, nxt; int ui = 0;
    if (!S.next(0, cur)) return;
    f32x4 acc[2][2][4][2];
#pragma unroll
    for (int a = 0; a < 2; ++a)
#pragma unroll
        for (int b = 0; b < 2; ++b)
#pragma unroll
            for (int m = 0; m < 4; ++m)
#pragma unroll
                for (int n = 0; n < 2; ++n) acc[a][b][m][n] = (f32x4){0.f, 0.f, 0.f, 0.f};
    bf16x8 At[4][2], B0[2][2], B1[2][2];
    cur.lbuf = 0;
    if constexpr (LIST) {
        S.list_issue(cur, lds, 0, wid, lane);
        asm volatile("s_waitcnt vmcnt(0)" ::: "memory"); __builtin_amdgcn_s_barrier(); asm volatile("" ::: "memory");
    }
    if constexpr (GATHER) {
        gcur_00 = S.grow_l(cur, lds, 0, R0) + (unsigned)(C0 * 2); gcur_01 = S.grow_l(cur, lds, 0, R1) + (unsigned)(C1 * 2); gcur_10 = S.grow_l(cur, lds, 0, 128 + R0) + (unsigned)(C0 * 2); gcur_11 = S.grow_l(cur, lds, 0, 128 + R1) + (unsigned)(C1 * 2);
    }
    PG_SB_CUR(PG_SB(0, 0), 0, 0, false); PG_SB_CUR(PG_SB(0, 1), 0, 1, false); PG_SA_CUR(PG_SA(0, 0), 0, 0, false); PG_SA_CUR(PG_SA(0, 1), 0, 1, false);
    if (wr == 1) PG_BAR;
    PG_WAIT_V(2); PG_BAR;
    PG_SB_CUR(PG_SB(1, 0), 1, 0, false); PG_SA_CUR(PG_SA(1, 0), 1, 0, false); PG_SB_CUR(PG_SB(1, 1), 1, 1, false);
    PG_WAIT_V(6); PG_BAR;
    for (;;) {
        const bool has_next = S.next(ui + 1, nxt);
        if (!has_next) nxt = cur;
        const int nbuf = (ui + 1) % 3; nxt.lbuf = has_next ? nbuf : cur.lbuf;
        if constexpr (LIST) { if (has_next) S.list_issue(nxt, lds, nbuf, wid, lane); }
#define PG_TRIP(T, A1S2, K23S2, LAST) do { const int t = (T); const bool last = (t == nt - 2); (void)(LAST); \
            const unsigned s_oA = last ? nxt.oA : cur.oA, s_oB = last ? nxt.oB : cur.oB, s_oA2 = last ? nxt.oA2 : cur.oA2, s_oB2 = last ? nxt.oB2 : cur.oB2; const int s_hB = last ? nxt.hB : cur.hB; \
            const int k2 = last ? 0 : t + 2, k3 = k2 + 1; \
            const unsigned gsel_00 = last ? gnxt_00 : gcur_00, gsel_01 = last ? gnxt_01 : gcur_01, gsel_10 = last ? gnxt_10 : gcur_10, gsel_11 = last ? gnxt_11 : gcur_11; \
            (void)s_oA2; (void)s_oB2; (void)gsel_00; (void)gsel_01; (void)gsel_10; (void)gsel_11; \
              \
            PG_LDB(B0, 0, 0); if constexpr (!HALFN) PG_LDB(B1, 0, 1); PG_SCHED; PG_LDA(At, 0, 0); PG_SA_CUR(PG_SA(1, 1), t + 1, 1, A1S2); \
            PG_WAIT_V(8); PG_WAIT_L(0); PG_BAR; PG_MMA(0, 0, At, B0); if constexpr (!HALFN) PG_MMA(0, 1, At, B1); PG_BAR; PG_SCHED; \
              \
            PG_LDA(At, 0, 1); PG_SB_SEL(PG_SB(0, 0), k2, 0, K23S2); PG_SB_SEL(PG_SB(0, 1), k2, 1, K23S2); PG_SA_SEL(PG_SA(0, 0), k2, 0, K23S2); \
            PG_WAIT_V(8); PG_WAIT_L(0); PG_BAR; PG_MMA(1, 0, At, B0); if constexpr (!HALFN) PG_MMA(1, 1, At, B1); PG_BAR; PG_SCHED; \
              \
            PG_LDB(B0, 1, 0); if constexpr (!HALFN) PG_LDB(B1, 1, 1); PG_SCHED; PG_LDA(At, 1, 0); PG_SA_SEL(PG_SA(0, 1), k2, 1, K23S2); \
            PG_WAIT_V(8); PG_WAIT_L(0); PG_BAR; PG_MMA(0, 0, At, B0); if constexpr (!HALFN) PG_MMA(0, 1, At, B1); PG_BAR; PG_SCHED; \
              \
            PG_LDA(At, 1, 1); PG_SB_SEL(PG_SB(1, 0), k3, 0, K23S2); PG_SB_SEL(PG_SB(1, 1), k3, 1, K23S2); PG_SA_SEL(PG_SA(1, 0), k3, 0, K23S2); \
            PG_WAIT_V(8); PG_WAIT_L(0); PG_BAR; PG_MMA(1, 0, At, B0); if constexpr (!HALFN) PG_MMA(1, 1, At, B1); PG_BAR; PG_SCHED; } while (0)
        if constexpr (!SEG2) {
            for (int tt = 0; tt < nt; tt += 2) {
                if constexpr (GATHER) { if (tt == nt - 2) {
                    if (has_next) { gnxt_00 = S.grow_l(nxt, lds, nbuf, R0) + (unsigned)(C0 * 2); gnxt_01 = S.grow_l(nxt, lds, nbuf, R1) + (unsigned)(C1 * 2); gnxt_10 = S.grow_l(nxt, lds, nbuf, 128 + R0) + (unsigned)(C0 * 2); gnxt_11 = S.grow_l(nxt, lds, nbuf, 128 + R1) + (unsigned)(C1 * 2); }
                    else { gnxt_00 = gcur_00; gnxt_01 = gcur_01; gnxt_10 = gcur_10; gnxt_11 = gcur_11; } } }
                PG_TRIP(tt, false, false, false);
            }
        } else {
            for (int tt = 0; tt < nt - 4; tt += 2) PG_TRIP(tt, false, false, false);
            PG_TRIP(nt - 4, false, true, false);
            PG_TRIP(nt - 2, true, false, true);
        }
#undef PG_TRIP
        if (wr == 0) PG_BAR;
        E(acc, cur, wr, wc, fr, fq);
        HK(ui);
        if (!has_next) break;
#pragma unroll
        for (int a = 0; a < 2; ++a)
#pragma unroll
            for (int b = 0; b < 2; ++b)
#pragma unroll
                for (int m = 0; m < 4; ++m)
#pragma unroll
                    for (int n = 0; n < 2; ++n) acc[a][b][m][n] = (f32x4){0.f, 0.f, 0.f, 0.f};
        cur = nxt; ++ui;
        if constexpr (GATHER) { gcur_00 = gnxt_00; gcur_01 = gnxt_01; gcur_10 = gnxt_10; gcur_11 = gnxt_11; }
        if (wr == 1) PG_BAR;
    }
    PG_WAIT_V(0);
    PG_BAR;
#undef PG_SA
#undef PG_SB
#undef PG_GLDS
#undef PG_STAGE_A
#undef PG_STAGE_B
#undef PG_SB_CUR
#undef PG_SA_CUR
#undef PG_SB_SEL
#undef PG_SA_SEL
#undef PG_LDA
#undef PG_LDB
#undef PG_MMA
#undef PG_WAIT_V
#undef PG_WAIT_L
#undef PG_BAR
#undef PG_SCHED
}
}


struct Args { const float* in[25]; float* out; unsigned char* ws; int ph_lo, ph_hi; };

struct Ctx {
    const float* in[25]; float* out; unsigned char* ws; LAS unsigned char* lds;
    int tid, lane, wave, G, bid;
};
#define WSP(T, off) ((T*)(c.ws + (off)))

struct ConvJob { const float* src; bf16* dst; int ld, k0, col0, dK, drow0; };
__device__ __forceinline__ ConvJob conv_job(const Ctx& c, int t);
__device__ __forceinline__ void conv_load(const ConvJob& j, f32x4 (&v)[8]) {
    const int tid = threadIdx.x;
#pragma unroll
    for (int it = 0; it < 8; ++it) { const int kk = it * 16 + (tid >> 5), c4 = tid & 31; v[it] = __builtin_nontemporal_load((const f32x4*)(j.src + (size_t)(j.k0 + kk) * j.ld + j.col0 + c4 * 4)); }
}
__device__ __forceinline__ void conv_to_lds(LAS float* L, const f32x4 (&v)[8]) {
    const int tid = threadIdx.x;
#pragma unroll
    for (int it = 0; it < 8; ++it) { const int kk = it * 16 + (tid >> 5), c4 = tid & 31; LAS float* p = L + kk * 129 + c4 * 4; p[0] = v[it][0]; p[1] = v[it][1]; p[2] = v[it][2]; p[3] = v[it][3]; }
}
__device__ __forceinline__ void conv_store(const LAS float* L, const ConvJob& j) {
    const int tid = threadIdx.x;
    const int rr = tid >> 2, kq = tid & 3; const int sc = (rr & ~31) + perm32(rr & 31);
#pragma unroll
    for (int j8 = 0; j8 < 4; ++j8) {
        float f[8];
#pragma unroll
        for (int q = 0; q < 8; ++q) f[q] = L[(kq * 32 + j8 * 8 + q) * 129 + sc];
        *(u32x4*)(j.dst + (size_t)(j.drow0 + rr) * j.dK + j.k0 + kq * 32 + j8 * 8) = pack8(f);
    }
}

__device__ __forceinline__ void row_load32(const float* __restrict__ p, int lane, float (&v)[32]) {
#pragma unroll
    for (int cch = 0; cch < 4; ++cch) { const f32x4 a = *(const f32x4*)(p + cch * 512 + lane * 8), b = *(const f32x4*)(p + cch * 512 + lane * 8 + 4);
        v[cch * 8 + 0] = a[0]; v[cch * 8 + 1] = a[1]; v[cch * 8 + 2] = a[2]; v[cch * 8 + 3] = a[3]; v[cch * 8 + 4] = b[0]; v[cch * 8 + 5] = b[1]; v[cch * 8 + 6] = b[2]; v[cch * 8 + 7] = b[3]; }
}
__device__ __forceinline__ void row_add_bf16(const bf16* __restrict__ p, int lane, float (&v)[32]) {
#pragma unroll
    for (int cch = 0; cch < 4; ++cch) { const u32x4 w = *(const u32x4*)(p + cch * 512 + lane * 8); float f[8]; unpack8(w, f);
#pragma unroll
        for (int j = 0; j < 8; ++j) v[cch * 8 + j] += f[j]; }
}
__device__ __forceinline__ float row_rstd(const float (&v)[32]) {
    float ss = 0.f;
#pragma unroll
    for (int j = 0; j < 32; ++j) ss += v[j] * v[j];
    ss = wave_sum(ss);
    return rsqrtf(ss * (1.0f / 2048.0f) + EPS);
}
__device__ __forceinline__ void row_store_norm_bf16(bf16* __restrict__ o, const float* __restrict__ g, int lane, const float (&v)[32], float r) {
#pragma unroll
    for (int cch = 0; cch < 4; ++cch) { const f32x4 ga = *(const f32x4*)(g + cch * 512 + lane * 8), gb = *(const f32x4*)(g + cch * 512 + lane * 8 + 4); float f[8];
#pragma unroll
        for (int j = 0; j < 4; ++j) { f[j] = v[cch * 8 + j] * r * ga[j]; f[4 + j] = v[cch * 8 + 4 + j] * r * gb[j]; }
        *(u32x4*)(o + cch * 512 + lane * 8) = pack8(f); }
}

constexpr int CV_IN = 16 * 56, CV_OUT = 16 * 16, CV_GLU = 16 * 32, CV_GU = 2 * 32 * 2 * 128, CV_DN = 2 * 32 * 128;
constexpr int CONV_TOT = CV_IN + CV_OUT + CV_GLU + CV_GU + CV_DN;
#ifndef CONV_IN_GEMM
#define CONV_IN_GEMM 1
#endif
constexpr int CONV_PRO = CONV_IN_GEMM ? CV_IN + CV_OUT : CONV_TOT;
constexpr int CVO_GLU = CV_IN + CV_OUT, CVO_GU = CVO_GLU + CV_GLU, CVO_DN = CVO_GU + CV_GU;
constexpr int CV_GU1_SPLIT = 13;
__device__ __forceinline__ ConvJob conv_job(const Ctx& c, int t) {
    ConvJob j; int i = t;
    if (i < CV_IN) { const int kb = i % 16, cb = i / 16; j.src = c.in[4]; j.ld = NIN; j.k0 = kb * 128; j.col0 = cb * 128; j.dst = WSP(bf16, WS_WIN); j.dK = 2048; j.drow0 = cb * 128; return j; }
    i -= CV_IN;
    if (i < CV_OUT) { const int kb = i % 16, cb = i / 16; j.src = c.in[8]; j.ld = 2048; j.k0 = kb * 128; j.col0 = cb * 128; j.dst = WSP(bf16, WS_WOUT); j.dK = 2048; j.drow0 = cb * 128; return j; }
    i -= CV_OUT;
    if (i < CV_GLU) { const int kb = i % 16, cb = i / 16; j.src = c.in[17]; j.ld = 4096; j.k0 = kb * 128; j.col0 = cb * 128; j.dst = WSP(bf16, WS_WGLU); j.dK = 2048; j.drow0 = cb < 16 ? cb * 256 : (cb - 16) * 256 + 128; return j; }
    i -= CV_GLU;
    if (i < CV_GU) { const int kb = i % 16, cb = (i / 16) % 8, gu = (i / 128) % 2, le = i / 256;
        j.src = (gu ? c.in[23] : c.in[22]) + (size_t)le * 2048 * 1024; j.ld = 1024; j.k0 = kb * 128; j.col0 = cb * 128; j.dst = WSP(bf16, WS_WGU) + (size_t)le * 2048 * 2048; j.dK = 2048; j.drow0 = cb * 256 + gu * 128; return j; }
    i -= CV_GU;
    { const int kb = i % 8, cb = (i / 8) % 16, le = i / 128;
        j.src = c.in[24] + (size_t)le * 1024 * 2048; j.ld = 2048; j.k0 = kb * 128; j.col0 = cb * 128; j.dst = WSP(bf16, WS_WD) + (size_t)le * 2048 * 1024; j.dK = 1024; j.drow0 = cb * 128; return j; }
}

__device__ __forceinline__ int cv_fz(int k) { return (k >> 3) & 7; }
__device__ __forceinline__ void conv_slice(const Ctx& c, int lo0, int n0, int lo1, int n1, int lo2, int n2) {
    const int tot = n0 + n1 + n2, G = c.G;
    const int mine = (tot - c.bid + G - 1) / G;
    if (mine <= 0) return;
    const int tid = c.tid, w = c.wave, lrow = c.lane >> 5, gp = c.lane & 31;
    const int rr0 = tid >> 3, kq = tid & 7;
#define CV_JOB(i) conv_job(c, [&](int ii) { const int v = c.bid + (ii < mine ? ii : mine - 1) * G; return v < n0 ? lo0 + v : (v < n0 + n1 ? lo1 + (v - n0) : lo2 + (v - n0 - n1)); }(i))
#define CV_ISSUE(i, buf) do { const ConvJob _j = CV_JOB(i); _Pragma("unroll") for (int _q = 0; _q < 8; ++_q) { const int _row = 2 * (_q * 8 + w) + lrow; const int _g = gp ^ cv_fz(_row); \
        __builtin_amdgcn_global_load_lds((const unsigned*)(_j.src + (size_t)(_j.k0 + _row) * _j.ld + _j.col0 + _g * 4), (LAS unsigned*)(c.lds + (buf) * 65536 + (_q * 8 + w) * 1024), 16, 0, 2); } } while (0)
    CV_ISSUE(0, 0); CV_ISSUE(1, 1);
    for (int i = 0; i < mine; ++i) {
        if (i == 0) asm volatile("s_waitcnt vmcnt(8)" ::: "memory"); else if (i == 1) asm volatile("s_waitcnt vmcnt(12)" ::: "memory"); else asm volatile("s_waitcnt vmcnt(16)" ::: "memory");
        __builtin_amdgcn_s_barrier();
        asm volatile("" ::: "memory");
        const LAS float* B = (const LAS float*)(c.lds + (i & 1) * 65536);
        u32x4 o[4];
#pragma unroll
        for (int p = 0; p < 2; ++p) { const int rr = rr0 + 64 * p, sc = (rr & ~31) + perm32(rr & 31), scg = sc >> 2, scl = sc & 3;
#pragma unroll
            for (int h = 0; h < 2; ++h) { float f[8];
#pragma unroll
                for (int q = 0; q < 8; ++q) { const int k = 64 * h + kq * 8 + q; f[q] = B[k * 128 + ((scg ^ kq) << 2) + scl]; }
                o[p * 2 + h] = pack8(f); } }
        asm volatile("s_waitcnt lgkmcnt(0)" ::: "memory");
        __builtin_amdgcn_s_barrier();
        asm volatile("" ::: "memory");
        if ((i & 1) == 0) CV_ISSUE(i + 2, 0); else CV_ISSUE(i + 2, 1);
        asm volatile("" ::: "memory");
        { const ConvJob j = CV_JOB(i);
#pragma unroll
          for (int p = 0; p < 2; ++p) { const int n = j.drow0 + rr0 + 64 * p;
              bf16* d = j.dst + (((size_t)(n >> 8) * (j.dK >> 6) + (j.k0 >> 6)) * 256 + (n & 255)) * 64 + kq * 8;
#pragma unroll
              for (int h = 0; h < 2; ++h) *(u32x4*)(d + (size_t)h * 16384) = o[p * 2 + h]; } }
        asm volatile("" ::: "memory");
    }
    asm volatile("s_waitcnt vmcnt(0)" ::: "memory");
    __builtin_amdgcn_s_barrier();
#undef CV_ISSUE
#undef CV_JOB
}

__device__ __forceinline__ void conv_slice_moe(const Ctx& c, int lo, int n, int nwg, int per_light) {
    const int extra = nwg % c.G, n_light = extra ? c.G - extra : 0;
    int nb = n_light * per_light; if (nb > n) nb = n;
    if (n_light > 0 && c.bid >= extra && nb > 0) { Ctx c2 = c; c2.bid = c.bid - extra; c2.G = n_light; conv_slice(c2, lo, nb, 0, 0, 0, 0); }
    conv_slice(c, lo + nb, n - nb, 0, 0, 0, 0);
}

__device__ __forceinline__ void s5_precompute_group(const Ctx& c, int g) {
    LAS float* AR = (LAS float*)c.lds; LAS float* AI = AR + 64; LAS float* BBR = AI + 64; LAS float* BBI = BBR + 1024;
    LAS float* PR = BBI + 1024; LAS float* PI = PR + 33 * 64; LAS float* CRE = PI + 33 * 64; LAS float* CIM = CRE + 1024;
    const int tid = c.tid;
    if (tid < 64) {
        const int p = tid, i = g * 64 + p;
        const float dt = expf(c.in[11][g]), lr = c.in[9][i], li = c.in[10][i];
        const float mag = expf(lr * dt), ar = mag * cosf(li * dt), ai = mag * sinf(li * dt);
        const float den = lr * lr + li * li;
        const float cr = ((ar - 1.0f) * lr + ai * li) / den, ci = (ai * lr - (ar - 1.0f) * li) / den;
        AR[p] = ar; AI[p] = ai;
        for (int ch = 0; ch < 16; ++ch) { const float br = c.in[12][(size_t)i * 16 + ch], bi = c.in[13][(size_t)i * 16 + ch]; BBR[p * 16 + ch] = cr * br - ci * bi; BBI[p * 16 + ch] = cr * bi + ci * br; }
        float pr = 1.0f, pi = 0.0f; PR[p] = pr; PI[p] = pi;
        for (int tau = 1; tau <= 32; ++tau) { const float nr = pr * ar - pi * ai, ni = pr * ai + pi * ar; pr = nr; pi = ni; PR[tau * 64 + p] = pr; PI[tau * 64 + p] = pi; }
        float* A32 = WSP(float, WS_S5A32) + (size_t)i * 2; A32[0] = pr; A32[1] = pi;
        *(u32x4*)(WSP(bf16, WS_S5ZERO) + (size_t)g * 512 + p * 8) = (u32x4){0u, 0u, 0u, 0u};
    }
    for (int i = tid; i < 1024; i += NTHR) { CRE[i] = c.in[14][(size_t)g * 1024 + i]; CIM[i] = c.in[15][(size_t)g * 1024 + i]; }
    __syncthreads();
    bf16* Rg = WSP(bf16, WS_S5R) + (size_t)g * 16 * 1024;
    for (int idx = tid; idx < 16 * 32 * 16; idx += NTHR) {
        const int co = idx >> 9, tau = (idx >> 4) & 31, ci = idx & 15; float acc = 0.f;
        for (int p = 0; p < 64; ++p) { const float pr = PR[tau * 64 + p], pi = PI[tau * 64 + p], br = BBR[p * 16 + ci], bi = BBI[p * 16 + ci];
            const float wr = pr * br - pi * bi, wi = pr * bi + pi * br; acc += CRE[co * 64 + p] * wr - CIM[co * 64 + p] * wi; }
        Rg[co * 1024 + (31 - tau) * 16 + ci] = f2bf(acc);
    }
    for (int idx = tid; idx < 16 * 64; idx += NTHR) { const int co = idx >> 6, q = idx & 63; *(u32x4*)(Rg + co * 1024 + 512 + q * 8) = (u32x4){0u, 0u, 0u, 0u}; }
    bf16* Wst = WSP(bf16, WS_S5WST) + (size_t)g * 128 * 512;
    for (int idx = tid; idx < 128 * 64; idx += NTHR) {
        const int r = idx >> 6, k8 = idx & 63, sI = k8 >> 1, ci0 = (k8 & 1) * 8; const int j = (r & ~31) + perm32(r & 31), ri = j >> 6, p = j & 63, tau = 31 - sI;
        const float pr = PR[tau * 64 + p], pi = PI[tau * 64 + p]; float f[8];
#pragma unroll
        for (int q = 0; q < 8; ++q) { const float br = BBR[p * 16 + ci0 + q], bi = BBI[p * 16 + ci0 + q]; f[q] = ri ? (pr * bi + pi * br) : (pr * br - pi * bi); }
        *(u32x4*)(Wst + (size_t)r * 512 + k8 * 8) = pack8(f);
    }
    bf16* Wc = WSP(bf16, WS_S5WC) + (size_t)g * 512 * 128;
    for (int idx = tid; idx < 512 * 16; idx += NTHR) {
        const int r = idx >> 4, k8 = idx & 15, ri = k8 >> 3, p0 = (k8 & 7) * 8; const int j = (r & ~31) + perm32(r & 31), t = j >> 4, co = j & 15, n = t + 1; float f[8];
#pragma unroll
        for (int q = 0; q < 8; ++q) { const int p = p0 + q; const float pr = PR[n * 64 + p], pi = PI[n * 64 + p], cr = CRE[co * 64 + p], ci = CIM[co * 64 + p]; f[q] = ri ? (-cr * pi - ci * pr) : (cr * pr - ci * pi); }
        *(u32x4*)(Wc + (size_t)r * 128 + k8 * 8) = pack8(f);
    }
    __syncthreads();
}
__device__ __forceinline__ void ph_prologue(const Ctx& c) {
    LAS float* L = (LAS float*)c.lds;
    if (S5_MFMA) { for (int g = c.bid; g < 128; g += c.G) s5_precompute_group(c, g); }
    conv_slice(c, 0, CONV_PRO, 0, 0, 0, 0);
    __syncthreads();
    {
        const bool bal = S5_MFMA && c.G == 256; const int heavy = c.bid < 128;
        const int nrow = bal ? (heavy ? 6 : 10) : (T_ + c.G * NWAVE - 1) / (c.G * NWAVE);
        const int row0 = bal ? (heavy ? (c.bid * NWAVE + c.wave) * 6 : 128 * NWAVE * 6 + ((c.bid - 128) * NWAVE + c.wave) * 10) : (c.bid * NWAVE + c.wave) * nrow;
        for (int i = 0; i < nrow; ++i) { const int row = row0 + i; if (row >= T_) break;
            float v[32]; row_load32(c.in[0] + (size_t)row * D_, c.lane, v);
            const float r = row_rstd(v);
            row_store_norm_bf16(WSP(bf16, WS_HB) + (size_t)row * D_, c.in[1], c.lane, v, r);
        }
    }
    const int gtid = c.bid * NTHR + c.tid, gn = c.G * NTHR;
    for (int i = gtid; i < 1024; i += gn) { const float a = c.in[6][i], b = c.in[6][1024 + i], m = fmaxf(a, b); const float ea = expf(a - m), eb = expf(b - m); WSP(float, WS_LB)[i] = ea / (ea + eb); }
    for (int i = gtid; i < 128 * 64; i += gn) {
        const int g = i >> 6;
        const float dt = expf(c.in[11][g]), lr = c.in[9][i], li = c.in[10][i];
        const float mag = expf(lr * dt), ar = mag * cosf(li * dt), ai = mag * sinf(li * dt);
        const float den = lr * lr + li * li;
        const float cr = ((ar - 1.0f) * lr + ai * li) / den, ci = (ai * lr - (ar - 1.0f) * li) / den;
        float pr = ar, pi = ai;
#pragma unroll
        for (int s = 0; s < 6; ++s) { const float nr = pr * pr - pi * pi, ni = 2.0f * pr * pi; pr = nr; pi = ni; }
        float* A4 = WSP(float, WS_S5A) + (size_t)i * 4; A4[0] = ar; A4[1] = ai; A4[2] = pr; A4[3] = pi;
        float* Bo = WSP(float, WS_S5B) + (size_t)i * 32;
        for (int ch = 0; ch < 16; ++ch) { const float br = c.in[12][(size_t)i * 16 + ch], bi = c.in[13][(size_t)i * 16 + ch]; Bo[ch] = cr * br - ci * bi; Bo[16 + ch] = cr * bi + ci * br; }
    }
    for (int i = gtid; i < 2 * 48 * 2048; i += gn) {
        const int k = i % 2048, n = (i / 2048) % 48, l = i / (48 * 2048);
        float w = 0.f;
        if (n < 4) w = c.in[18][((size_t)l * 2048 + k) * 4 + n]; else if (n < 36) w = c.in[20][((size_t)l * 2048 + k) * 32 + (n - 4)];
        w *= c.in[2][l * 2048 + k];
        const bf16 hi = f2bf(w), lo = f2bf(w - bf2f(hi));
        bf16* d = WSP(bf16, WS_WR) + ((size_t)(l * 48 + n) * 2) * 2048 + k; d[0] = hi; d[2048] = lo;
    }
}

template <bool PAIRED, class ARow, class Epi>
__device__ __forceinline__ void naive_gemm(const Ctx& c, int M, int N, int K, const ARow& arow, const float* __restrict__ W, const float* __restrict__ W2, int ldw, const Epi& epi) {
    LAS float* As = (LAS float*)c.lds;
    LAS float* Ws = As + 16 * 68;
    LAS float* Ws2 = Ws + 16 * 132;
    const int tid = c.tid, ty = tid >> 5, tx = tid & 31;
    const int ntm = (M + 63) / 64, ntn = N / 128;
    for (int tile = c.bid; tile < ntm * ntn; tile += c.G) {
        const int tm = tile / ntn, tn = tile % ntn, r0 = tm * 64, c0 = tn * 128;
        float a1[4][4], a2[4][4];
#pragma unroll
        for (int i = 0; i < 4; ++i)
#pragma unroll
            for (int j = 0; j < 4; ++j) { a1[i][j] = 0.f; a2[i][j] = 0.f; }
        const int lr = tid >> 3, lk = (tid & 7) * 2;
        const bf16* ap = (r0 + lr < M) ? arow(r0 + lr) : nullptr;
        for (int k0 = 0; k0 < K; k0 += 16) {
            { float x0 = 0.f, x1 = 0.f; if (ap) { const unsigned w = *(const unsigned*)(ap + k0 + lk); x0 = __uint_as_float(w << 16); x1 = __uint_as_float(w & 0xffff0000u); }
              As[lk * 68 + lr] = x0; As[(lk + 1) * 68 + lr] = x1; }
            { const int wk = tid >> 5, w4 = tid & 31; const f32x4 wv = *(const f32x4*)(W + (size_t)(k0 + wk) * ldw + c0 + w4 * 4);
              LAS float* p = Ws + wk * 132 + w4 * 4; p[0] = bf2f(f2bf(wv[0])); p[1] = bf2f(f2bf(wv[1])); p[2] = bf2f(f2bf(wv[2])); p[3] = bf2f(f2bf(wv[3]));
              if (PAIRED) { const f32x4 wv2 = *(const f32x4*)(W2 + (size_t)(k0 + wk) * ldw + c0 + w4 * 4); LAS float* p2 = Ws2 + wk * 132 + w4 * 4;
                  p2[0] = bf2f(f2bf(wv2[0])); p2[1] = bf2f(f2bf(wv2[1])); p2[2] = bf2f(f2bf(wv2[2])); p2[3] = bf2f(f2bf(wv2[3])); } }
            __syncthreads();
#pragma unroll
            for (int kk = 0; kk < 16; ++kk) {
                float av[4], wv[4], wv2[4];
#pragma unroll
                for (int i = 0; i < 4; ++i) av[i] = As[kk * 68 + ty * 4 + i];
#pragma unroll
                for (int j = 0; j < 4; ++j) { wv[j] = Ws[kk * 132 + tx * 4 + j]; if (PAIRED) wv2[j] = Ws2[kk * 132 + tx * 4 + j]; }
#pragma unroll
                for (int i = 0; i < 4; ++i)
#pragma unroll
                    for (int j = 0; j < 4; ++j) { a1[i][j] += av[i] * wv[j]; if (PAIRED) a2[i][j] += av[i] * wv2[j]; }
            }
            __syncthreads();
        }
#pragma unroll
        for (int i = 0; i < 4; ++i) { const int r = r0 + ty * 4 + i; if (r < M)
#pragma unroll
            for (int j = 0; j < 4; ++j) epi(r, c0 + tx * 4 + j, a1[i][j], a2[i][j]); }
    }
}

constexpr size_t ZH_AS = (size_t)2 * 8 * SEQ * 128;
struct EpiZ {
    bf16* Z; bf16* ZH;
    __device__ __forceinline__ void operator()(const f32x4 (&acc)[2][2][4][2], const pg::Unit& u, int wr, int wc, int fr, int fq) const {
        if (u.pn >= 12) {
            const int pp = u.pn - 12, arr = pp >> 2, h0 = (pp & 3) * 2;
#pragma unroll
            for (int ai = 0; ai < 2; ++ai)
#pragma unroll
                for (int m = 0; m < 4; ++m) { const int row = u.pm * 256 + ai * 128 + wr * 64 + m * 16 + fr; const int b = row >> 13, t = row & (SEQ - 1);
#pragma unroll
                    for (int bj = 0; bj < 2; ++bj) { const f32x4 v0 = acc[ai][bj][m][0], v1 = acc[ai][bj][m][1]; u32x4 w; w.x = pk2(v0[0], v0[1]); w.y = pk2(v0[2], v0[3]); w.z = pk2(v1[0], v1[1]); w.w = pk2(v1[2], v1[3]);
                        *(u32x4*)(ZH + (size_t)arr * ZH_AS + ((size_t)((b * 8 + h0 + bj) * SEQ + t)) * 128 + wc * 32 + 8 * fq) = w; } }
            return;
        }
#pragma unroll
        for (int ai = 0; ai < 2; ++ai)
#pragma unroll
            for (int m = 0; m < 4; ++m) { const int row = u.pm * 256 + ai * 128 + wr * 64 + m * 16 + fr; bf16* rp = Z + (size_t)row * NIN + u.pn * 256 + wc * 32 + 8 * fq;
#pragma unroll
                for (int bj = 0; bj < 2; ++bj) { const f32x4 v0 = acc[ai][bj][m][0], v1 = acc[ai][bj][m][1]; u32x4 w; w.x = pk2(v0[0], v0[1]); w.y = pk2(v0[2], v0[3]); w.z = pk2(v1[0], v1[1]); w.w = pk2(v1[2], v1[3]);
                    *(u32x4*)(rp + bj * 128) = w; } }
    }
};
__device__ __forceinline__ void ph_inproj(const Ctx& c) {
    if (NAIVE_GEMM & 1) {
        const bf16* hb = WSP(bf16, WS_HB); bf16* Z = WSP(bf16, WS_Z);
        naive_gemm<false>(c, T_, NIN, 2048, [=](int r) { return hb + (size_t)r * 2048; }, c.in[4], nullptr, NIN, [=](int r, int col, float a, float) { Z[(size_t)r * NIN + col] = f2bf(a); });
    } else {
        pg::DenseSched S; S.init(WSP(bf16, WS_HB), WSP(bf16, WS_WIN), T_, NIN, 2048, c.G, c.bid);
        EpiZ E{WSP(bf16, WS_Z), WSP(bf16, WS_XB)};
        if (CONV_IN_GEMM) {
            const int slot = (c.bid >> 3) % 7; S.i1 = slot + 1; pg::gemm_phase_w(c.lds, S, E, c.wave);
            conv_slice(c, CVO_GLU, CV_GLU + CV_GU / 2, 0, 0, 0, 0);
            S.i0 = slot + 1; S.i1 = 1 << 20; pg::gemm_phase_w(c.lds, S, E, c.wave); }
        else pg::gemm_phase_w(c.lds, S, E, c.wave);
    }
}

constexpr int HS = 132;
__device__ __forceinline__ void hg_load_tile(const Ctx& c, LAS float* dst, const bf16* __restrict__ src  ) {
#pragma unroll
    for (int i = 0; i < 2; ++i) { const int vid = c.tid + i * 512, t = vid >> 4, d8 = vid & 15; const u32x4 w = *(const u32x4*)(src + (size_t)t * NIN + d8 * 8); float f[8]; unpack8(w, f);
        LAS float* p = dst + t * HS + d8 * 8;
#pragma unroll
        for (int j = 0; j < 8; ++j) p[j] = f[j]; }
}
__device__ __forceinline__ void ph_conv_hglocal(const Ctx& c) {
    const bf16* Z = WSP(bf16, WS_Z); bf16* Y = WSP(bf16, WS_YCAT);
    {
        const float* cw = c.in[5];
        const int gtid = c.bid * NTHR + c.tid, gn = c.G * NTHR;
        for (int it = gtid; it < (T_ / 8) * 128; it += gn) {
            const int c8 = it & 127, tb = it >> 7, t0 = tb * 8, ch = c8 * 8;
            float w0[8], w1[8], w2[8];
#pragma unroll
            for (int j = 0; j < 8; ++j) { w0[j] = cw[ch + j]; w1[j] = cw[1024 + ch + j]; w2[j] = cw[2048 + ch + j]; }
            float um2[8], um1[8];
#pragma unroll
            for (int j = 0; j < 8; ++j) { um2[j] = 0.f; um1[j] = 0.f; }
            if ((t0 & (SEQ - 1)) != 0) {
                float a[8], b[8];
                unpack8(*(const u32x4*)(Z + (size_t)(t0 - 2) * NIN + 1024 + ch), a); unpack8(*(const u32x4*)(Z + (size_t)(t0 - 2) * NIN + 2048 + ch), b);
#pragma unroll
                for (int j = 0; j < 8; ++j) um2[j] = a[j] * b[j];
                unpack8(*(const u32x4*)(Z + (size_t)(t0 - 1) * NIN + 1024 + ch), a); unpack8(*(const u32x4*)(Z + (size_t)(t0 - 1) * NIN + 2048 + ch), b);
#pragma unroll
                for (int j = 0; j < 8; ++j) um1[j] = a[j] * b[j];
            }
#pragma unroll
            for (int tt = 0; tt < 8; ++tt) {
                const size_t ro = (size_t)(t0 + tt) * NIN; float ab[8], ac[8], ah[8], o[8];
                unpack8(*(const u32x4*)(Z + ro + ch), ab); unpack8(*(const u32x4*)(Z + ro + 1024 + ch), ac); unpack8(*(const u32x4*)(Z + ro + 2048 + ch), ah);
#pragma unroll
                for (int j = 0; j < 8; ++j) { const float u0 = ac[j] * ah[j]; o[j] = ab[j] * (w0[j] * um2[j] + w1[j] * um1[j] + w2[j] * u0); um2[j] = um1[j]; um1[j] = u0; }
                *(u32x4*)(Y + (size_t)(t0 + tt) * D_ + ch) = pack8(o);
            }
        }
    }
    if (!HG_MFMA) {
        LAS float* B0 = (LAS float*)c.lds; LAS float* B1 = B0 + 64 * HS; LAS float* B2 = B1 + 64 * HS;
        const float* lb = WSP(float, WS_LB); float* KV = WSP(float, WS_KV); float* DEC = WSP(float, WS_HGDEC);
        for (int u = c.bid; u < 2048; u += c.G) {
            const int chunk = u & 127, bh = u >> 7, h = bh & 7, b = bh >> 3; const int t0 = b * SEQ + chunk * 64;
            hg_load_tile(c, B0, Z + (size_t)t0 * NIN + 4096 + h * 128);
            hg_load_tile(c, B2, Z + (size_t)t0 * NIN + 5120 + h * 128);
            __syncthreads();
            for (int i = c.tid; i < 64 * 128; i += 512) { const int t = i >> 7, d = i & 127; const float l = lb[h * 128 + d]; const float f = l + (1.0f - l) * sigmoidf_(B0[t * HS + d]); B0[t * HS + d] = logf(f); B1[t * HS + d] = 1.0f - f; }
            __syncthreads();
            if (c.tid < 128) { float run = 0.f; for (int t = 0; t < 64; ++t) { run += B0[t * HS + c.tid]; B0[t * HS + c.tid] = run; } }
            __syncthreads();
            for (int i = c.tid; i < 64 * 128; i += 512) { const int t = i >> 7, d = i & 127; B1[t * HS + d] *= expf(B0[63 * HS + d] - B0[t * HS + d]); }
            __syncthreads();
            const int kd0 = (c.tid >> 4) * 4, vd0 = (c.tid & 15) * 8;
            float acc[4][8];
#pragma unroll
            for (int i = 0; i < 4; ++i)
#pragma unroll
                for (int j = 0; j < 8; ++j) acc[i][j] = 0.f;
            for (int t = 0; t < 64; ++t) {
                const f32x4 kv = *(const LAS f32x4*)(B1 + t * HS + kd0), va = *(const LAS f32x4*)(B2 + t * HS + vd0), vb = *(const LAS f32x4*)(B2 + t * HS + vd0 + 4);
#pragma unroll
                for (int i = 0; i < 4; ++i) {
#pragma unroll
                    for (int j = 0; j < 4; ++j) { acc[i][j] += kv[i] * va[j]; acc[i][4 + j] += kv[i] * vb[j]; } }
            }
            float* kvp = KV + (size_t)u * 16384;
#pragma unroll
            for (int i = 0; i < 4; ++i) { *(f32x4*)(kvp + (kd0 + i) * 128 + vd0) = (f32x4){acc[i][0], acc[i][1], acc[i][2], acc[i][3]}; *(f32x4*)(kvp + (kd0 + i) * 128 + vd0 + 4) = (f32x4){acc[i][4], acc[i][5], acc[i][6], acc[i][7]}; }
            if (c.tid < 128) DEC[(size_t)u * 128 + c.tid] = expf(B0[63 * HS + c.tid]);
            __syncthreads();
        }
    }
}

__device__ __forceinline__ void ph_hgscan(const Ctx& c) {
    float* KV = WSP(float, WS_KV); const float* DEC = WSP(float, WS_HGDEC);
    const int gtid = c.bid * NTHR + c.tid, gn = c.G * NTHR;
    for (int i = gtid; i < 16 * 16384; i += gn) {
        const int bh = i >> 14, el = i & 16383, kd = el >> 7;
        float s = 0.f;
        for (int c0 = 0; c0 < 128; c0 += 8) {
            float tmp[8], dc[8];
#pragma unroll
            for (int j = 0; j < 8; ++j) { tmp[j] = KV[(size_t)(bh * 128 + c0 + j) * 16384 + el]; dc[j] = DEC[(size_t)(bh * 128 + c0 + j) * 128 + kd]; }
#pragma unroll
            for (int j = 0; j < 8; ++j) { KV[(size_t)(bh * 128 + c0 + j) * 16384 + el] = s; s = dc[j] * s + tmp[j]; }
        }
    }
}

__device__ __forceinline__ void ph_hgout(const Ctx& c) {
    const bf16* Z = WSP(bf16, WS_Z); bf16* Y = WSP(bf16, WS_YCAT);
    LAS float* B0 = (LAS float*)c.lds; LAS float* B1 = B0 + 64 * HS; LAS float* B2 = B1 + 64 * HS; LAS float* B3 = B2 + 64 * HS;
    const float* lb = WSP(float, WS_LB); const float* KV = WSP(float, WS_KV); const float* ng = c.in[7];
    for (int u = c.bid; u < 2048; u += c.G) {
        const int chunk = u & 127, bh = u >> 7, h = bh & 7, b = bh >> 3; const int t0 = b * SEQ + chunk * 64;
        hg_load_tile(c, B0, Z + (size_t)t0 * NIN + 4096 + h * 128);
        hg_load_tile(c, B1, Z + (size_t)t0 * NIN + 3072 + h * 128);
        hg_load_tile(c, B2, Z + (size_t)t0 * NIN + 5120 + h * 128);
        __syncthreads();
        for (int i = c.tid; i < 64 * 128; i += 512) { const int t = i >> 7, d = i & 127; const float l = lb[h * 128 + d]; const float f = l + (1.0f - l) * sigmoidf_(B0[t * HS + d]); B0[t * HS + d] = logf(f); B3[t * HS + d] = 1.0f - f; }
        __syncthreads();
        if (c.tid < 128) { float run = 0.f; for (int t = 0; t < 64; ++t) { run += B0[t * HS + c.tid]; B0[t * HS + c.tid] = run; } }
        __syncthreads();
        const int dd = c.tid & 127; const float ref = B0[31 * HS + dd];
        __syncthreads();
        for (int i = c.tid; i < 64 * 128; i += 512) { const int t = i >> 7; const float bb = B0[t * HS + dd], q = B1[t * HS + dd];
            B1[t * HS + dd] = q * expf(bb); B0[t * HS + dd] = q * expf(bb - ref); B3[t * HS + dd] *= expf(ref - bb); }
        __syncthreads();
        const int tg = c.tid >> 4, vg = c.tid & 15, ta = tg * 2, vd0 = vg * 8;
        float o[2][8];
#pragma unroll
        for (int i = 0; i < 2; ++i)
#pragma unroll
            for (int j = 0; j < 8; ++j) o[i][j] = 0.f;
        {
            const float* sp = KV + (size_t)u * 16384 + vd0;
            for (int kd = 0; kd < 128; kd += 4) {
                const f32x4 qa = *(const LAS f32x4*)(B1 + ta * HS + kd), qb = *(const LAS f32x4*)(B1 + (ta + 1) * HS + kd);
#pragma unroll
                for (int k2 = 0; k2 < 4; ++k2) { const f32x4 s0 = *(const f32x4*)(sp + (size_t)(kd + k2) * 128), s1 = *(const f32x4*)(sp + (size_t)(kd + k2) * 128 + 4);
#pragma unroll
                    for (int j = 0; j < 4; ++j) { o[0][j] += qa[k2] * s0[j]; o[0][4 + j] += qa[k2] * s1[j]; o[1][j] += qb[k2] * s0[j]; o[1][4 + j] += qb[k2] * s1[j]; } }
            }
        }
        __syncthreads();
        {
            const int t = c.tid >> 3, s0 = (c.tid & 7) * 8; float sc[8];
#pragma unroll
            for (int j = 0; j < 8; ++j) sc[j] = 0.f;
            for (int kd = 0; kd < 128; kd += 4) { const f32x4 q = *(const LAS f32x4*)(B0 + t * HS + kd);
#pragma unroll
                for (int j = 0; j < 8; ++j) { const f32x4 k = *(const LAS f32x4*)(B3 + (s0 + j) * HS + kd); sc[j] += q[0] * k[0] + q[1] * k[1] + q[2] * k[2] + q[3] * k[3]; } }
#pragma unroll
            for (int j = 0; j < 8; ++j) B1[t * 68 + s0 + j] = (s0 + j <= t) ? sc[j] : 0.f;
        }
        __syncthreads();
        for (int s = 0; s <= ta + 1; ++s) {
            const float p0 = B1[ta * 68 + s], p1 = B1[(ta + 1) * 68 + s];
            const f32x4 va = *(const LAS f32x4*)(B2 + s * HS + vd0), vb = *(const LAS f32x4*)(B2 + s * HS + vd0 + 4);
#pragma unroll
            for (int j = 0; j < 4; ++j) { o[0][j] += p0 * va[j]; o[0][4 + j] += p0 * vb[j]; o[1][j] += p1 * va[j]; o[1][4 + j] += p1 * vb[j]; }
        }
#pragma unroll
        for (int i = 0; i < 2; ++i) {
            float ss = 0.f;
#pragma unroll
            for (int j = 0; j < 8; ++j) ss += o[i][j] * o[i][j];
            ss += __shfl_xor(ss, 1); ss += __shfl_xor(ss, 2); ss += __shfl_xor(ss, 4); ss += __shfl_xor(ss, 8);
            const float r = rsqrtf(ss * (1.0f / 128.0f) + EPS);
            float g[8], res[8]; unpack8(*(const u32x4*)(Z + (size_t)(t0 + ta + i) * NIN + 6144 + h * 128 + vd0), g);
#pragma unroll
            for (int j = 0; j < 8; ++j) res[j] = o[i][j] * r * ng[vd0 + j] * siluf_(g[j]);
            *(u32x4*)(Y + (size_t)(t0 + ta + i) * D_ + 1024 + h * 128 + vd0) = pack8(res);
        }
        __syncthreads();
    }
}

__device__ __forceinline__ void hg_col16(const bf16* __restrict__ p, unsigned short (&o)[16]) {
#pragma unroll
    for (int i = 0; i < 16; ++i) o[i] = p[(size_t)i * NIN];
}
__device__ __forceinline__ u32x4 pk8us(unsigned short a0, unsigned short a1, unsigned short a2, unsigned short a3, unsigned short a4, unsigned short a5, unsigned short a6, unsigned short a7) {
    u32x4 w; w.x = (unsigned)a0 | ((unsigned)a1 << 16); w.y = (unsigned)a2 | ((unsigned)a3 << 16); w.z = (unsigned)a4 | ((unsigned)a5 << 16); w.w = (unsigned)a6 | ((unsigned)a7 << 16); return w;
}
__device__ __forceinline__ void ph_hgL(const Ctx& c) {
    const bf16* ZH = WSP(bf16, WS_XB); const float* lb = WSP(float, WS_LB); float* KV = WSP(float, WS_KV); float* DEC = WSP(float, WS_HGDEC);
    LAS bf16* VT = (LAS bf16*)c.lds; LAS bf16* KT = VT + 128 * 72; LAS float* SS = (LAS float*)(KT + 128 * 72); LAS bf16* ST = (LAS bf16*)(c.lds + 65536);
    const int d = c.tid & 127, seg = c.tid >> 7, r = c.lane & 31, hh = c.lane >> 5, w = c.wave;
    unsigned short fl[16], vv[16];
    LAS unsigned char* ZW = c.lds + 107520 + w * 4096;
    const int zr = c.lane >> 3, zp = c.lane & 7;
#define HGL_DMA(U) do { const int _c = (U) & 127, _bh = (U) >> 7; const bf16* _z = ZH + ((size_t)_bh * SEQ + _c * 64 + 16 * seg + zr) * 128 + 64 * (w & 1) + zp * 8; \
        _Pragma("unroll") for (int _a = 0; _a < 2; ++_a) _Pragma("unroll") for (int _hr = 0; _hr < 2; ++_hr) \
            __builtin_amdgcn_global_load_lds((const unsigned*)(_z + (size_t)(_a ? 2 : 1) * ZH_AS + (8 * _hr) * 128), (LAS unsigned*)(ZW + _a * 2048 + _hr * 1024), 16, 0, 0); } while (0)
#define HGL_COLS() do { asm volatile("s_waitcnt vmcnt(0)" ::: "memory"); _Pragma("unroll") for (int i = 0; i < 16; ++i) { fl[i] = *(const LAS unsigned short*)(ZW + i * 128 + c.lane * 2); vv[i] = *(const LAS unsigned short*)(ZW + 2048 + i * 128 + c.lane * 2); } \
        asm volatile("s_waitcnt lgkmcnt(0)" ::: "memory"); } while (0)
    if (c.bid < 2048) { HGL_DMA(c.bid); HGL_COLS(); }
    for (int u = c.bid; u < 2048; u += c.G) {
        const int bh = u >> 7, h = bh & 7;
        if (u + c.G < 2048) HGL_DMA(u + c.G);
        const float lbv = lb[h * 128 + d];
        float cs[16], kk[16]; float run = 0.f;
#pragma unroll
        for (int i = 0; i < 16; ++i) { const float f = lbv + (1.0f - lbv) * sigmoidf_(bf2f(fl[i])); kk[i] = 1.0f - f; run += __builtin_amdgcn_logf(f); cs[i] = run; }
        SS[seg * 128 + d] = run;
        __syncthreads();
        const float s0 = SS[d], s1 = SS[128 + d], s2 = SS[256 + d], s3 = SS[384 + d];
        const float prefix = (seg > 0 ? s0 : 0.f) + (seg > 1 ? s1 : 0.f) + (seg > 2 ? s2 : 0.f), total = (s0 + s1) + (s2 + s3);
        float kd[16];
#pragma unroll
        for (int i = 0; i < 16; ++i) kd[i] = kk[i] * __builtin_amdgcn_exp2f(total - prefix - cs[i]);
        { float f0[8], f1[8];
#pragma unroll
          for (int i = 0; i < 8; ++i) { f0[i] = kd[i]; f1[i] = kd[8 + i]; }
          *(LAS u32x4*)(KT + d * 72 + 16 * seg) = pack8(f0); *(LAS u32x4*)(KT + d * 72 + 16 * seg + 8) = pack8(f1);
          *(LAS u32x4*)(VT + d * 72 + 16 * seg) = pk8us(vv[0], vv[1], vv[2], vv[3], vv[4], vv[5], vv[6], vv[7]);
          *(LAS u32x4*)(VT + d * 72 + 16 * seg + 8) = pk8us(vv[8], vv[9], vv[10], vv[11], vv[12], vv[13], vv[14], vv[15]); }
        if (seg == 0) DEC[(size_t)u * 128 + d] = __builtin_amdgcn_exp2f(total);
        __syncthreads();
        const int vdt = w >> 1, kdt0 = (w & 1) * 2;
        f32x16 acc0, acc1;
#pragma unroll
        for (int i = 0; i < 16; ++i) { acc0[i] = 0.f; acc1[i] = 0.f; }
#pragma unroll
        for (int ks = 0; ks < 4; ++ks) {
            const bf16x8 a = *(const LAS bf16x8*)(VT + (32 * vdt + r) * 72 + 16 * ks + 8 * hh);
            const bf16x8 b0 = *(const LAS bf16x8*)(KT + (32 * kdt0 + r) * 72 + 16 * ks + 8 * hh), b1 = *(const LAS bf16x8*)(KT + (32 * (kdt0 + 1) + r) * 72 + 16 * ks + 8 * hh);
            acc0 = __builtin_amdgcn_mfma_f32_32x32x16_bf16(a, b0, acc0, 0, 0, 0); acc1 = __builtin_amdgcn_mfma_f32_32x32x16_bf16(a, b1, acc1, 0, 0, 0);
        }
        bf16* kvp = (bf16*)KV + (size_t)u * 16384;
#pragma unroll
        for (int i = 0; i < 16; ++i) { const int vd = 32 * vdt + (i & 3) + 8 * (i >> 2) + 4 * hh; ST[vd * 136 + 32 * kdt0 + r] = f2bf(acc0[i]); ST[vd * 136 + 32 * (kdt0 + 1) + r] = f2bf(acc1[i]); }
        __syncthreads();
        if (u + c.G < 2048) HGL_COLS();
#pragma unroll
        for (int p = 0; p < 4; ++p) { const int vd = p * 32 + (c.tid >> 4), k0 = (c.tid & 15) * 8;
            *(u32x4*)(kvp + vd * 128 + k0) = *(const LAS u32x4*)(ST + vd * 136 + k0); }
    }
}
#undef HGL_DMA
#undef HGL_COLS
__device__ __forceinline__ void ph_hgS(const Ctx& c) {
    const float* KV = WSP(float, WS_KV); const float* DEC = WSP(float, WS_HGDEC); bf16* SIN = WSP(bf16, WS_SIN);
    const int gtid = c.bid * NTHR + c.tid, gn = c.G * NTHR;
    for (int i = gtid; i < 16 * 8192; i += gn) {
        const int bh = i >> 13, e2 = i & 8191, vd = e2 >> 6, kd = (e2 & 63) * 2;
        float sa = 0.f, sb = 0.f;
        for (int c0 = 0; c0 < 128; c0 += 16) {
            f32x2 kv[16], dc[16];
#pragma unroll
            for (int j = 0; j < 16; ++j) { const unsigned wv = *(const unsigned*)((const bf16*)KV + (size_t)(bh * 128 + c0 + j) * 16384 + vd * 128 + kd); kv[j][0] = __uint_as_float(wv << 16); kv[j][1] = __uint_as_float(wv & 0xffff0000u);
                dc[j] = *(const f32x2*)(DEC + (size_t)(bh * 128 + c0 + j) * 128 + kd); }
#pragma unroll
            for (int j = 0; j < 16; ++j) { *(unsigned*)(SIN + (size_t)(bh * 128 + c0 + j) * 16384 + vd * 128 + kd) = pk2(sa, sb); sa = dc[j][0] * sa + kv[j][0]; sb = dc[j][1] * sb + kv[j][1]; }
        }
    }
}
__device__ __forceinline__ void ph_hgO(const Ctx& c) {
    const bf16* ZH = WSP(bf16, WS_XB); bf16* Y = WSP(bf16, WS_YCAT); const float* lb = WSP(float, WS_LB); const bf16* SIN = WSP(bf16, WS_SIN); const float* ng = c.in[7];
    LAS bf16* QB = (LAS bf16*)c.lds; LAS bf16* QS = QB + 64 * 136; LAS bf16* KS = QS + 64 * 136; LAS bf16* VT = KS + 64 * 136;
    LAS float* SS = (LAS float*)(c.lds + MISC_OFF + 1024); LAS float* RS = SS + 512; LAS float* OT = (LAS float*)(VT + 128 * 72);
    const int d = c.tid & 127, seg = c.tid >> 7, r = c.lane & 31, hh = c.lane >> 5, w = c.wave, vdt = w & 3, tt = w >> 2;
    bf16x8 sfr[8]; unsigned short fl[16], qq[16], vv[16]; u32x4 gn0, gn1;
    const int ot = c.tid >> 3, ovd0 = (c.tid & 7) * 8;
    LAS unsigned char* ZW = c.lds + 104448 + w * 6144;
    const int zr = c.lane >> 3, zp = c.lane & 7;
#define HGO_DMA(U) do { const int _c = (U) & 127, _bh = (U) >> 7; const bf16* _z = ZH + ((size_t)_bh * SEQ + _c * 64 + 16 * seg + zr) * 128 + 64 * (w & 1) + zp * 8; \
        _Pragma("unroll") for (int _a = 0; _a < 3; ++_a) _Pragma("unroll") for (int _hr = 0; _hr < 2; ++_hr) \
            __builtin_amdgcn_global_load_lds((const unsigned*)(_z + (size_t)(_a == 0 ? 1 : _a == 1 ? 0 : 2) * ZH_AS + (8 * _hr) * 128), (LAS unsigned*)(ZW + _a * 2048 + _hr * 1024), 16, 0, 0); } while (0)
#define HGO_LOAD_G(U) do { const int _c = (U) & 127, _bh = (U) >> 7; \
        const bf16* _gp = ZH + 3 * ZH_AS + ((size_t)_bh * SEQ + _c * 64 + ot) * 128 + ovd0; gn0 = *(const u32x4*)_gp; gn1 = *(const u32x4*)(_gp + 64); } while (0)
#define HGO_COLS(NW) do { asm volatile("s_waitcnt vmcnt(" #NW ")" ::: "memory"); _Pragma("unroll") for (int i = 0; i < 16; ++i) { fl[i] = *(const LAS unsigned short*)(ZW + i * 128 + c.lane * 2); \
        qq[i] = *(const LAS unsigned short*)(ZW + 2048 + i * 128 + c.lane * 2); vv[i] = *(const LAS unsigned short*)(ZW + 4096 + i * 128 + c.lane * 2); } asm volatile("s_waitcnt lgkmcnt(0)" ::: "memory"); } while (0)
#define HGO_LOAD_S(U) do { const bf16* _sp = SIN + (size_t)(U) * 16384 + (32 * vdt + r) * 128 + 8 * hh; _Pragma("unroll") for (int k8 = 0; k8 < 8; ++k8) sfr[k8] = *(const bf16x8*)(_sp + 16 * k8); } while (0)
    if (c.bid < 2048) { HGO_DMA(c.bid); HGO_LOAD_G(c.bid); HGO_LOAD_S(c.bid); HGO_COLS(0); }
    for (int u = c.bid; u < 2048; u += c.G) {
        const int chunk = u & 127, bh = u >> 7, h = bh & 7, b = bh >> 3; const int t0 = b * SEQ + chunk * 64;
        const u32x4 gc0 = gn0, gc1 = gn1;
        if (u + c.G < 2048) { HGO_DMA(u + c.G); HGO_LOAD_G(u + c.G); }
        const float lbv = lb[h * 128 + d];
        float cs[16], kk[16]; float run = 0.f;
#pragma unroll
        for (int i = 0; i < 16; ++i) { const float f = lbv + (1.0f - lbv) * sigmoidf_(bf2f(fl[i])); kk[i] = 1.0f - f; run += __builtin_amdgcn_logf(f); cs[i] = run; }
        SS[seg * 128 + d] = run;
        __syncthreads();
        { const float s0 = SS[d], s1 = SS[128 + d], s2 = SS[256 + d];
          const float prefix = (seg > 0 ? s0 : 0.f) + (seg > 1 ? s1 : 0.f) + (seg > 2 ? s2 : 0.f), ref = s0 + s1;
#pragma unroll
          for (int i = 0; i < 16; ++i) { const float bb = prefix + cs[i], q = bf2f(qq[i]); const int t = 16 * seg + i;
              QB[t * 136 + d] = f2bf(q * __builtin_amdgcn_exp2f(bb)); QS[t * 136 + d] = f2bf(q * __builtin_amdgcn_exp2f(bb - ref)); KS[t * 136 + d] = f2bf(kk[i] * __builtin_amdgcn_exp2f(ref - bb)); }
          *(LAS u32x4*)(VT + d * 72 + 16 * seg) = pk8us(vv[0], vv[1], vv[2], vv[3], vv[8], vv[9], vv[10], vv[11]);
          *(LAS u32x4*)(VT + d * 72 + 16 * seg + 8) = pk8us(vv[4], vv[5], vv[6], vv[7], vv[12], vv[13], vv[14], vv[15]); }
        __syncthreads();
        f32x16 acc;
#pragma unroll
        for (int i = 0; i < 16; ++i) acc[i] = 0.f;
#pragma unroll
        for (int k8 = 0; k8 < 8; ++k8) { const bf16x8 bq = *(const LAS bf16x8*)(QB + (32 * tt + r) * 136 + 16 * k8 + 8 * hh); acc = __builtin_amdgcn_mfma_f32_32x32x16_bf16(sfr[k8], bq, acc, 0, 0, 0); }
        if (u + c.G < 2048) HGO_LOAD_S(u + c.G);
        for (int st = 0; st <= tt; ++st) {
            f32x16 x;
#pragma unroll
            for (int i = 0; i < 16; ++i) x[i] = 0.f;
#pragma unroll
            for (int k8 = 0; k8 < 8; ++k8) { const bf16x8 ak = *(const LAS bf16x8*)(KS + (32 * st + r) * 136 + 16 * k8 + 8 * hh), bq = *(const LAS bf16x8*)(QS + (32 * tt + r) * 136 + 16 * k8 + 8 * hh);
                x = __builtin_amdgcn_mfma_f32_32x32x16_bf16(ak, bq, x, 0, 0, 0); }
            if (st == tt) {
#pragma unroll
                for (int i = 0; i < 16; ++i) { const int row = (i & 3) + 8 * (i >> 2) + 4 * hh; if (row > r) x[i] = 0.f; }
            }
#pragma unroll
            for (int sp = 0; sp < 2; ++sp) {
                u32x4 pw; pw.x = pk2(x[8 * sp], x[8 * sp + 1]); pw.y = pk2(x[8 * sp + 2], x[8 * sp + 3]); pw.z = pk2(x[8 * sp + 4], x[8 * sp + 5]); pw.w = pk2(x[8 * sp + 6], x[8 * sp + 7]);
                const bf16x8 pf = __builtin_bit_cast(bf16x8, pw);
                const bf16x8 av = *(const LAS bf16x8*)(VT + (32 * vdt + r) * 72 + 32 * st + 16 * sp + 8 * hh);
                acc = __builtin_amdgcn_mfma_f32_32x32x16_bf16(av, pf, acc, 0, 0, 0);
            }
        }
        { float ss = 0.f;
#pragma unroll
          for (int i = 0; i < 16; ++i) ss += acc[i] * acc[i];
          ss += __shfl_xor(ss, 32);
          if (hh == 0) RS[(tt * 4 + vdt) * 32 + r] = ss;
#pragma unroll
          for (int i4 = 0; i4 < 4; ++i4) *(LAS f32x4*)(OT + (32 * tt + r) * 132 + 32 * vdt + 8 * i4 + 4 * hh) = (f32x4){acc[4 * i4], acc[4 * i4 + 1], acc[4 * i4 + 2], acc[4 * i4 + 3]}; }
        __syncthreads();
        if (u + c.G < 2048) HGO_COLS(8);
        { const int t = ot, vd0 = ovd0;
          const float ssum = (RS[((t >> 5) * 4 + 0) * 32 + (t & 31)] + RS[((t >> 5) * 4 + 1) * 32 + (t & 31)]) + (RS[((t >> 5) * 4 + 2) * 32 + (t & 31)] + RS[((t >> 5) * 4 + 3) * 32 + (t & 31)]);
          const float rr = rsqrtf(ssum * (1.0f / 128.0f) + EPS);
#pragma unroll
          for (int hf = 0; hf < 2; ++hf) { float g[8], o[8]; unpack8(hf ? gc1 : gc0, g);
              const f32x4 oa = *(const LAS f32x4*)(OT + t * 132 + vd0 + 64 * hf), ob = *(const LAS f32x4*)(OT + t * 132 + vd0 + 64 * hf + 4);
#pragma unroll
              for (int j = 0; j < 4; ++j) { o[j] = oa[j] * rr * ng[vd0 + 64 * hf + j] * siluf_(g[j]); o[4 + j] = ob[j] * rr * ng[vd0 + 64 * hf + 4 + j] * siluf_(g[4 + j]); }
              *(u32x4*)(Y + (size_t)(t0 + t) * D_ + 1024 + h * 128 + vd0 + 64 * hf) = pack8(o); } }
    }
}

#undef HGO_DMA
#undef HGO_LOAD_G
#undef HGO_COLS
#undef HGO_LOAD_S
struct EpiRes {
    const float* R; float* O; bf16* HBo; const float* g;
    __device__ __forceinline__ void operator()(const f32x4 (&acc)[2][2][4][2], const pg::Unit& u, int wr, int wc, int fr, int fq) const {
        const int colb = u.pn * 256 + wc * 32 + 8 * fq;
        f32x4 gv[2][2];
#pragma unroll
        for (int bj = 0; bj < 2; ++bj)
#pragma unroll
            for (int n = 0; n < 2; ++n) gv[bj][n] = *(const f32x4*)(g + colb + bj * 128 + n * 4);
#pragma unroll
        for (int ai = 0; ai < 2; ++ai)
#pragma unroll
            for (int m = 0; m < 4; ++m) { const int row = u.pm * 256 + ai * 128 + wr * 64 + m * 16 + fr; const size_t off = (size_t)row * D_ + colb;
#pragma unroll
                for (int bj = 0; bj < 2; ++bj) { f32x4 o[2];
#pragma unroll
                    for (int n = 0; n < 2; ++n) { const f32x4 r = *(const f32x4*)(R + off + bj * 128 + n * 4); o[n] = r + acc[ai][bj][m][n]; *(f32x4*)(O + off + bj * 128 + n * 4) = o[n]; }
                    u32x4 w; w.x = pk2(o[0][0] * gv[bj][0][0], o[0][1] * gv[bj][0][1]); w.y = pk2(o[0][2] * gv[bj][0][2], o[0][3] * gv[bj][0][3]);
                    w.z = pk2(o[1][0] * gv[bj][1][0], o[1][1] * gv[bj][1][1]); w.w = pk2(o[1][2] * gv[bj][1][2], o[1][3] * gv[bj][1][3]);
                    *(u32x4*)(HBo + off + bj * 128) = w; } }
    }
};
__device__ __forceinline__ void ph_outproj(const Ctx& c) {
    if (NAIVE_GEMM & 2) {
        const bf16* A = WSP(bf16, WS_YCAT); const float* X = c.in[0]; float* O = WSP(float, WS_XA); bf16* HBn = WSP(bf16, WS_HB); const float* gn = c.in[2];
        naive_gemm<false>(c, T_, 2048, 2048, [=](int r) { return A + (size_t)r * 2048; }, c.in[8], nullptr, 2048, [=](int r, int col, float a, float) { const float o = X[(size_t)r * 2048 + col] + a; O[(size_t)r * 2048 + col] = o; HBn[(size_t)r * 2048 + col] = f2bf(o * gn[col]); });
    } else {
        pg::DenseSched S; S.init(WSP(bf16, WS_YCAT), WSP(bf16, WS_WOUT), T_, 2048, 2048, c.G, c.bid);
        EpiRes E{c.in[0], WSP(float, WS_XA), WSP(bf16, WS_HB), c.in[2]};
        pg::gemm_phase_w(c.lds, S, E, c.wave);
    }
}

template <int LAYER, bool DRY = false>
__device__ __forceinline__ void ph_router(const Ctx& c, const float* __restrict__ X) {
    constexpr int WST = 264, WBUF = 2 * 48 * WST;
    LAS bf16* WL = (LAS bf16*)c.lds;
    LAS float* P = (LAS float*)c.lds;
    LAS float* SSQ = P + 8 * 16 * 48;
    LAS float* LG = SSQ + 128;
    LAS float* RS = LG + 64 * 48;
    LAS int* DE = (LAS int*)(RS + 64); LAS int* DV = DE + 128; LAS int* LC = DV + 128; LAS int* LB = LC + 32; LAS float* DG = (LAS float*)(LB + 32);
    const bf16* WRS = WSP(bf16, WS_WR) + (size_t)LAYER * 48 * 2 * 2048;
    const float* bc = c.in[19] + LAYER * 4; const float* bfi = c.in[21] + LAYER * 32;
    int* rowl = WSP(int, WS_ROWL) + (size_t)LAYER * NE * CAP; float* tokg = WSP(float, WS_TOKG) + (size_t)LAYER * 2 * T_; float* tokr = WSP(float, WS_TOKR) + (size_t)LAYER * T_; u32x4* rowl16 = WSP(u32x4, WS_ROWL16) + (size_t)LAYER * NE * CAP;
    unsigned* cnt = WSP(unsigned, WS_CTL) + CW_CNT + LAYER * 32;
    const int tok = c.lane & 15, kq = c.lane >> 4, w = c.wave, tg = w & 3, kh = w >> 2;
#define RT_WSRC(idx, cc) (WRS + ((size_t)((((idx) % 1536) >> 5) * 2 + ((((idx) % 1536) & 31) >> 4)) * 2048) + 1024 * ((idx) / 1536) + 128 * (cc) + 8 * ((idx) & 15))
#define RT_WDST(idx, buf) (WL + (buf) * WBUF + (((idx) / 1536) * 48 + (((idx) % 1536) >> 5)) * WST + ((((idx) % 1536) & 31) >> 4) * 128 + 8 * ((idx) & 15))
    for (int pass = c.bid; pass < T_ / 64; pass += c.G) {
        const int t0 = pass * 64;
        const float* xr = X + (size_t)(t0 + 16 * tg + tok) * D_ + 1024 * kh + 8 * kq;
        u32x4 wst[6];
#pragma unroll
        for (int i = 0; i < 6; ++i) wst[i] = *(const u32x4*)RT_WSRC(c.tid + i * 512, 0);
#pragma unroll
        for (int i = 0; i < 6; ++i) *(LAS u32x4*)RT_WDST(c.tid + i * 512, 0) = wst[i];
        f32x4 xn[8];
#pragma unroll
        for (int i = 0; i < 4; ++i) { xn[2 * i] = *(const f32x4*)(xr + 32 * i); xn[2 * i + 1] = *(const f32x4*)(xr + 32 * i + 4); }
        __syncthreads();
        f32x4 acc[3]; acc[0] = acc[1] = acc[2] = (f32x4){0.f, 0.f, 0.f, 0.f};
        float ss = 0.f;
        for (int cc = 0; cc < 8; ++cc) {
            f32x4 xc[8];
#pragma unroll
            for (int i = 0; i < 8; ++i) xc[i] = xn[i];
            if (cc < 7) {
#pragma unroll
                for (int i = 0; i < 6; ++i) wst[i] = *(const u32x4*)RT_WSRC(c.tid + i * 512, cc + 1);
#pragma unroll
                for (int i = 0; i < 4; ++i) { xn[2 * i] = *(const f32x4*)(xr + 128 * (cc + 1) + 32 * i); xn[2 * i + 1] = *(const f32x4*)(xr + 128 * (cc + 1) + 32 * i + 4); }
            }
            const LAS bf16* wb = WL + (cc & 1) * WBUF + (kh * 48 + tok) * WST + 8 * kq;
#pragma unroll
            for (int i = 0; i < 4; ++i) {
                const f32x4 xa = xc[2 * i], xb = xc[2 * i + 1];
                u32x4 hw; hw.x = pk2(xa[0], xa[1]); hw.y = pk2(xa[2], xa[3]); hw.z = pk2(xb[0], xb[1]); hw.w = pk2(xb[2], xb[3]);
                u32x4 lw;
                lw.x = pk2(xa[0] - __uint_as_float(hw.x << 16), xa[1] - __uint_as_float(hw.x & 0xffff0000u)); lw.y = pk2(xa[2] - __uint_as_float(hw.y << 16), xa[3] - __uint_as_float(hw.y & 0xffff0000u));
                lw.z = pk2(xb[0] - __uint_as_float(hw.z << 16), xb[1] - __uint_as_float(hw.z & 0xffff0000u)); lw.w = pk2(xb[2] - __uint_as_float(hw.w << 16), xb[3] - __uint_as_float(hw.w & 0xffff0000u));
                const bf16x8 ahi = __builtin_bit_cast(bf16x8, hw), alo = __builtin_bit_cast(bf16x8, lw);
#pragma unroll
                for (int j = 0; j < 4; ++j) ss += xa[j] * xa[j] + xb[j] * xb[j];
#pragma unroll
                for (int nt = 0; nt < 3; ++nt) {
                    const bf16x8 bhi = *(const LAS bf16x8*)(wb + nt * 16 * WST + 32 * i), blo = *(const LAS bf16x8*)(wb + nt * 16 * WST + 128 + 32 * i);
                    acc[nt] = __builtin_amdgcn_mfma_f32_16x16x32_bf16(ahi, bhi, acc[nt], 0, 0, 0);
                    acc[nt] = __builtin_amdgcn_mfma_f32_16x16x32_bf16(ahi, blo, acc[nt], 0, 0, 0);
                    acc[nt] = __builtin_amdgcn_mfma_f32_16x16x32_bf16(alo, bhi, acc[nt], 0, 0, 0);
                }
            }
            if (cc < 7) {
#pragma unroll
                for (int i = 0; i < 6; ++i) *(LAS u32x4*)RT_WDST(c.tid + i * 512, (cc + 1) & 1) = wst[i];
            }
            __syncthreads();
        }
        ss += __shfl_xor(ss, 16); ss += __shfl_xor(ss, 32);
#pragma unroll
        for (int nt = 0; nt < 3; ++nt)
#pragma unroll
            for (int r = 0; r < 4; ++r) P[(w * 16 + 4 * kq + r) * 48 + 16 * nt + tok] = acc[nt][r];
        if (kq == 0) SSQ[w * 16 + tok] = ss;
        __syncthreads();
        for (int i = c.tid; i < 64 * 48; i += 512) { const int tk = i / 48, n = i % 48, g4 = tk >> 4, tl = tk & 15; LG[i] = P[(g4 * 16 + tl) * 48 + n] + P[((g4 + 4) * 16 + tl) * 48 + n]; }
        if (c.tid < 64) { const int g4 = c.tid >> 4, tl = c.tid & 15; RS[c.tid] = rsqrtf((SSQ[g4 * 16 + tl] + SSQ[(g4 + 4) * 16 + tl]) * (1.0f / 2048.0f) + EPS); }
        __syncthreads();
        if (c.tid < 64) {
            const int t = t0 + c.tid; const float rr = RS[c.tid];
            float lc[4]; int grp = 0; float mx = -3.0e38f;
#pragma unroll
            for (int i = 0; i < 4; ++i) { lc[i] = rr * LG[c.tid * 48 + i] + bc[i]; if (lc[i] > mx) { mx = lc[i]; grp = i; } }
            float den = 0.f;
#pragma unroll
            for (int i = 0; i < 4; ++i) den += expf(lc[i] - mx);
            const float ptop = 1.0f / den;
            float fv[8]; int i0 = 0; float v0 = -3.0e38f;
#pragma unroll
            for (int i = 0; i < 8; ++i) { fv[i] = rr * LG[c.tid * 48 + 4 + grp * 8 + i] + bfi[grp * 8 + i]; if (fv[i] > v0) { v0 = fv[i]; i0 = i; } }
            int i1 = 0; float v1 = -3.0e38f;
#pragma unroll
            for (int i = 0; i < 8; ++i) if (i != i0 && fv[i] > v1) { v1 = fv[i]; i1 = i; }
            const float e1 = expf(v1 - v0); const float w0 = 1.0f / (1.0f + e1), w1 = e1 / (1.0f + e1);
            DE[2 * c.tid] = grp * 8 + i0; DV[2 * c.tid] = 2 * t; DE[2 * c.tid + 1] = grp * 8 + i1; DV[2 * c.tid + 1] = 2 * t + 1;
            DG[2 * c.tid] = ptop * w0; DG[2 * c.tid + 1] = ptop * w1;
            if (!DRY) { tokg[2 * t] = ptop * w0; tokg[2 * t + 1] = ptop * w1; tokr[t] = rr; }
        }
        if (c.tid < 32) LC[c.tid] = 0;
        __syncthreads();
        int rank0 = 0;
        if (c.tid < 128) rank0 = __hip_atomic_fetch_add(&LC[DE[c.tid]], 1, __ATOMIC_RELAXED, __HIP_MEMORY_SCOPE_WORKGROUP);
        __syncthreads();
        if (!DRY && c.tid < 32) { const int n = LC[c.tid]; LB[c.tid] = n ? (int)atomicAdd(&cnt[c.tid], (unsigned)n) : 0; }
        __syncthreads();
        if (!DRY && c.tid < 128) { const int e = DE[c.tid]; const size_t pos = (size_t)e * CAP + LB[e] + rank0; rowl[pos] = DV[c.tid];
            rowl16[pos] = (u32x4){(unsigned)DV[c.tid], __float_as_uint(DG[c.tid]), __float_as_uint(RS[c.tid >> 1]), 0u}; }
        __syncthreads();
    }
}

#undef RT_WSRC
#undef RT_WDST
struct MoeTab { const LAS int* tile0; const LAS int* cnt; const LAS unsigned char* tileExp; int ntiles; };
__device__ __forceinline__ MoeTab moe_tables(const Ctx& c, int layer) {
    LAS int* tile0 = (LAS int*)(c.lds + MISC_OFF + 64); LAS int* cn = (LAS int*)(c.lds + MISC_OFF + 256); LAS unsigned char* te = (LAS unsigned char*)(c.lds + MISC_OFF + 512);
    const unsigned* cnt = WSP(unsigned, WS_CTL) + CW_CNT + layer * 32;
    __syncthreads();
    if (c.tid < 64) {
        const int e = c.tid & 31; const int ce = (int)__hip_atomic_load(cnt + e, __ATOMIC_RELAXED, __HIP_MEMORY_SCOPE_AGENT); const int nt = (ce + 255) >> 8;
        int incl = nt;
#pragma unroll
        for (int o = 1; o < 32; o <<= 1) { const int v = __shfl_up(incl, o, 32); if (e >= o) incl += v; }
        if (c.tid < 32) { const int start = incl - nt; cn[e] = ce; tile0[e] = start; for (int j = 0; j < nt; ++j) te[start + j] = (unsigned char)e; if (e == 31) tile0[NE] = incl; }
    }
    __syncthreads();
    MoeTab t; t.tile0 = tile0; t.cnt = cn; t.tileExp = te; t.ntiles = tile0[NE]; return t;
}
struct EpiGU {
    bf16* H; const LAS unsigned char* lds;
    __device__ __forceinline__ void operator()(const f32x4 (&acc)[2][2][4][2], const pg::Unit& u, int wr, int wc, int fr, int fq) const {
        const LAS u32x4* lst = (const LAS u32x4*)(lds + LIST_OFF + u.lbuf * 4096);
#pragma unroll
        for (int ai = 0; ai < 2; ++ai)
#pragma unroll
            for (int m = 0; m < 4; ++m) { const int r = ai * 128 + wr * 64 + m * 16 + fr; const int slot = u.pm * 256 + r;
                const float rs = r < u.nvalid ? *(const LAS float*)((const LAS unsigned char*)lst + r * 16 + 8) : 0.f;
                u32x4 w = (u32x4){0u, 0u, 0u, 0u};
                if (r < u.nvalid) { float f[8];
#pragma unroll
                    for (int n = 0; n < 2; ++n)
#pragma unroll
                        for (int j = 0; j < 4; ++j) { const float a = rs * acc[ai][0][m][n][j]; f[n * 4 + j] = a * (rs * acc[ai][1][m][n][j]) * __builtin_amdgcn_rcpf(1.0f + __builtin_amdgcn_exp2f(-1.4426950408889634f * a)); }
                    w = pack8(f); }
                *(u32x4*)(H + (size_t)slot * FF + u.pn * 128 + wc * 32 + 8 * fq) = w; }
    }
};
struct EpiDown {
    bf16* Y; const LAS unsigned char* lds;
    __device__ __forceinline__ void operator()(const f32x4 (&acc)[2][2][4][2], const pg::Unit& u, int wr, int wc, int fr, int fq) const {
        const LAS u32x4* lst = (const LAS u32x4*)(lds + LIST_OFF + u.lbuf * 4096);
#pragma unroll
        for (int ai = 0; ai < 2; ++ai)
#pragma unroll
            for (int m = 0; m < 4; ++m) { const int r = ai * 128 + wr * 64 + m * 16 + fr;
                if (r < u.nvalid) { const u32x2 en = *(const LAS u32x2*)((const LAS unsigned char*)lst + r * 16); const int v = (int)en.x; const float g = __uint_as_float(en.y); bf16* rp = Y + (size_t)v * D_ + u.pn * 256 + wc * 32 + 8 * fq;
#pragma unroll
                    for (int bj = 0; bj < 2; ++bj) { float f[8];
#pragma unroll
                        for (int n = 0; n < 2; ++n)
#pragma unroll
                            for (int j = 0; j < 4; ++j) f[n * 4 + j] = g * acc[ai][bj][m][n][j];
                        *(u32x4*)(rp + bj * 128) = pack8(f); } } }
    }
};
template <int LAYER>
__device__ __forceinline__ void ph_moe_gu(const Ctx& c) {
    const MoeTab tb = moe_tables(c, LAYER);
    const int* rowl = WSP(int, WS_ROWL) + (size_t)LAYER * NE * CAP;
    if (NAIVE_GEMM & 4) {
        const bf16* hb = WSP(bf16, WS_HB); bf16* H = WSP(bf16, WS_HID); const float* tokr = WSP(float, WS_TOKR) + (size_t)LAYER * T_;
        for (int rt = 0; rt < tb.ntiles; ++rt) {
            const int e = tb.tileExp[rt], lt = rt - tb.tile0[e], nv = tb.cnt[e] - lt * 256; const int M = nv < 256 ? nv : 256;
            const float* Wg = c.in[22] + ((size_t)LAYER * 32 + e) * 2048 * 1024; const float* Wu = c.in[23] + ((size_t)LAYER * 32 + e) * 2048 * 1024;
            naive_gemm<true>(c, M, 1024, 2048, [=](int r) { return hb + (size_t)(rowl[(size_t)e * CAP + lt * 256 + r] >> 1) * 2048; }, Wg, Wu, 1024,
                             [=](int r, int col, float a, float b) { const float rs = tokr[rowl[(size_t)e * CAP + lt * 256 + r] >> 1]; H[(size_t)(rt * 256 + r) * FF + col] = f2bf(siluf_(rs * a) * (rs * b)); });
        }
    } else {
        pg::MoeSched<true> S; S.A = (const char*)WSP(bf16, WS_HB); S.B = (const char*)(WSP(bf16, WS_WGU) + (size_t)LAYER * 32 * 2048 * 2048); S.nt1 = 32; S.nt2 = 0; S.i0 = 0; S.i1 = 1 << 20; S.nN = 8; S.nwg = tb.ntiles * 8; S.G = c.G; S.c = c.bid;
        S.pitchA = 4096; S.pitchB = 128; S.usB = 256u * 4096u; S.hA = 128 * 4096; S.hA2 = 0; S.hB2 = 0; S.A2 = S.A; S.B2 = S.B; S.expStrideB = 2048u * 2048u * 2u; S.tile0 = tb.tile0; S.cnt = tb.cnt; S.tileExp = tb.tileExp; S.rowl = rowl;
        S.rowl16 = WSP(u32x4, WS_ROWL16) + (size_t)LAYER * NE * CAP;
        EpiGU E{WSP(bf16, WS_HID), c.lds};
        if (CONV_IN_GEMM) {
            const int slot = (c.bid >> 3) % 4; S.i1 = slot + 1; pg::gemm_phase_w(c.lds, S, E, c.wave);
            conv_slice_moe(c, CVO_DN + LAYER * (CV_DN / 2), CV_DN / 2, S.nwg, 12);
            S.i0 = slot + 1; S.i1 = 1 << 20; pg::gemm_phase_w(c.lds, S, E, c.wave); }
        else pg::gemm_phase_w(c.lds, S, E, c.wave);
    }
}
template <int LAYER>
__device__ __forceinline__ void ph_moe_down(const Ctx& c) {
    const MoeTab tb = moe_tables(c, LAYER);
    const int* rowl = WSP(int, WS_ROWL) + (size_t)LAYER * NE * CAP; const float* tokg = WSP(float, WS_TOKG) + (size_t)LAYER * 2 * T_;
    bf16* Y = WSP(bf16, WS_KV);
    if (NAIVE_GEMM & 8) {
        const bf16* H = WSP(bf16, WS_HID);
        for (int rt = 0; rt < tb.ntiles; ++rt) {
            const int e = tb.tileExp[rt], lt = rt - tb.tile0[e], nv = tb.cnt[e] - lt * 256; const int M = nv < 256 ? nv : 256;
            const float* Wd = c.in[24] + ((size_t)LAYER * 32 + e) * 1024 * 2048;
            naive_gemm<false>(c, M, 2048, 1024, [=](int r) { return H + (size_t)(rt * 256 + r) * FF; }, Wd, nullptr, 2048,
                              [=](int r, int col, float a, float) { const int v = rowl[(size_t)e * CAP + lt * 256 + r]; Y[(size_t)v * D_ + col] = f2bf(tokg[v] * a); });
        }
    } else {
        pg::MoeSched<false> S; S.A = (const char*)WSP(bf16, WS_HID); S.B = (const char*)(WSP(bf16, WS_WD) + (size_t)LAYER * 32 * 2048 * 1024); S.nt1 = 16; S.nt2 = 0; S.i0 = 0; S.i1 = 1 << 20; S.nN = 8; S.nwg = tb.ntiles * 8; S.G = c.G; S.c = c.bid;
        S.pitchA = 2048; S.pitchB = 128; S.usB = 256u * 2048u; S.hA = 128 * 2048; S.hA2 = 0; S.hB2 = 0; S.A2 = S.A; S.B2 = S.B; S.expStrideB = 2048u * 1024u * 2u; S.tile0 = tb.tile0; S.cnt = tb.cnt; S.tileExp = tb.tileExp; S.rowl = rowl;
        S.rowl16 = WSP(u32x4, WS_ROWL16) + (size_t)LAYER * NE * CAP;
        EpiDown E{Y, c.lds};
        if (CONV_IN_GEMM && LAYER == 0) {
            const int slot = (c.bid >> 3) % 4; S.i1 = slot + 1; pg::gemm_phase_w(c.lds, S, E, c.wave);
            conv_slice_moe(c, CVO_GU + CV_GU / 2, CV_GU1_SPLIT * 256, S.nwg, 7);
            S.i0 = slot + 1; S.i1 = 1 << 20; pg::gemm_phase_w(c.lds, S, E, c.wave); }
        else pg::gemm_phase_w(c.lds, S, E, c.wave);
    }
}

template <bool U2L>
__device__ __forceinline__ void ph_res_norm(const Ctx& c, const float* __restrict__ Xin, float* __restrict__ Xout, const float* __restrict__ g, bf16* __restrict__ U) {
    const bf16* Ys = WSP(bf16, WS_KV);
    const int gw = c.bid * NWAVE + c.wave, nw = c.G * NWAVE;
    for (int rb = gw; rb < T_ / 4; rb += nw) {
#pragma unroll 1
        for (int r4 = 0; r4 < 4; ++r4) {
            const int row = rb * 4 + r4;
            float v[32]; row_load32(Xin + (size_t)row * D_, c.lane, v);
            row_add_bf16(Ys + (size_t)(2 * row) * D_, c.lane, v); row_add_bf16(Ys + (size_t)(2 * row + 1) * D_, c.lane, v);
            if (Xout) {
#pragma unroll
            for (int cch = 0; cch < 4; ++cch) { *(f32x4*)(Xout + (size_t)row * D_ + cch * 512 + c.lane * 8) = (f32x4){v[cch * 8], v[cch * 8 + 1], v[cch * 8 + 2], v[cch * 8 + 3]};
                *(f32x4*)(Xout + (size_t)row * D_ + cch * 512 + c.lane * 8 + 4) = (f32x4){v[cch * 8 + 4], v[cch * 8 + 5], v[cch * 8 + 6], v[cch * 8 + 7]}; } }
            const float r = row_rstd(v);
            if (!U2L) row_store_norm_bf16(U + (size_t)row * D_, g, c.lane, v, r);
            else {
#pragma unroll
                for (int cch = 0; cch < 4; ++cch) { const f32x4 ga = *(const f32x4*)(g + cch * 512 + c.lane * 8), gb = *(const f32x4*)(g + cch * 512 + c.lane * 8 + 4); float f[8];
#pragma unroll
                    for (int j = 0; j < 4; ++j) { f[j] = v[cch * 8 + j] * r * ga[j]; f[4 + j] = v[cch * 8 + 4 + j] * r * gb[j]; }
                    *(LAS u32x4*)(c.lds + c.wave * 16640 + r4 * 4160 + cch * 1024 + c.lane * 16) = pack8(f); }
            }
        }
        if (U2L) {
#pragma unroll 4
            for (int it = 0; it < 16; ++it) { const int grp = it * 8 + (c.lane >> 3), r4 = (c.lane >> 1) & 3, hf = c.lane & 1;
                const u32x4 w = *(const LAS u32x4*)(c.lds + c.wave * 16640 + r4 * 4160 + grp * 32 + hf * 16);
                *(u32x4*)(U + ((size_t)grp * T_ + rb * 4 + r4) * 16 + hf * 8) = w; }
        }
    }
}

struct S5aSched {
    static constexpr bool GATHER = false, SEG2 = false, LIST = false, HALFN = true; static constexpr int KSB = 128;
    const char* A; const char* B; const char* A2; const char* B2; int zoff; int nt1, nt2, G, c; int hA, hA2, hB2;
    __device__ __forceinline__ unsigned voffA(int R, int C) const { return (unsigned)(R * 1024 + C * 2); }
    __device__ __forceinline__ unsigned voffB(int R, int C) const { return (unsigned)(R * 1024 + C * 2); }
    __device__ __forceinline__ unsigned voffA2(int, int) const { return 0u; }
    __device__ __forceinline__ unsigned voffB2(int, int) const { return 0u; }
    __device__ __forceinline__ bool next(int i, pg::Unit& u) const {
        const int L = i * G + c; if (L >= 256) return false;
        const int g = L >> 1, pm = L & 1; u.pm = pm; u.pn = 0; u.e = g; u.nvalid = 256;
        u.oA = (unsigned)g * 524288u + (unsigned)pm * 262144u; u.oB = (unsigned)g * 131072u; u.oA2 = 0u; u.oB2 = 0u; u.hB = zoff - (int)u.oB; return true;
    }
    __device__ __forceinline__ unsigned grow(const pg::Unit&, int) const { return 0u; }
    __device__ __forceinline__ void list_issue(const pg::Unit&, LAS unsigned char*, int, int, int) const {}
};
constexpr int LSW = 132;
struct EpiS5Loc {
    float* L; LAS float* LS; int to_lds;
    __device__ __forceinline__ void operator()(const f32x4 (&acc)[2][2][4][2], const pg::Unit& u, int wr, int wc, int fr, int fq) const {
        if (to_lds) {
            asm volatile("s_waitcnt vmcnt(0)" ::: "memory");
            __builtin_amdgcn_s_barrier();
#pragma unroll
            for (int ai = 0; ai < 2; ++ai)
#pragma unroll
                for (int m = 0; m < 4; ++m) { LAS float* rp = LS + (ai * 128 + wr * 64 + m * 16 + fr) * LSW + wc * 32 + 8 * fq;
                    *(LAS f32x4*)rp = acc[ai][0][m][0]; *(LAS f32x4*)(rp + 4) = acc[ai][0][m][1]; }
            return;
        }
#pragma unroll
        for (int ai = 0; ai < 2; ++ai)
#pragma unroll
            for (int m = 0; m < 4; ++m) { const int n = u.pm * 256 + ai * 128 + wr * 64 + m * 16 + fr; float* rp = L + ((size_t)u.e * 512 + n) * 128 + wc * 32 + 8 * fq;
                *(f32x4*)rp = acc[ai][0][m][0]; *(f32x4*)(rp + 4) = acc[ai][0][m][1]; }
    }
};
struct S5cSched {
    static constexpr bool GATHER = false, SEG2 = true, LIST = false, HALFN = false; static constexpr int KSB = 128;
    const char* A; const char* A2; const char* B; const char* B2; int nt1, nt2, G, c; int hA, hA2, hB2; int pnf;
    __device__ __forceinline__ unsigned voffA(int R_, int C) const { return (unsigned)(R_ * 1024 + C * 2); }
    __device__ __forceinline__ unsigned voffA2(int R_, int C) const { return (unsigned)(R_ * 256 + C * 2); }
    __device__ __forceinline__ unsigned voffB(int R_, int C) const { const int pj = perm32(R_ & 31), co = pj & 15, tl = 2 * (R_ >> 5) + (pj >> 4); return (unsigned)(co * 2048 + (31 - tl) * 32 + C * 2); }
    __device__ __forceinline__ unsigned voffB2(int R_, int C) const { return (unsigned)(R_ * 256 + C * 2); }
    __device__ __forceinline__ bool next(int i, pg::Unit& u) const {
        const int L = i * G + c; if (L >= 256) return false;
        const int wgid = (L & 7) * 32 + (L >> 3); const int g = wgid >> 1, pm = wgid & 1, pn = pnf;
        u.pm = pm; u.pn = pn; u.e = g; u.nvalid = 256;
        u.oA = (unsigned)g * 524288u + (unsigned)pm * 262144u; u.oA2 = (unsigned)g * 131072u + (unsigned)pm * 65536u;
        u.oB = (unsigned)(g * 32768 - pn * 512); u.hB = -256; u.oB2 = (unsigned)g * 131072u + (unsigned)pn * 65536u; return true;
    }
    __device__ __forceinline__ unsigned grow(const pg::Unit&, int) const { return 0u; }
    __device__ __forceinline__ void list_issue(const pg::Unit&, LAS unsigned char*, int, int, int) const {}
};
struct EpiS5Out {
    bf16* V; const bf16* U2; const float* dsk;
    __device__ __forceinline__ void operator()(const f32x4 (&acc)[2][2][4][2], const pg::Unit& u, int wr, int wc, int fr, int fq) const {
        const int g = u.e, ch0 = (fq & 1) * 8; float dv[8];
#pragma unroll
        for (int q = 0; q < 8; ++q) dv[q] = dsk[g * 16 + ch0 + q];
#pragma unroll
        for (int ai = 0; ai < 2; ++ai)
#pragma unroll
            for (int m = 0; m < 4; ++m) { const int n = u.pm * 256 + ai * 128 + wr * 64 + m * 16 + fr;
#pragma unroll
                for (int bj = 0; bj < 2; ++bj) { const int t = u.pn * 16 + 8 * bj + 2 * wc + (fq >> 1); const int token = n * 32 + t;
                    float uu[8], o[8]; unpack8(*(const u32x4*)(U2 + ((size_t)g * T_ + token) * 16 + ch0), uu);
#pragma unroll
                    for (int q = 0; q < 8; ++q) o[q] = gelu_tanh(acc[ai][bj][m][q >> 2][q & 3] + dv[q] * uu[q]);
                    *(u32x4*)(V + (size_t)token * D_ + g * 16 + ch0) = pack8(o); } }
    }
};
__device__ __forceinline__ void ph_s5a(const Ctx& c) {
    S5aSched S; S.A = (const char*)WSP(bf16, WS_HB); S.B = (const char*)WSP(bf16, WS_S5WST); S.A2 = S.A; S.B2 = S.B; S.zoff = (int)(WS_S5ZERO - WS_S5WST); S.nt1 = 8; S.nt2 = 0; S.G = c.G; S.c = c.bid; S.hA = 128 * 1024; S.hA2 = 0; S.hB2 = 0;
    EpiS5Loc E{WSP(float, WS_S5LOC), (LAS float*)c.lds, (S5_MERGE && c.G == 256) ? 1 : 0};
    pg::gemm_phase_w(c.lds, S, E, c.wave);
}
__device__ __forceinline__ void ph_s5b(const Ctx& c, bool from_lds) {
    const float* L = WSP(float, WS_S5LOC); bf16* H = WSP(bf16, WS_S5HIN); const float* A32 = WSP(float, WS_S5A32);
    LAS float* LS = (LAS float*)c.lds;
    const int p = c.tid & 63, seg = c.tid >> 6;
    for (int item = c.bid; item < 256; item += c.G) {
        const int g = item >> 1, b = item & 1;
        const size_t base = ((size_t)g * 512 + b * 256) * 128;
        if (!from_lds) {
#pragma unroll
            for (int i = 0; i < 16; ++i) { const int e4 = (i * 512 + c.tid) * 4; const f32x4 v = *(const f32x4*)(L + base + e4); *(LAS f32x4*)(LS + (e4 >> 7) * LSW + (e4 & 127)) = v; }
        }
        const float er = A32[(size_t)(g * 64 + p) * 2], ei = A32[(size_t)(g * 64 + p) * 2 + 1];
        __syncthreads();
        float hr = 0.f, hi = 0.f;
        for (int i = 0; i < 32; ++i) { const int n = seg * 32 + i; const float lr = LS[n * LSW + p], li = LS[n * LSW + 64 + p];
            const float nr = er * hr - ei * hi + lr, ni = er * hi + ei * hr + li; hr = nr; hi = ni; LS[n * LSW + p] = hr; LS[n * LSW + 64 + p] = hi; }
        __syncthreads();
        float pr = er, pi = ei;
#pragma unroll
        for (int q = 0; q < 5; ++q) { const float nr = pr * pr - pi * pi, ni = 2.0f * pr * pi; pr = nr; pi = ni; }
        float cr = 0.f, ci = 0.f;
        for (int sp = 0; sp < seg; ++sp) { const float fr = LS[(sp * 32 + 31) * LSW + p], fi = LS[(sp * 32 + 31) * LSW + 64 + p];
            const float nr = pr * cr - pi * ci + fr, ni = pr * ci + pi * cr + fi; cr = nr; ci = ni; }
        __syncthreads();
        float wr = er, wi = ei;
        for (int i = 0; i < 32; ++i) { const int n = seg * 32 + i;
            const float vr = LS[n * LSW + p] + (wr * cr - wi * ci), vi = LS[n * LSW + 64 + p] + (wr * ci + wi * cr);
            LAS bf16* hb = (LAS bf16*)(LS + n * LSW); hb[p] = f2bf(vr); hb[64 + p] = f2bf(vi);
            const float nr = wr * er - wi * ei, ni = wr * ei + wi * er; wr = nr; wi = ni; }
        __syncthreads();
        bf16* hp = H + base;
#pragma unroll
        for (int ps = 0; ps < 8; ++ps) { const int row = ps * 32 + (c.tid >> 4), piece = c.tid & 15;
            if (row < 255) *(u32x4*)(hp + (size_t)(row + 1) * 128 + piece * 8) = *(const LAS u32x4*)((const LAS unsigned char*)(LS + row * LSW) + piece * 16); }
        if (c.tid < 16) *(u32x4*)(hp + c.tid * 8) = (u32x4){0u, 0u, 0u, 0u};
        __syncthreads();
    }
}
__device__ __forceinline__ void ph_s5c(const Ctx& c) {
    S5cSched S; S.A = (const char*)WSP(bf16, WS_HB); S.A2 = (const char*)WSP(bf16, WS_S5HIN); S.B = (const char*)WSP(bf16, WS_S5R); S.B2 = (const char*)WSP(bf16, WS_S5WC);
    S.nt1 = 8; S.nt2 = 2; S.G = c.G; S.c = c.bid; S.hA = 128 * 1024; S.hA2 = 128 * 256; S.hB2 = 128 * 256;
    EpiS5Out E{WSP(bf16, WS_YCAT), WSP(bf16, WS_HB), c.in[16]};
#pragma unroll 1
    for (int hp = 0; hp < 2; ++hp) { S.pnf = hp; S.nt1 = 4 + 4 * hp; pg::gemm_phase_w(c.lds, S, E, c.wave); }
}

__device__ __forceinline__ void s5_load_u(LAS float* ut, const bf16* __restrict__ U, int tbase, int g, int lane) {
    const bf16* p = U + (size_t)(tbase + lane) * D_ + g * 16; float f0[8], f1[8]; unpack8(*(const u32x4*)p, f0); unpack8(*(const u32x4*)(p + 8), f1);
    LAS float* q = ut + lane * 16;
#pragma unroll
    for (int j = 0; j < 8; ++j) { q[j] = f0[j]; q[8 + j] = f1[j]; }
}
template <int MODE>
__device__ __forceinline__ void ph_s5_chunks(const Ctx& c) {
    const bf16* U = WSP(bf16, WS_HB); bf16* V = WSP(bf16, WS_YCAT); float* LOC = WSP(float, WS_S5L);
    const float* A4 = WSP(float, WS_S5A); const float* BB = WSP(float, WS_S5B);
    LAS float* CR = (LAS float*)c.lds;
    LAS float* CI = CR + 16 * 65;
    LAS float* UT = CI + 16 * 65 + c.wave * 1024;
    LAS float* HR = (LAS float*)c.lds + 2 * 16 * 65 + 8 * 1024 + c.wave * (2 * 16 * 65);
    LAS float* HI = HR + 16 * 65;
    const int p = c.lane;
    for (int item = c.bid; item < 256; item += c.G) {
        const int g = item >> 1, b = item & 1;
        __syncthreads();
        if (MODE == 1) { for (int i = c.tid; i < 1024; i += 512) { const int co = i >> 6, pp = i & 63; CR[co * 65 + pp] = c.in[14][(size_t)g * 1024 + i]; CI[co * 65 + pp] = c.in[15][(size_t)g * 1024 + i]; } }
        __syncthreads();
        const float ar = A4[(size_t)(g * 64 + p) * 4], ai = A4[(size_t)(g * 64 + p) * 4 + 1];
        float br[16], bi[16];
#pragma unroll
        for (int j = 0; j < 16; ++j) { br[j] = BB[(size_t)(g * 64 + p) * 32 + j]; bi[j] = BB[(size_t)(g * 64 + p) * 32 + 16 + j]; }
        for (int chunk = c.wave; chunk < NCH; chunk += NWAVE) {
            const int tbase = b * SEQ + chunk * 64;
            s5_load_u(UT, U, tbase, g, c.lane);
            float hr = 0.f, hi = 0.f;
            const size_t li = ((size_t)((b * NCH + chunk) * 128 + g) * 64 + p) * 2;
            if (MODE == 1) { hr = LOC[li]; hi = LOC[li + 1]; }
            for (int sub = 0; sub < 4; ++sub) {
#pragma unroll 4
                for (int tt = 0; tt < 16; ++tt) {
                    const LAS float* up = UT + (sub * 16 + tt) * 16; float xr = 0.f, xi = 0.f;
#pragma unroll
                    for (int q4 = 0; q4 < 4; ++q4) { const f32x4 u4 = *(const LAS f32x4*)(up + q4 * 4);
#pragma unroll
                        for (int j = 0; j < 4; ++j) { xr += br[q4 * 4 + j] * u4[j]; xi += bi[q4 * 4 + j] * u4[j]; } }
                    const float nr = ar * hr - ai * hi + xr, ni = ar * hi + ai * hr + xi; hr = nr; hi = ni;
                    if (MODE == 1) { HR[tt * 65 + p] = hr; HI[tt * 65 + p] = hi; }
                }
                if (MODE == 1) {
                    const int tl = c.lane & 15, cq = c.lane >> 4; float y[4] = {0.f, 0.f, 0.f, 0.f};
                    for (int pp = 0; pp < 64; ++pp) { const float h_r = HR[tl * 65 + pp], h_i = HI[tl * 65 + pp];
#pragma unroll
                        for (int j = 0; j < 4; ++j) y[j] += CR[(cq * 4 + j) * 65 + pp] * h_r - CI[(cq * 4 + j) * 65 + pp] * h_i; }
                    const int t = tbase + sub * 16 + tl; const LAS float* up = UT + (sub * 16 + tl) * 16 + cq * 4;
                    float o[4];
#pragma unroll
                    for (int j = 0; j < 4; ++j) o[j] = gelu_tanh(y[j] + c.in[16][g * 16 + cq * 4 + j] * up[j]);
                    u32x2 w; w.x = pk2(o[0], o[1]); w.y = pk2(o[2], o[3]);
                    *(u32x2*)(V + (size_t)t * D_ + g * 16 + cq * 4) = w;
                }
            }
            if (MODE == 0) { LOC[li] = hr; LOC[li + 1] = hi; }
        }
    }
}
__device__ __forceinline__ void ph_s5_scan(const Ctx& c) {
    float* LOC = WSP(float, WS_S5L); const float* A4 = WSP(float, WS_S5A);
    const int gtid = c.bid * NTHR + c.tid, gn = c.G * NTHR;
    for (int i = gtid; i < 2 * 128 * 64; i += gn) {
        const int b = i >> 13, gp = i & 8191;
        const float er = A4[(size_t)gp * 4 + 2], ei = A4[(size_t)gp * 4 + 3];
        float hr = 0.f, hi = 0.f;
        for (int ch = 0; ch < NCH; ++ch) { const size_t li = ((size_t)(b * NCH + ch) * 8192 + gp) * 2; const float lr = LOC[li], lim = LOC[li + 1]; LOC[li] = hr; LOC[li + 1] = hi;
            const float nr = er * hr - ei * hi + lr, ni = er * hi + ei * hr + lim; hr = nr; hi = ni; }
    }
}

struct EpiGlu {
    const float* R; float* O; bf16* HBo; const float* g; const bf16* Ys;
    __device__ __forceinline__ void operator()(const f32x4 (&acc)[2][2][4][2], const pg::Unit& u, int wr, int wc, int fr, int fq) const {
        const int colb = u.pn * 128 + wc * 32 + 8 * fq;
        const f32x4 g0 = *(const f32x4*)(g + colb), g1 = *(const f32x4*)(g + colb + 4);
#pragma unroll
        for (int ai = 0; ai < 2; ++ai) {
            f32x4 rv[4][2]; u32x4 ya[4], yb[4];
#pragma unroll
            for (int m = 0; m < 4; ++m) { const size_t row = (size_t)(u.pm * 256 + ai * 128 + wr * 64 + m * 16 + fr);
#pragma unroll
                for (int n = 0; n < 2; ++n) rv[m][n] = *(const f32x4*)(R + row * D_ + colb + n * 4);
                if (Ys) { ya[m] = *(const u32x4*)(Ys + (2 * row) * D_ + colb); yb[m] = *(const u32x4*)(Ys + (2 * row + 1) * D_ + colb); } }
            asm volatile("" ::: "memory");
#pragma unroll
            for (int m = 0; m < 4; ++m) { const size_t off = (size_t)(u.pm * 256 + ai * 128 + wr * 64 + m * 16 + fr) * D_ + colb; f32x4 o[2];
                if (Ys) { float fa[8], fb[8]; unpack8(ya[m], fa); unpack8(yb[m], fb);
#pragma unroll
                    for (int j = 0; j < 4; ++j) { rv[m][0][j] += fa[j] + fb[j]; rv[m][1][j] += fa[4 + j] + fb[4 + j]; } }
#pragma unroll
                for (int n = 0; n < 2; ++n) {
#pragma unroll
                    for (int j = 0; j < 4; ++j) o[n][j] = rv[m][n][j] + acc[ai][0][m][n][j] * sigmoidf_(acc[ai][1][m][n][j]);
                    *(f32x4*)(O + off + n * 4) = o[n]; }
                u32x4 w; w.x = pk2(o[0][0] * g0[0], o[0][1] * g0[1]); w.y = pk2(o[0][2] * g0[2], o[0][3] * g0[3]); w.z = pk2(o[1][0] * g1[0], o[1][1] * g1[1]); w.w = pk2(o[1][2] * g1[2], o[1][3] * g1[3]);
                *(u32x4*)(HBo + off) = w; }
            asm volatile("" ::: "memory");
        }
    }
};
__device__ __forceinline__ void ph_glu(const Ctx& c) {
    if (NAIVE_GEMM & 16) {
        const bf16* A = WSP(bf16, WS_YCAT); const float* X = WSP(float, WS_XB); float* O = WSP(float, WS_XA); bf16* HBn = WSP(bf16, WS_HB); const float* gn = c.in[2] + 2048;
        naive_gemm<true>(c, T_, 2048, 2048, [=](int r) { return A + (size_t)r * 2048; }, c.in[17], c.in[17] + 2048, 4096, [=](int r, int col, float a, float b) { const float o = X[(size_t)r * 2048 + col] + a * sigmoidf_(b); O[(size_t)r * 2048 + col] = o; HBn[(size_t)r * 2048 + col] = f2bf(o * gn[col]); });
    } else {
        pg::DenseSched S; S.init(WSP(bf16, WS_YCAT), WSP(bf16, WS_WGLU), T_, 4096, 2048, c.G, c.bid);
        EpiGlu E{SKIP_X2 ? WSP(float, WS_XA) : WSP(float, WS_XB), WSP(float, WS_XA), WSP(bf16, WS_HB), c.in[2] + 2048, SKIP_X2 ? WSP(bf16, WS_KV) : (const bf16*)nullptr};
        if (CONV_IN_GEMM) {
            const int slot = (c.bid >> 3) % 4; S.i1 = slot + 1; pg::gemm_phase_w(c.lds, S, E, c.wave);
            conv_slice(c, CVO_GU + CV_GU / 2 + CV_GU1_SPLIT * 256, CV_GU / 2 - CV_GU1_SPLIT * 256, 0, 0, 0, 0);
            S.i0 = slot + 1; S.i1 = 1 << 20; pg::gemm_phase_w(c.lds, S, E, c.wave); }
        else pg::gemm_phase_w(c.lds, S, E, c.wave);
    }
}

__device__ __forceinline__ void ph_final(const Ctx& c) {
    const bf16* Ys = WSP(bf16, WS_KV); const float* X = WSP(float, WS_XA); const float* g = c.in[3];
    const int gw = c.bid * NWAVE + c.wave, nw = c.G * NWAVE;
    for (int row = gw; row < T_; row += nw) {
        float v[32]; row_load32(X + (size_t)row * D_, c.lane, v);
        row_add_bf16(Ys + (size_t)(2 * row) * D_, c.lane, v); row_add_bf16(Ys + (size_t)(2 * row + 1) * D_, c.lane, v);
        const float r = row_rstd(v);
#pragma unroll
        for (int cch = 0; cch < 4; ++cch) { const f32x4 ga = *(const f32x4*)(g + cch * 512 + c.lane * 8), gb = *(const f32x4*)(g + cch * 512 + c.lane * 8 + 4);
            *(f32x4*)(c.out + (size_t)row * D_ + cch * 512 + c.lane * 8) = (f32x4){v[cch * 8] * r * ga[0], v[cch * 8 + 1] * r * ga[1], v[cch * 8 + 2] * r * ga[2], v[cch * 8 + 3] * r * ga[3]};
            *(f32x4*)(c.out + (size_t)row * D_ + cch * 512 + c.lane * 8 + 4) = (f32x4){v[cch * 8 + 4] * r * gb[0], v[cch * 8 + 5] * r * gb[1], v[cch * 8 + 6] * r * gb[2], v[cch * 8 + 7] * r * gb[3]}; }
    }
}

constexpr int NPHASE = 18;
__global__ void __launch_bounds__(NTHR, 2) mk_fwd(Args args) {
    extern __shared__ __attribute__((aligned(16))) unsigned char lds_raw[];
    Ctx c;
#pragma unroll
    for (int i = 0; i < 25; ++i) c.in[i] = args.in[i];
    c.out = args.out; c.ws = args.ws; c.lds = (LAS unsigned char*)lds_raw;
    c.wave = __builtin_amdgcn_readfirstlane((int)threadIdx.x >> 6); c.lane = lane_id(); c.tid = c.wave * 64 + c.lane;     c.G = gridDim.x; c.bid = blockIdx.x;
    const int lo = args.ph_lo, hi = args.ph_hi;
    volatile LAS unsigned* st = (volatile LAS unsigned*)(c.lds + MISC_OFF);
    if (c.tid < 4) st[c.tid] = 0u;
    __syncthreads();
    XcdBarrier bar; bar.bar = WSP(unsigned, WS_CTL) + CW_BAR; bar.x = 0; bar.st = st;
    if (hi - lo > 1) bar = xcd_barrier_post(WSP(unsigned, WS_CTL) + CW_BAR, st, c.tid == 0);
#define IN(k) (lo <= (k) && (k) < hi)
#define SEAM(k) do { c.lane = lane_id(); c.tid = c.wave * 64 + c.lane; if (IN(k) && IN((k) + 1)) { xcd_barrier(bar, c.tid == 0); if (PROBE_DUP & (1 << 30)) xcd_barrier(bar, c.tid == 0); } } while (0)
    if (IN(0)) { ph_prologue(c); if (PROBE_DUP & (1 << 0)) { __syncthreads(); ph_prologue(c); } }
    SEAM(0);
    if (IN(1)) { ph_inproj(c); if (PROBE_DUP & (1 << 1)) { __syncthreads(); ph_inproj(c); } }
    SEAM(1);
    if (IN(2)) { ph_conv_hglocal(c); if (HG_MFMA) ph_hgL(c); if (PROBE_DUP & (1 << 2)) { __syncthreads(); ph_conv_hglocal(c); if (HG_MFMA) ph_hgL(c); } }
    SEAM(2);
    if (IN(3)) { if (HG_MFMA) ph_hgS(c); else ph_hgscan(c); if (PROBE_DUP & (1 << 3)) { __syncthreads(); if (HG_MFMA) ph_hgS(c); else ph_hgscan(c); } }
    SEAM(3);
    if (IN(4)) { if (HG_MFMA) ph_hgO(c); else ph_hgout(c); if (PROBE_DUP & (1 << 4)) { __syncthreads(); if (HG_MFMA) ph_hgO(c); else ph_hgout(c); } }
    SEAM(4);
    if (IN(5)) { ph_outproj(c); if (PROBE_DUP & (1 << 5)) { __syncthreads(); ph_outproj(c); } }
    SEAM(5);
    if (IN(6)) { ph_router<0>(c, WSP(float, WS_XA)); if (PROBE_DUP & (1 << 6)) { __syncthreads(); ph_router<0, true>(c, WSP(float, WS_XA)); } }
    SEAM(6);
    if (IN(7)) { ph_moe_gu<0>(c); if (PROBE_DUP & (1 << 7)) { __syncthreads(); ph_moe_gu<0>(c); } }
    SEAM(7);
    if (IN(8)) { ph_moe_down<0>(c); if (PROBE_DUP & (1 << 8)) { __syncthreads(); ph_moe_down<0>(c); } }
    SEAM(8);
    if (IN(9)) { ph_res_norm<S5_MFMA != 0>(c, WSP(float, WS_XA), (SKIP_X2 && !(NAIVE_GEMM & 16)) ? (float*)nullptr : WSP(float, WS_XB), c.in[1] + 2048, WSP(bf16, WS_HB)); if (PROBE_DUP & (1 << 9)) { __syncthreads(); ph_res_norm<S5_MFMA != 0>(c, WSP(float, WS_XA), (SKIP_X2 && !(NAIVE_GEMM & 16)) ? (float*)nullptr : WSP(float, WS_XB), c.in[1] + 2048, WSP(bf16, WS_HB)); } }
    SEAM(9);
    if (IN(10)) { if (S5_MFMA) { ph_s5a(c); if (S5_MERGE && c.G == 256) { asm volatile("s_waitcnt vmcnt(0)" ::: "memory"); __syncthreads(); ph_s5b(c, true); } } else ph_s5_chunks<0>(c); if (PROBE_DUP & (1 << 10)) { __syncthreads(); if (S5_MFMA) ph_s5a(c); else ph_s5_chunks<0>(c); } }
    if (!(S5_MFMA && S5_MERGE && c.G == 256)) SEAM(10);
    if (IN(11)) { if (S5_MFMA) { if (!(S5_MERGE && c.G == 256)) ph_s5b(c, false); } else ph_s5_scan(c); if (PROBE_DUP & (1 << 11)) { __syncthreads(); if (S5_MFMA) ph_s5b(c, false); else ph_s5_scan(c); } }
    SEAM(11);
    if (IN(12)) { if (S5_MFMA) ph_s5c(c); else ph_s5_chunks<1>(c); if (PROBE_DUP & (1 << 12)) { __syncthreads(); if (S5_MFMA) ph_s5c(c); else ph_s5_chunks<1>(c); } }
    SEAM(12);
    if (IN(13)) { ph_glu(c); if (PROBE_DUP & (1 << 13)) { __syncthreads(); ph_glu(c); } }
    SEAM(13);
    if (IN(14)) { ph_router<1>(c, WSP(float, WS_XA)); if (PROBE_DUP & (1 << 14)) { __syncthreads(); ph_router<1, true>(c, WSP(float, WS_XA)); } }
    SEAM(14);
    if (IN(15)) { ph_moe_gu<1>(c); if (PROBE_DUP & (1 << 15)) { __syncthreads(); ph_moe_gu<1>(c); } }
    SEAM(15);
    if (IN(16)) { ph_moe_down<1>(c); if (PROBE_DUP & (1 << 16)) { __syncthreads(); ph_moe_down<1>(c); } }
    SEAM(16);
    if (IN(17)) { ph_final(c); if (PROBE_DUP & (1 << 17)) { __syncthreads(); ph_final(c); } }
#undef IN
#undef SEAM
}

extern "C" void kernel_launch(void* const* d_in, const int* in_sizes, int n_in, void* d_out, int out_size, void* d_ws, size_t ws_size, hipStream_t stream) {
    static int grid = 0;
    if (grid == 0) {
        if (n_in != 25 || out_size != T_ * D_ || ws_size < WS_END) { fprintf(stderr, "kernel_launch: unexpected shapes (n_in %d out %d ws %zu)\n", n_in, out_size, ws_size); grid = -1; return; }
        int dev = 0, cus = 0, per_cu = 0;
        if (hipGetDevice(&dev) != hipSuccess || hipDeviceGetAttribute(&cus, hipDeviceAttributeMultiprocessorCount, dev) != hipSuccess) { grid = -1; return; }
        if (hipFuncSetAttribute((const void*)mk_fwd, hipFuncAttributeMaxDynamicSharedMemorySize, LDS_BYTES) != hipSuccess) { fprintf(stderr, "kernel_launch: hipFuncSetAttribute failed\n"); grid = -1; return; }
        if (hipOccupancyMaxActiveBlocksPerMultiprocessor(&per_cu, (const void*)mk_fwd, NTHR, LDS_BYTES) != hipSuccess || per_cu < 1) fprintf(stderr, "kernel_launch: occupancy query says %d\n", per_cu);
        (void)hipGetLastError();
        grid = cus;
    }
    if (grid < 0) return;
    (void)hipMemsetAsync((char*)d_ws + WS_CTL, 0, CTL_BYTES, stream);
    Args a{};
    for (int i = 0; i < 25; ++i) a.in[i] = (const float*)d_in[i];
    a.out = (float*)d_out; a.ws = (unsigned char*)d_ws;
#if N_LAUNCH_MODE == 1
    a.ph_lo = 0; a.ph_hi = NPHASE;
    hipLaunchKernelGGL(mk_fwd, dim3(grid), dim3(NTHR), LDS_BYTES, stream, a);
#else
    for (int p = 0; p < NPHASE; ++p) { a.ph_lo = p; a.ph_hi = p + 1; hipLaunchKernelGGL(mk_fwd, dim3(grid), dim3(NTHR), LDS_BYTES, stream, a); }
#endif
}
```

```cpp
#include <hip/hip_runtime.h>
#include <cstdio>
#include <cstdint>

#ifndef N_LAUNCH_MODE
#define N_LAUNCH_MODE 1
#endif
#ifndef NAIVE_GEMM
#define NAIVE_GEMM 0
#endif

#ifndef S5_MFMA
#define S5_MFMA 1
#endif
#ifndef HG_MFMA
#define HG_MFMA 1
#endif
#ifndef S5_MERGE
#define S5_MERGE 1
#endif
#ifndef SKIP_X2
#define SKIP_X2 1
#endif
#ifndef PROBE_DUP
#define PROBE_DUP 0
#endif
#define LAS __attribute__((address_space(3)))
typedef unsigned short bf16;
typedef short bf16x8 __attribute__((ext_vector_type(8)));
typedef float f32x4 __attribute__((ext_vector_type(4)));
typedef float f32x2 __attribute__((ext_vector_type(2)));
typedef float f32x16 __attribute__((ext_vector_type(16)));
typedef unsigned u32x4 __attribute__((ext_vector_type(4)));
typedef unsigned u32x2 __attribute__((ext_vector_type(2)));

constexpr int T_ = 16384, SEQ = 8192, D_ = 2048, NIN = 7168, FF = 1024, NE = 32, CAP = 16384, HSLOT = 40960;
constexpr int NCH = 128;
constexpr float EPS = 1e-6f;
constexpr int NTHR = 512, NWAVE = 8;

constexpr size_t MiB = 1u << 20;
constexpr size_t WS_CTL = 0, CTL_BYTES = 1 * MiB;
constexpr size_t WS_WIN = 1 * MiB;
constexpr size_t WS_WOUT = 29 * MiB;
constexpr size_t WS_WGLU = 37 * MiB;
constexpr size_t WS_WGU = 53 * MiB;
constexpr size_t WS_WD = 565 * MiB;
constexpr size_t WS_HB = 821 * MiB;
constexpr size_t WS_YCAT = 885 * MiB;
constexpr size_t WS_XA = 949 * MiB;
constexpr size_t WS_XB = 1077 * MiB;
constexpr size_t WS_Z = 1205 * MiB;
constexpr size_t WS_KV = 1429 * MiB;
constexpr size_t WS_HID = 1557 * MiB;
constexpr size_t WS_ROWL = 1637 * MiB;
constexpr size_t WS_TOKG = 1641 * MiB;
constexpr size_t WS_TOKR = 1641 * MiB + 262144;
constexpr size_t WS_HGDEC = 1642 * MiB;
constexpr size_t WS_LB = 1643 * MiB;
constexpr size_t WS_S5A = 1643 * MiB + 65536;
constexpr size_t WS_S5B = 1644 * MiB;
constexpr size_t WS_S5L = 1645 * MiB;
constexpr size_t WS_WR = 1661 * MiB;
constexpr size_t WS_S5R = 1662 * MiB;
constexpr size_t WS_S5WST = 1666 * MiB;
constexpr size_t WS_S5WC = 1682 * MiB;
constexpr size_t WS_S5ZERO = 1698 * MiB;
constexpr size_t WS_S5A32 = 1698 * MiB + 524288;
constexpr size_t WS_S5LOC = 1699 * MiB;
constexpr size_t WS_S5HIN = 1731 * MiB;
constexpr size_t WS_SIN = 1747 * MiB;
constexpr size_t WS_ROWL16 = 1811 * MiB;
constexpr size_t WS_END = 1827 * MiB;

constexpr int CW_BAR = 4096;
constexpr int CW_CNT = 8192;

constexpr int LDS_BYTES = 163840;
constexpr int CONV_OFF = 131072;
constexpr int LIST_OFF = 131072;
constexpr int MISC_OFF = 155648;

__device__ __forceinline__ float bf2f(bf16 b) { return __uint_as_float(((unsigned)b) << 16); }
typedef __bf16 bf16x2_t __attribute__((ext_vector_type(2)));
__device__ __forceinline__ unsigned pk2(float lo, float hi) { const f32x2 v = {lo, hi}; return __builtin_bit_cast(unsigned, __builtin_convertvector(v, bf16x2_t)); }
__device__ __forceinline__ bf16 f2bf(float f) { return __builtin_bit_cast(bf16, (__bf16)f); }
__device__ __forceinline__ float sigmoidf_(float x) { return __builtin_amdgcn_rcpf(1.0f + __builtin_amdgcn_exp2f(-1.4426950408889634f * x)); }
__device__ __forceinline__ float siluf_(float x) { return x * __builtin_amdgcn_rcpf(1.0f + __builtin_amdgcn_exp2f(-1.4426950408889634f * x)); }
__device__ __forceinline__ float gelu_tanh(float x) { const float t = x * x; const float p = __builtin_fmaf(t, -0.10294324f, -2.3022082f); return x * __builtin_amdgcn_rcpf(1.0f + __builtin_amdgcn_exp2f(x * p)); }
__device__ __forceinline__ void unpack8(const u32x4 w, float (&o)[8]) {
    o[0] = __uint_as_float(w.x << 16); o[1] = __uint_as_float(w.x & 0xffff0000u); o[2] = __uint_as_float(w.y << 16); o[3] = __uint_as_float(w.y & 0xffff0000u);
    o[4] = __uint_as_float(w.z << 16); o[5] = __uint_as_float(w.z & 0xffff0000u); o[6] = __uint_as_float(w.w << 16); o[7] = __uint_as_float(w.w & 0xffff0000u);
}
__device__ __forceinline__ u32x4 pack8(const float (&v)[8]) { u32x4 w; w.x = pk2(v[0], v[1]); w.y = pk2(v[2], v[3]); w.z = pk2(v[4], v[5]); w.w = pk2(v[6], v[7]); return w; }
__host__ __device__ __forceinline__ int perm32(int rho) { const int n = rho >> 4, i = rho & 15; return 8 * (i >> 2) + 4 * n + (i & 3); }
__device__ __forceinline__ int lane_id() { unsigned z = 0u; asm volatile("" : "+v"(z)); return (int)__builtin_amdgcn_mbcnt_hi(~0u, __builtin_amdgcn_mbcnt_lo(~0u, z)); }
__device__ __forceinline__ float wave_sum(float v) {
#pragma unroll
    for (int o = 32; o >= 1; o >>= 1) v += __shfl_xor(v, o);
    return v;
}

#define XB_TMO      128
#define XB_XCNT(j)  (256  + 64 * (j))
#define XB_XSUB(j)  (1280 + 64 * (j))
#define XB_XGEN(j)  (2304 + 64 * (j))
#define XB_TOP      3328
#define XB_TOPGEN   3392
#define XCD_BAR_WORDS 3456
#define XB_SPIN_CAP (1u << 24)
__device__ __forceinline__ unsigned xb_ld(unsigned* p)              { return __hip_atomic_load(p, __ATOMIC_RELAXED, __HIP_MEMORY_SCOPE_AGENT); }
__device__ __forceinline__ unsigned xb_add(unsigned* p, unsigned v) { return __hip_atomic_fetch_add(p, v, __ATOMIC_RELAXED, __HIP_MEMORY_SCOPE_AGENT); }
__device__ __forceinline__ unsigned xb_xcc_id() { return (unsigned)__builtin_amdgcn_s_getreg((3 << 11) | 20) & 0xFu; }
#define XB_SPIN(cond, bar) do { unsigned _sp = 0; while (cond) { __builtin_amdgcn_s_sleep(1); \
    if ((++_sp & 255u) == 0u) { if (xb_ld(&(bar)[XB_TMO])) break; if (_sp > XB_SPIN_CAP) { atomicAdd(&(bar)[XB_TMO], 1u); break; } } } } while (0)
struct XcdBarrier { unsigned* bar; unsigned x; volatile LAS unsigned* st; };
__device__ __forceinline__ XcdBarrier xcd_barrier_post(unsigned* bar, volatile LAS unsigned* st, bool t0) {
    XcdBarrier b; b.bar = bar; b.x = xb_xcc_id(); b.st = st;
    if (t0) (void)xb_add(&bar[XB_XCNT(b.x)], 1u);
    return b;
}
__device__ __forceinline__ void xcd_barrier_complete(unsigned* bar, unsigned x, unsigned& nloc, unsigned& nx) {
    const unsigned G = gridDim.x * gridDim.y * gridDim.z;
    unsigned sum, cnt, mine, sp = 0u;
    for (;;) {
        sum = 0u; cnt = 0u; mine = 0u;
#pragma unroll
        for (unsigned j = 0; j < 16; ++j) { const unsigned c = xb_ld(&bar[XB_XCNT(j)]); sum += c; cnt += (c > 0u) ? 1u : 0u; mine = (j == x) ? c : mine; }
        if (sum == G) break;
        __builtin_amdgcn_s_sleep(1);
        if ((++sp & 255u) == 0u) { if (xb_ld(&bar[XB_TMO])) break; if (sp > XB_SPIN_CAP) { atomicAdd(&bar[XB_TMO], 1u); break; } }
    }
    nloc = mine > 0u ? mine : 1u; nx = cnt > 0u ? cnt : 1u;
}
__device__ __forceinline__ void xcd_barrier(const XcdBarrier& b, bool t0) {
    asm volatile("s_waitcnt vmcnt(0)" ::: "memory");
    __syncthreads();
    if (t0) {
        unsigned* bar = b.bar;
        __builtin_amdgcn_s_waitcnt(0);
        unsigned nloc = b.st[0], nx = b.st[1];
        if (nloc == 0u) { xcd_barrier_complete(bar, b.x, nloc, nx); b.st[0] = nloc; b.st[1] = nx; }
        const unsigned old = xb_add(&bar[XB_XSUB(b.x)], 1u);
        const unsigned gen = old / nloc;
        if (old + 1u == (gen + 1u) * nloc) {
            __builtin_amdgcn_fence(__ATOMIC_RELEASE, "agent");
            asm volatile("s_waitcnt vmcnt(0)" ::: "memory");
            const unsigned og = xb_add(&bar[XB_TOP], 1u);
            const unsigned tg = og / nx;
            if (og + 1u == (tg + 1u) * nx) xb_add(&bar[XB_TOPGEN], 1u);
            else XB_SPIN(xb_ld(&bar[XB_TOPGEN]) == tg, bar);
            __builtin_amdgcn_fence(__ATOMIC_ACQUIRE, "agent");
            xb_add(&bar[XB_XGEN(b.x)], 1u);
            asm volatile("s_waitcnt vmcnt(0)" ::: "memory");
        } else {
            XB_SPIN(xb_ld(&bar[XB_XGEN(b.x)]) == gen, bar);
            __builtin_amdgcn_fence(__ATOMIC_ACQUIRE, "agent");
            asm volatile("s_waitcnt vmcnt(0)" ::: "memory");
        }
    }
    __syncthreads();
}

namespace pg {
constexpr int BM = 256, BK = 64, HALF = 128, HTB = HALF * BK * 2, STAGE_BYTES = 8 * HTB, NXCD = 8, WGM = 8;
__host__ __device__ __forceinline__ int lds_byte(int r, int c) { const int st = (r >> 4) * 2 + (c >> 5), rr = r & 15, cc = c & 31, ob = rr * 64 + cc * 2; return st * 1024 + (ob ^ (((ob >> 9) & 1) << 5)); }
__host__ __device__ __forceinline__ void stage_rc(int b, int& R, int& C) { const int st = b / 1024, sb = b % 1024, swz = sb ^ (((sb >> 9) & 1) << 5); R = (st >> 1) * 16 + swz / 64; C = (st & 1) * 32 + (swz % 64) / 2; }

struct Unit { unsigned oA, oB, oA2, oB2; int hB, pm, pn, e, nvalid, lbuf; };

struct DenseSched {
    static constexpr bool GATHER = false, SEG2 = false, LIST = false, HALFN = false; static constexpr int KSA = 128;
    const char* A; const char* B; const char* A2; const char* B2; int nt1, nt2, nM, nN, nwg, G, c, i0, i1;
    int pitchA, pitchB, hA, hA2, hB2;
    __device__ __forceinline__ void init(const bf16* A_, const bf16* B_, int M, int N, int K_, int G_, int c_) { A = (const char*)A_; B = (const char*)B_; A2 = A; B2 = B; nt1 = K_ / BK; nt2 = 0; nM = M / BM; nN = N / BM; nwg = nM * nN; G = G_; c = c_; pitchA = K_ * 2; pitchB = K_ * 2; hA = 128 * pitchA; hA2 = 0; hB2 = 0; i0 = 0; i1 = 1 << 20; }
    __device__ __forceinline__ unsigned voffA(int R, int C) const { return (unsigned)(R * pitchA + C * 2); }
    __device__ __forceinline__ unsigned voffB(int R, int C) const { return (unsigned)(R * pitchB + C * 2); }
    __device__ __forceinline__ unsigned voffA2(int, int) const { return 0u; }
    __device__ __forceinline__ unsigned voffB2(int, int) const { return 0u; }
    __device__ __forceinline__ bool next(int i, Unit& u) const {
        if (i0 + i >= i1) return false;
        const long L = (long)(i0 + i) * G + c; if (L >= nwg) return false;
        int wgid = (int)L; { const int q = nwg / NXCD, r = nwg % NXCD, xcd = wgid % NXCD, off = wgid / NXCD; wgid = (xcd < r ? xcd * (q + 1) : r * (q + 1) + (xcd - r) * q) + off; }
        const int nig = WGM * nN, gid = wgid / nig, fm = gid * WGM, gsz = (nM - fm) < WGM ? (nM - fm) : WGM;
        u.pm = fm + ((wgid % nig) % gsz); u.pn = (wgid % nig) / gsz; u.e = 0; u.nvalid = 256;
        u.oA = (unsigned)u.pm * 256u * (unsigned)pitchA; u.oB = (unsigned)u.pn * 256u * (unsigned)pitchB; u.oA2 = 0u; u.oB2 = 0u; u.hB = 128 * pitchB; return true;
    }
    __device__ __forceinline__ unsigned grow(const Unit&, int) const { return 0u; }
    __device__ __forceinline__ void list_issue(const Unit&, LAS unsigned char*, int, int, int) const {}
};

template <bool GATHER_> struct MoeSched {
    static constexpr bool GATHER = GATHER_, SEG2 = false, LIST = true, HALFN = false; static constexpr int KSA = 128;
    const u32x4* rowl16;
    const char* A; const char* B; const char* A2; const char* B2; int nt1, nt2, nN, nwg, G, c, i0, i1; int pitchA, pitchB, hA, hA2, hB2; unsigned expStrideB;
    const LAS int* tile0; const LAS int* cnt; const LAS unsigned char* tileExp; const int* rowl;
    __device__ __forceinline__ unsigned voffA(int R, int C) const { return (unsigned)(R * pitchA + C * 2); }
    __device__ __forceinline__ unsigned voffB(int R, int C) const { return (unsigned)(R * pitchB + C * 2); }
    __device__ __forceinline__ unsigned voffA2(int, int) const { return 0u; }
    __device__ __forceinline__ unsigned voffB2(int, int) const { return 0u; }
    __device__ __forceinline__ bool next(int i, Unit& u) const {
        if (i0 + i >= i1) return false;
        const long L = (long)(i0 + i) * G + c; if (L >= nwg) return false;
        int wgid = (int)L; { const int q = nwg / NXCD, xcd = wgid % NXCD, off = wgid / NXCD; wgid = xcd * q + off; }
        const int rt = wgid / nN, nt = wgid % nN;
        const int e = __builtin_amdgcn_readfirstlane((int)tileExp[rt]);
        const int lt = rt - __builtin_amdgcn_readfirstlane(tile0[e]);
        const int ce = __builtin_amdgcn_readfirstlane(cnt[e]);
        u.pm = rt; u.pn = nt; u.e = e; u.nvalid = ce - lt * 256;
        u.oA = GATHER ? 0u : (unsigned)rt * 256u * (unsigned)pitchA;
        u.oB = (unsigned)e * expStrideB + (unsigned)nt * 256u * (unsigned)pitchB; u.oA2 = 0u; u.oB2 = 0u; u.hB = 128 * pitchB; return true;
    }
    __device__ __forceinline__ void list_issue(const Unit& u, LAS unsigned char* lds, int buf, int wid, int lane) const {
        if (wid < 4) { const u32x4* src = rowl16 + (size_t)u.e * CAP + (size_t)(u.pm - tile0[u.e]) * 256 + wid * 64 + lane;
            __builtin_amdgcn_global_load_lds((const unsigned*)src, (LAS unsigned*)(lds + LIST_OFF + buf * 4096 + wid * 1024), 16, 0, 0); }
    }
    __device__ __forceinline__ unsigned grow_l(const Unit& u, const LAS unsigned char* lds, int buf, int r) const {
        const int v = *(const LAS int*)(lds + LIST_OFF + buf * 4096 + r * 16);
        const int tok = r < u.nvalid ? (v >> 1) : 0;
        return (unsigned)tok * (unsigned)pitchA;
    }
};

struct NoHook { __device__ __forceinline__ void operator()(int) const {} };
template <class Epi, class Sched, class Hook = NoHook>
__device__ __forceinline__ void gemm_phase_w(LAS unsigned char* lds, const Sched& S, const Epi& E, int wave_id, const Hook& HK = Hook()) {
    constexpr bool GATHER = Sched::GATHER, SEG2 = Sched::SEG2, LIST = Sched::LIST, HALFN = Sched::HALFN;
    const int lane = lane_id(), wid = wave_id, tid = wid * 64 + lane, wr = wid >> 2, wc = wid & 3, fr = lane & 15, fq = lane >> 4;
    const int nt1 = S.nt1, nt = S.nt1 + S.nt2;
    int R0, C0, R1, C1; stage_rc(tid * 16, R0, C0); stage_rc(tid * 16 + 8192, R1, C1);
    const unsigned voffA_0 = S.voffA(R0, C0), voffA_1 = S.voffA(R1, C1), voffB_0 = S.voffB(R0, C0), voffB_1 = S.voffB(R1, C1);
    const unsigned voffA2_0 = SEG2 ? S.voffA2(R0, C0) : 0u, voffA2_1 = SEG2 ? S.voffA2(R1, C1) : 0u, voffB2_0 = SEG2 ? S.voffB2(R0, C0) : 0u, voffB2_1 = SEG2 ? S.voffB2(R1, C1) : 0u;
    const int hA = S.hA, hA2 = S.hA2, hB2 = S.hB2;
    const unsigned ldsw = (unsigned)wid * 1024u;
    const int aoff = lds_byte(wr * 64 + fr, fq * 8), boff = lds_byte(wc * 32 + fr, fq * 8);
    unsigned gcur_00 = 0u, gcur_01 = 0u, gcur_10 = 0u, gcur_11 = 0u, gnxt_00 = 0u, gnxt_01 = 0u, gnxt_10 = 0u, gnxt_11 = 0u;
#define PG_SA(b, h) (((b) * 2 + (h)) * HTB)
#define PG_SB(b, h) ((4 + (b) * 2 + (h)) * HTB)
#define PG_GLDS(gp, bufoff, _i) __builtin_amdgcn_global_load_lds((const unsigned*)(gp), (LAS unsigned*)(lds + (bufoff) + ldsw + (_i) * 8192), 16, 0, 0)
#define PG_STAGE_B(bufoff, oB_, oB2_, hB_, kt, h, S2) do { \
        const char* _b = (S2) ? S.B2 + (long)(int)((oB2_) + (unsigned)(((kt) - nt1) * 128 + (h) * hB2)) : S.B + (long)(int)((oB_) + (unsigned)((kt) * 128 + (h) * (hB_))); \
        PG_GLDS(_b + ((S2) ? voffB2_0 : voffB_0), bufoff, 0); PG_GLDS(_b + ((S2) ? voffB2_1 : voffB_1), bufoff, 1); } while (0)
#define PG_STAGE_A(bufoff, oA_, oA2_, kt, h, GV, S2) do { \
        const char* _b = (S2) ? S.A2 + (size_t)((oA2_) + (unsigned)(((kt) - nt1) * 128 + (h) * hA2)) : S.A + (size_t)((oA_) + (unsigned)((kt) * S.KSA + (GATHER ? 0 : (h) * hA))); \
        if constexpr (GATHER) { PG_GLDS(_b + (GV##_##h##0), bufoff, 0); PG_GLDS(_b + (GV##_##h##1), bufoff, 1); } \
        else { PG_GLDS(_b + ((S2) ? voffA2_0 : voffA_0), bufoff, 0); PG_GLDS(_b + ((S2) ? voffA2_1 : voffA_1), bufoff, 1); } } while (0)
#define PG_SB_CUR(bufoff, kt, h, S2) PG_STAGE_B(bufoff, cur.oB, cur.oB2, cur.hB, kt, h, S2)
#define PG_SA_CUR(bufoff, kt, h, S2) PG_STAGE_A(bufoff, cur.oA, cur.oA2, kt, h, gcur, S2)
#define PG_SB_SEL(bufoff, kt, h, S2) PG_STAGE_B(bufoff, s_oB, s_oB2, s_hB, kt, h, S2)
#define PG_SA_SEL(bufoff, kt, h, S2) PG_STAGE_A(bufoff, s_oA, s_oA2, kt, h, gsel, S2)
#define PG_LDA(dst, b, h) do { _Pragma("unroll") for (int m = 0; m < 4; ++m) _Pragma("unroll") for (int k = 0; k < 2; ++k) dst[m][k] = *(const LAS bf16x8*)(lds + PG_SA(b, h) + aoff + m * 2048 + k * 1024); } while (0)
#define PG_LDB(dst, b, h) do { _Pragma("unroll") for (int n = 0; n < 2; ++n) _Pragma("unroll") for (int k = 0; k < 2; ++k) dst[n][k] = *(const LAS bf16x8*)(lds + PG_SB(b, h) + boff + n * 2048 + k * 1024); } while (0)
#define PG_MMA(ai, bj, At, Bt) do { __builtin_amdgcn_s_setprio(1); _Pragma("unroll") for (int m = 0; m < 4; ++m) _Pragma("unroll") for (int n = 0; n < 2; ++n) _Pragma("unroll") for (int k = 0; k < 2; ++k) \
        acc[ai][bj][m][n] = __builtin_amdgcn_mfma_f32_16x16x32_bf16(Bt[n][k], At[m][k], acc[ai][bj][m][n], 0, 0, 0); __builtin_amdgcn_s_setprio(0); } while (0)
#define PG_WAIT_V(n) asm volatile("s_waitcnt vmcnt(" #n ")" ::: "memory")
#define PG_WAIT_L(n) asm volatile("s_waitcnt lgkmcnt(" #n ")" ::: "memory")
#define PG_BAR __builtin_amdgcn_s_barrier()
#define PG_SCHED __builtin_amdgcn_sched_barrier(0)
    Unit cur, nxt; int ui = 0;
    if (!S.next(0, cur)) return;
    f32x4 acc[2][2][4][2];
#pragma unroll
    for (int a = 0; a < 2; ++a)
#pragma unroll
        for (int b = 0; b < 2; ++b)
#pragma unroll
            for (int m = 0; m < 4; ++m)
#pragma unroll
                for (int n = 0; n < 2; ++n) acc[a][b][m][n] = (f32x4){0.f, 0.f, 0.f, 0.f};
    bf16x8 At[4][2], B0[2][2], B1[2][2];
    cur.lbuf = 0;
    if constexpr (LIST) {
        S.list_issue(cur, lds, 0, wid, lane);
        asm volatile("s_waitcnt vmcnt(0)" ::: "memory"); __builtin_amdgcn_s_barrier(); asm volatile("" ::: "memory");
    }
    if constexpr (GATHER) {
        gcur_00 = S.grow_l(cur, lds, 0, R0) + (unsigned)(C0 * 2); gcur_01 = S.grow_l(cur, lds, 0, R1) + (unsigned)(C1 * 2); gcur_10 = S.grow_l(cur, lds, 0, 128 + R0) + (unsigned)(C0 * 2); gcur_11 = S.grow_l(cur, lds, 0, 128 + R1) + (unsigned)(C1 * 2);
    }
    PG_SB_CUR(PG_SB(0, 0), 0, 0, false); PG_SB_CUR(PG_SB(0, 1), 0, 1, false); PG_SA_CUR(PG_SA(0, 0), 0, 0, false); PG_SA_CUR(PG_SA(0, 1), 0, 1, false);
    if (wr == 1) PG_BAR;
    PG_WAIT_V(2); PG_BAR;
    PG_SB_CUR(PG_SB(1, 0), 1, 0, false); PG_SA_CUR(PG_SA(1, 0), 1, 0, false); PG_SB_CUR(PG_SB(1, 1), 1, 1, false);
    PG_WAIT_V(6); PG_BAR;
    for (;;) {
        const bool has_next = S.next(ui + 1, nxt);
        if (!has_next) nxt = cur;
        const int nbuf = (ui + 1) % 3; nxt.lbuf = has_next ? nbuf : cur.lbuf;
        if constexpr (LIST) { if (has_next) S.list_issue(nxt, lds, nbuf, wid, lane); }
#define PG_TRIP(T, A1S2, K23S2, LAST) do { const int t = (T); const bool last = (t == nt - 2); (void)(LAST); \
            const unsigned s_oA = last ? nxt.oA : cur.oA, s_oB = last ? nxt.oB : cur.oB, s_oA2 = last ? nxt.oA2 : cur.oA2, s_oB2 = last ? nxt.oB2 : cur.oB2; const int s_hB = last ? nxt.hB : cur.hB; \
            const int k2 = last ? 0 : t + 2, k3 = k2 + 1; \
            const unsigned gsel_00 = last ? gnxt_00 : gcur_00, gsel_01 = last ? gnxt_01 : gcur_01, gsel_10 = last ? gnxt_10 : gcur_10, gsel_11 = last ? gnxt_11 : gcur_11; \
            (void)s_oA2; (void)s_oB2; (void)gsel_00; (void)gsel_01; (void)gsel_10; (void)gsel_11; \
              \
            PG_LDB(B0, 0, 0); if constexpr (!HALFN) PG_LDB(B1, 0, 1); PG_SCHED; PG_LDA(At, 0, 0); PG_SA_CUR(PG_SA(1, 1), t + 1, 1, A1S2); \
            PG_WAIT_V(8); PG_WAIT_L(0); PG_BAR; PG_MMA(0, 0, At, B0); if constexpr (!HALFN) PG_MMA(0, 1, At, B1); PG_BAR; PG_SCHED; \
              \
            PG_LDA(At, 0, 1); PG_SB_SEL(PG_SB(0, 0), k2, 0, K23S2); PG_SB_SEL(PG_SB(0, 1), k2, 1, K23S2); PG_SA_SEL(PG_SA(0, 0), k2, 0, K23S2); \
            PG_WAIT_V(8); PG_WAIT_L(0); PG_BAR; PG_MMA(1, 0, At, B0); if constexpr (!HALFN) PG_MMA(1, 1, At, B1); PG_BAR; PG_SCHED; \
              \
            PG_LDB(B0, 1, 0); if constexpr (!HALFN) PG_LDB(B1, 1, 1); PG_SCHED; PG_LDA(At, 1, 0); PG_SA_SEL(PG_SA(0, 1), k2, 1, K23S2); \
            PG_WAIT_V(8); PG_WAIT_L(0); PG_BAR; PG_MMA(0, 0, At, B0); if constexpr (!HALFN) PG_MMA(0, 1, At, B1); PG_BAR; PG_SCHED; \
              \
            PG_LDA(At, 1, 1); PG_SB_SEL(PG_SB(1, 0), k3, 0, K23S2); PG_SB_SEL(PG_SB(1, 1), k3, 1, K23S2); PG_SA_SEL(PG_SA(1, 0), k3, 0, K23S2); \
            PG_WAIT_V(8); PG_WAIT_L(0); PG_BAR; PG_MMA(1, 0, At, B0); if constexpr (!HALFN) PG_MMA(1, 1, At, B1); PG_BAR; PG_SCHED; } while (0)
        if constexpr (!SEG2) {
            for (int tt = 0; tt < nt; tt += 2) {
                if constexpr (GATHER) { if (tt == nt - 2) {
                    if (has_next) { gnxt_00 = S.grow_l(nxt, lds, nbuf, R0) + (unsigned)(C0 * 2); gnxt_01 = S.grow_l(nxt, lds, nbuf, R1) + (unsigned)(C1 * 2); gnxt_10 = S.grow_l(nxt, lds, nbuf, 128 + R0) + (unsigned)(C0 * 2); gnxt_11 = S.grow_l(nxt, lds, nbuf, 128 + R1) + (unsigned)(C1 * 2); }
                    else { gnxt_00 = gcur_00; gnxt_01 = gcur_01; gnxt_10 = gcur_10; gnxt_11 = gcur_11; } } }
                PG_TRIP(tt, false, false, false);
            }
        } else {
            for (int tt = 0; tt < nt - 4; tt += 2) PG_TRIP(tt, false, false, false);
            PG_TRIP(nt - 4, false, true, false);
            PG_TRIP(nt - 2, true, false, true);
        }
#undef PG_TRIP
        if (wr == 0) PG_BAR;
        E(acc, cur, wr, wc, fr, fq);
        HK(ui);
        if (!has_next) break;
#pragma unroll
        for (int a = 0; a < 2; ++a)
#pragma unroll
            for (int b = 0; b < 2; ++b)
#pragma unroll
                for (int m = 0; m < 4; ++m)
#pragma unroll
                    for (int n = 0; n < 2; ++n) acc[a][b][m][n] = (f32x4){0.f, 0.f, 0.f, 0.f};
        cur = nxt; ++ui;
        if constexpr (GATHER) { gcur_00 = gnxt_00; gcur_01 = gnxt_01; gcur_10 = gnxt_10; gcur_11 = gnxt_11; }
        if (wr == 1) PG_BAR;
    }
    PG_WAIT_V(0);
    PG_BAR;
#undef PG_SA
#undef PG_SB
#undef PG_GLDS
#undef PG_STAGE_A
#undef PG_STAGE_B
#undef PG_SB_CUR
#undef PG_SA_CUR
#undef PG_SB_SEL
#undef PG_SA_SEL
#undef PG_LDA
#undef PG_LDB
#undef PG_MMA
#undef PG_WAIT_V
#undef PG_WAIT_L
#undef PG_BAR
#undef PG_SCHED
}
}


struct Args { const float* in[25]; float* out; unsigned char* ws; int ph_lo, ph_hi; };

struct Ctx {
    const float* in[25]; float* out; unsigned char* ws; LAS unsigned char* lds;
    int tid, lane, wave, G, bid;
};
#define WSP(T, off) ((T*)(c.ws + (off)))

struct ConvJob { const float* src; bf16* dst; int ld, k0, col0, dK, drow0; };
__device__ __forceinline__ ConvJob conv_job(const Ctx& c, int t);
__device__ __forceinline__ void conv_load(const ConvJob& j, f32x4 (&v)[8]) {
    const int tid = threadIdx.x;
#pragma unroll
    for (int it = 0; it < 8; ++it) { const int kk = it * 16 + (tid >> 5), c4 = tid & 31; v[it] = __builtin_nontemporal_load((const f32x4*)(j.src + (size_t)(j.k0 + kk) * j.ld + j.col0 + c4 * 4)); }
}
__device__ __forceinline__ void conv_to_lds(LAS float* L, const f32x4 (&v)[8]) {
    const int tid = threadIdx.x;
#pragma unroll
    for (int it = 0; it < 8; ++it) { const int kk = it * 16 + (tid >> 5), c4 = tid & 31; LAS float* p = L + kk * 129 + c4 * 4; p[0] = v[it][0]; p[1] = v[it][1]; p[2] = v[it][2]; p[3] = v[it][3]; }
}
__device__ __forceinline__ void conv_store(const LAS float* L, const ConvJob& j) {
    const int tid = threadIdx.x;
    const int rr = tid >> 2, kq = tid & 3; const int sc = (rr & ~31) + perm32(rr & 31);
#pragma unroll
    for (int j8 = 0; j8 < 4; ++j8) {
        float f[8];
#pragma unroll
        for (int q = 0; q < 8; ++q) f[q] = L[(kq * 32 + j8 * 8 + q) * 129 + sc];
        *(u32x4*)(j.dst + (size_t)(j.drow0 + rr) * j.dK + j.k0 + kq * 32 + j8 * 8) = pack8(f);
    }
}

__device__ __forceinline__ void row_load32(const float* __restrict__ p, int lane, float (&v)[32]) {
#pragma unroll
    for (int cch = 0; cch < 4; ++cch) { const f32x4 a = *(const f32x4*)(p + cch * 512 + lane * 8), b = *(const f32x4*)(p + cch * 512 + lane * 8 + 4);
        v[cch * 8 + 0] = a[0]; v[cch * 8 + 1] = a[1]; v[cch * 8 + 2] = a[2]; v[cch * 8 + 3] = a[3]; v[cch * 8 + 4] = b[0]; v[cch * 8 + 5] = b[1]; v[cch * 8 + 6] = b[2]; v[cch * 8 + 7] = b[3]; }
}
__device__ __forceinline__ void row_add_bf16(const bf16* __restrict__ p, int lane, float (&v)[32]) {
#pragma unroll
    for (int cch = 0; cch < 4; ++cch) { const u32x4 w = *(const u32x4*)(p + cch * 512 + lane * 8); float f[8]; unpack8(w, f);
#pragma unroll
        for (int j = 0; j < 8; ++j) v[cch * 8 + j] += f[j]; }
}
__device__ __forceinline__ float row_rstd(const float (&v)[32]) {
    float ss = 0.f;
#pragma unroll
    for (int j = 0; j < 32; ++j) ss += v[j] * v[j];
    ss = wave_sum(ss);
    return rsqrtf(ss * (1.0f / 2048.0f) + EPS);
}
__device__ __forceinline__ void row_store_norm_bf16(bf16* __restrict__ o, const float* __restrict__ g, int lane, const float (&v)[32], float r) {
#pragma unroll
    for (int cch = 0; cch < 4; ++cch) { const f32x4 ga = *(const f32x4*)(g + cch * 512 + lane * 8), gb = *(const f32x4*)(g + cch * 512 + lane * 8 + 4); float f[8];
#pragma unroll
        for (int j = 0; j < 4; ++j) { f[j] = v[cch * 8 + j] * r * ga[j]; f[4 + j] = v[cch * 8 + 4 + j] * r * gb[j]; }
        *(u32x4*)(o + cch * 512 + lane * 8) = pack8(f); }
}

constexpr int CV_IN = 16 * 56, CV_OUT = 16 * 16, CV_GLU = 16 * 32, CV_GU = 2 * 32 * 2 * 128, CV_DN = 2 * 32 * 128;
constexpr int CONV_TOT = CV_IN + CV_OUT + CV_GLU + CV_GU + CV_DN;
#ifndef CONV_IN_GEMM
#define CONV_IN_GEMM 1
#endif
constexpr int CONV_PRO = CONV_IN_GEMM ? CV_IN + CV_OUT : CONV_TOT;
constexpr int CVO_GLU = CV_IN + CV_OUT, CVO_GU = CVO_GLU + CV_GLU, CVO_DN = CVO_GU + CV_GU;
constexpr int CV_GU1_SPLIT = 13;
__device__ __forceinline__ ConvJob conv_job(const Ctx& c, int t) {
    ConvJob j; int i = t;
    if (i < CV_IN) { const int kb = i % 16, cb = i / 16; j.src = c.in[4]; j.ld = NIN; j.k0 = kb * 128; j.col0 = cb * 128; j.dst = WSP(bf16, WS_WIN); j.dK = 2048; j.drow0 = cb * 128; return j; }
    i -= CV_IN;
    if (i < CV_OUT) { const int kb = i % 16, cb = i / 16; j.src = c.in[8]; j.ld = 2048; j.k0 = kb * 128; j.col0 = cb * 128; j.dst = WSP(bf16, WS_WOUT); j.dK = 2048; j.drow0 = cb * 128; return j; }
    i -= CV_OUT;
    if (i < CV_GLU) { const int kb = i % 16, cb = i / 16; j.src = c.in[17]; j.ld = 4096; j.k0 = kb * 128; j.col0 = cb * 128; j.dst = WSP(bf16, WS_WGLU); j.dK = 2048; j.drow0 = cb < 16 ? cb * 256 : (cb - 16) * 256 + 128; return j; }
    i -= CV_GLU;
    if (i < CV_GU) { const int kb = i % 16, cb = (i / 16) % 8, gu = (i / 128) % 2, le = i / 256;
        j.src = (gu ? c.in[23] : c.in[22]) + (size_t)le * 2048 * 1024; j.ld = 1024; j.k0 = kb * 128; j.col0 = cb * 128; j.dst = WSP(bf16, WS_WGU) + (size_t)le * 2048 * 2048; j.dK = 2048; j.drow0 = cb * 256 + gu * 128; return j; }
    i -= CV_GU;
    { const int kb = i % 8, cb = (i / 8) % 16, le = i / 128;
        j.src = c.in[24] + (size_t)le * 1024 * 2048; j.ld = 2048; j.k0 = kb * 128; j.col0 = cb * 128; j.dst = WSP(bf16, WS_WD) + (size_t)le * 2048 * 1024; j.dK = 1024; j.drow0 = cb * 128; return j; }
}

__device__ __forceinline__ int cv_fz(int k) { return (k >> 3) & 7; }
__device__ __forceinline__ void conv_slice(const Ctx& c, int lo0, int n0, int lo1, int n1, int lo2, int n2) {
    const int tot = n0 + n1 + n2, G = c.G;
    const int mine = (tot - c.bid + G - 1) / G;
    if (mine <= 0) return;
    const int tid = c.tid, w = c.wave, lrow = c.lane >> 5, gp = c.lane & 31;
    const int rr0 = tid >> 3, kq = tid & 7;
#define CV_JOB(i) conv_job(c, [&](int ii) { const int v = c.bid + (ii < mine ? ii : mine - 1) * G; return v < n0 ? lo0 + v : (v < n0 + n1 ? lo1 + (v - n0) : lo2 + (v - n0 - n1)); }(i))
#define CV_ISSUE(i, buf) do { const ConvJob _j = CV_JOB(i); _Pragma("unroll") for (int _q = 0; _q < 8; ++_q) { const int _row = 2 * (_q * 8 + w) + lrow; const int _g = gp ^ cv_fz(_row); \
        __builtin_amdgcn_global_load_lds((const unsigned*)(_j.src + (size_t)(_j.k0 + _row) * _j.ld + _j.col0 + _g * 4), (LAS unsigned*)(c.lds + (buf) * 65536 + (_q * 8 + w) * 1024), 16, 0, 2); } } while (0)
    CV_ISSUE(0, 0); CV_ISSUE(1, 1);
    for (int i = 0; i < mine; ++i) {
        if (i == 0) asm volatile("s_waitcnt vmcnt(8)" ::: "memory"); else if (i == 1) asm volatile("s_waitcnt vmcnt(12)" ::: "memory"); else asm volatile("s_waitcnt vmcnt(16)" ::: "memory");
        __builtin_amdgcn_s_barrier();
        asm volatile("" ::: "memory");
        const LAS float* B = (const LAS float*)(c.lds + (i & 1) * 65536);
        u32x4 o[4];
#pragma unroll
        for (int p = 0; p < 2; ++p) { const int rr = rr0 + 64 * p, sc = (rr & ~31) + perm32(rr & 31), scg = sc >> 2, scl = sc & 3;
#pragma unroll
            for (int h = 0; h < 2; ++h) { float f[8];
#pragma unroll
                for (int q = 0; q < 8; ++q) { const int k = 64 * h + kq * 8 + q; f[q] = B[k * 128 + ((scg ^ kq) << 2) + scl]; }
                o[p * 2 + h] = pack8(f); } }
        asm volatile("s_waitcnt lgkmcnt(0)" ::: "memory");
        __builtin_amdgcn_s_barrier();
        asm volatile("" ::: "memory");
        if ((i & 1) == 0) CV_ISSUE(i + 2, 0); else CV_ISSUE(i + 2, 1);
        asm volatile("" ::: "memory");
        { const ConvJob j = CV_JOB(i);
#pragma unroll
          for (int p = 0; p < 2; ++p) { bf16* d = j.dst + (size_t)(j.drow0 + rr0 + 64 * p) * j.dK + j.k0 + kq * 8;
#pragma unroll
              for (int h = 0; h < 2; ++h) *(u32x4*)(d + 64 * h) = o[p * 2 + h]; } }
        asm volatile("" ::: "memory");
    }
    asm volatile("s_waitcnt vmcnt(0)" ::: "memory");
    __builtin_amdgcn_s_barrier();
#undef CV_ISSUE
#undef CV_JOB
}

__device__ __forceinline__ void conv_slice_moe(const Ctx& c, int lo, int n, int nwg, int per_light) {
    const int extra = nwg % c.G, n_light = extra ? c.G - extra : 0;
    int nb = n_light * per_light; if (nb > n) nb = n;
    if (n_light > 0 && c.bid >= extra && nb > 0) { Ctx c2 = c; c2.bid = c.bid - extra; c2.G = n_light; conv_slice(c2, lo, nb, 0, 0, 0, 0); }
    conv_slice(c, lo + nb, n - nb, 0, 0, 0, 0);
}

__device__ __forceinline__ void s5_precompute_group(const Ctx& c, int g) {
    LAS float* AR = (LAS float*)c.lds; LAS float* AI = AR + 64; LAS float* BBR = AI + 64; LAS float* BBI = BBR + 1024;
    LAS float* PR = BBI + 1024; LAS float* PI = PR + 33 * 64; LAS float* CRE = PI + 33 * 64; LAS float* CIM = CRE + 1024;
    const int tid = c.tid;
    if (tid < 64) {
        const int p = tid, i = g * 64 + p;
        const float dt = expf(c.in[11][g]), lr = c.in[9][i], li = c.in[10][i];
        const float mag = expf(lr * dt), ar = mag * cosf(li * dt), ai = mag * sinf(li * dt);
        const float den = lr * lr + li * li;
        const float cr = ((ar - 1.0f) * lr + ai * li) / den, ci = (ai * lr - (ar - 1.0f) * li) / den;
        AR[p] = ar; AI[p] = ai;
        for (int ch = 0; ch < 16; ++ch) { const float br = c.in[12][(size_t)i * 16 + ch], bi = c.in[13][(size_t)i * 16 + ch]; BBR[p * 16 + ch] = cr * br - ci * bi; BBI[p * 16 + ch] = cr * bi + ci * br; }
        float pr = 1.0f, pi = 0.0f; PR[p] = pr; PI[p] = pi;
        for (int tau = 1; tau <= 32; ++tau) { const float nr = pr * ar - pi * ai, ni = pr * ai + pi * ar; pr = nr; pi = ni; PR[tau * 64 + p] = pr; PI[tau * 64 + p] = pi; }
        float* A32 = WSP(float, WS_S5A32) + (size_t)i * 2; A32[0] = pr; A32[1] = pi;
        *(u32x4*)(WSP(bf16, WS_S5ZERO) + (size_t)g * 512 + p * 8) = (u32x4){0u, 0u, 0u, 0u};
    }
    for (int i = tid; i < 1024; i += NTHR) { CRE[i] = c.in[14][(size_t)g * 1024 + i]; CIM[i] = c.in[15][(size_t)g * 1024 + i]; }
    __syncthreads();
    bf16* Rg = WSP(bf16, WS_S5R) + (size_t)g * 16 * 1024;
    for (int idx = tid; idx < 16 * 32 * 16; idx += NTHR) {
        const int co = idx >> 9, tau = (idx >> 4) & 31, ci = idx & 15; float acc = 0.f;
        for (int p = 0; p < 64; ++p) { const float pr = PR[tau * 64 + p], pi = PI[tau * 64 + p], br = BBR[p * 16 + ci], bi = BBI[p * 16 + ci];
            const float wr = pr * br - pi * bi, wi = pr * bi + pi * br; acc += CRE[co * 64 + p] * wr - CIM[co * 64 + p] * wi; }
        Rg[co * 1024 + (31 - tau) * 16 + ci] = f2bf(acc);
    }
    for (int idx = tid; idx < 16 * 64; idx += NTHR) { const int co = idx >> 6, q = idx & 63; *(u32x4*)(Rg + co * 1024 + 512 + q * 8) = (u32x4){0u, 0u, 0u, 0u}; }
    bf16* Wst = WSP(bf16, WS_S5WST) + (size_t)g * 128 * 512;
    for (int idx = tid; idx < 128 * 64; idx += NTHR) {
        const int r = idx >> 6, k8 = idx & 63, sI = k8 >> 1, ci0 = (k8 & 1) * 8; const int j = (r & ~31) + perm32(r & 31), ri = j >> 6, p = j & 63, tau = 31 - sI;
        const float pr = PR[tau * 64 + p], pi = PI[tau * 64 + p]; float f[8];
#pragma unroll
        for (int q = 0; q < 8; ++q) { const float br = BBR[p * 16 + ci0 + q], bi = BBI[p * 16 + ci0 + q]; f[q] = ri ? (pr * bi + pi * br) : (pr * br - pi * bi); }
        *(u32x4*)(Wst + (size_t)r * 512 + k8 * 8) = pack8(f);
    }
    bf16* Wc = WSP(bf16, WS_S5WC) + (size_t)g * 512 * 128;
    for (int idx = tid; idx < 512 * 16; idx += NTHR) {
        const int r = idx >> 4, k8 = idx & 15, ri = k8 >> 3, p0 = (k8 & 7) * 8; const int j = (r & ~31) + perm32(r & 31), t = j >> 4, co = j & 15, n = t + 1; float f[8];
#pragma unroll
        for (int q = 0; q < 8; ++q) { const int p = p0 + q; const float pr = PR[n * 64 + p], pi = PI[n * 64 + p], cr = CRE[co * 64 + p], ci = CIM[co * 64 + p]; f[q] = ri ? (-cr * pi - ci * pr) : (cr * pr - ci * pi); }
        *(u32x4*)(Wc + (size_t)r * 128 + k8 * 8) = pack8(f);
    }
    __syncthreads();
}
__device__ __forceinline__ void ph_prologue(const Ctx& c) {
    LAS float* L = (LAS float*)c.lds;
    if (S5_MFMA) { for (int g = c.bid; g < 128; g += c.G) s5_precompute_group(c, g); }
    conv_slice(c, 0, CONV_PRO, 0, 0, 0, 0);
    __syncthreads();
    {
        const bool bal = S5_MFMA && c.G == 256; const int heavy = c.bid < 128;
        const int nrow = bal ? (heavy ? 6 : 10) : (T_ + c.G * NWAVE - 1) / (c.G * NWAVE);
        const int row0 = bal ? (heavy ? (c.bid * NWAVE + c.wave) * 6 : 128 * NWAVE * 6 + ((c.bid - 128) * NWAVE + c.wave) * 10) : (c.bid * NWAVE + c.wave) * nrow;
        for (int i = 0; i < nrow; ++i) { const int row = row0 + i; if (row >= T_) break;
            float v[32]; row_load32(c.in[0] + (size_t)row * D_, c.lane, v);
            const float r = row_rstd(v);
            row_store_norm_bf16(WSP(bf16, WS_HB) + (size_t)row * D_, c.in[1], c.lane, v, r);
        }
    }
    const int gtid = c.bid * NTHR + c.tid, gn = c.G * NTHR;
    for (int i = gtid; i < 1024; i += gn) { const float a = c.in[6][i], b = c.in[6][1024 + i], m = fmaxf(a, b); const float ea = expf(a - m), eb = expf(b - m); WSP(float, WS_LB)[i] = ea / (ea + eb); }
    for (int i = gtid; i < 128 * 64; i += gn) {
        const int g = i >> 6;
        const float dt = expf(c.in[11][g]), lr = c.in[9][i], li = c.in[10][i];
        const float mag = expf(lr * dt), ar = mag * cosf(li * dt), ai = mag * sinf(li * dt);
        const float den = lr * lr + li * li;
        const float cr = ((ar - 1.0f) * lr + ai * li) / den, ci = (ai * lr - (ar - 1.0f) * li) / den;
        float pr = ar, pi = ai;
#pragma unroll
        for (int s = 0; s < 6; ++s) { const float nr = pr * pr - pi * pi, ni = 2.0f * pr * pi; pr = nr; pi = ni; }
        float* A4 = WSP(float, WS_S5A) + (size_t)i * 4; A4[0] = ar; A4[1] = ai; A4[2] = pr; A4[3] = pi;
        float* Bo = WSP(float, WS_S5B) + (size_t)i * 32;
        for (int ch = 0; ch < 16; ++ch) { const float br = c.in[12][(size_t)i * 16 + ch], bi = c.in[13][(size_t)i * 16 + ch]; Bo[ch] = cr * br - ci * bi; Bo[16 + ch] = cr * bi + ci * br; }
    }
    for (int i = gtid; i < 2 * 48 * 2048; i += gn) {
        const int k = i % 2048, n = (i / 2048) % 48, l = i / (48 * 2048);
        float w = 0.f;
        if (n < 4) w = c.in[18][((size_t)l * 2048 + k) * 4 + n]; else if (n < 36) w = c.in[20][((size_t)l * 2048 + k) * 32 + (n - 4)];
        w *= c.in[2][l * 2048 + k];
        const bf16 hi = f2bf(w), lo = f2bf(w - bf2f(hi));
        bf16* d = WSP(bf16, WS_WR) + ((size_t)(l * 48 + n) * 2) * 2048 + k; d[0] = hi; d[2048] = lo;
    }
}

template <bool PAIRED, class ARow, class Epi>
__device__ __forceinline__ void naive_gemm(const Ctx& c, int M, int N, int K, const ARow& arow, const float* __restrict__ W, const float* __restrict__ W2, int ldw, const Epi& epi) {
    LAS float* As = (LAS float*)c.lds;
    LAS float* Ws = As + 16 * 68;
    LAS float* Ws2 = Ws + 16 * 132;
    const int tid = c.tid, ty = tid >> 5, tx = tid & 31;
    const int ntm = (M + 63) / 64, ntn = N / 128;
    for (int tile = c.bid; tile < ntm * ntn; tile += c.G) {
        const int tm = tile / ntn, tn = tile % ntn, r0 = tm * 64, c0 = tn * 128;
        float a1[4][4], a2[4][4];
#pragma unroll
        for (int i = 0; i < 4; ++i)
#pragma unroll
            for (int j = 0; j < 4; ++j) { a1[i][j] = 0.f; a2[i][j] = 0.f; }
        const int lr = tid >> 3, lk = (tid & 7) * 2;
        const bf16* ap = (r0 + lr < M) ? arow(r0 + lr) : nullptr;
        for (int k0 = 0; k0 < K; k0 += 16) {
            { float x0 = 0.f, x1 = 0.f; if (ap) { const unsigned w = *(const unsigned*)(ap + k0 + lk); x0 = __uint_as_float(w << 16); x1 = __uint_as_float(w & 0xffff0000u); }
              As[lk * 68 + lr] = x0; As[(lk + 1) * 68 + lr] = x1; }
            { const int wk = tid >> 5, w4 = tid & 31; const f32x4 wv = *(const f32x4*)(W + (size_t)(k0 + wk) * ldw + c0 + w4 * 4);
              LAS float* p = Ws + wk * 132 + w4 * 4; p[0] = bf2f(f2bf(wv[0])); p[1] = bf2f(f2bf(wv[1])); p[2] = bf2f(f2bf(wv[2])); p[3] = bf2f(f2bf(wv[3]));
              if (PAIRED) { const f32x4 wv2 = *(const f32x4*)(W2 + (size_t)(k0 + wk) * ldw + c0 + w4 * 4); LAS float* p2 = Ws2 + wk * 132 + w4 * 4;
                  p2[0] = bf2f(f2bf(wv2[0])); p2[1] = bf2f(f2bf(wv2[1])); p2[2] = bf2f(f2bf(wv2[2])); p2[3] = bf2f(f2bf(wv2[3])); } }
            __syncthreads();
#pragma unroll
            for (int kk = 0; kk < 16; ++kk) {
                float av[4], wv[4], wv2[4];
#pragma unroll
                for (int i = 0; i < 4; ++i) av[i] = As[kk * 68 + ty * 4 + i];
#pragma unroll
                for (int j = 0; j < 4; ++j) { wv[j] = Ws[kk * 132 + tx * 4 + j]; if (PAIRED) wv2[j] = Ws2[kk * 132 + tx * 4 + j]; }
#pragma unroll
                for (int i = 0; i < 4; ++i)
#pragma unroll
                    for (int j = 0; j < 4; ++j) { a1[i][j] += av[i] * wv[j]; if (PAIRED) a2[i][j] += av[i] * wv2[j]; }
            }
            __syncthreads();
        }
#pragma unroll
        for (int i = 0; i < 4; ++i) { const int r = r0 + ty * 4 + i; if (r < M)
#pragma unroll
            for (int j = 0; j < 4; ++j) epi(r, c0 + tx * 4 + j, a1[i][j], a2[i][j]); }
    }
}

constexpr size_t ZH_AS = (size_t)2 * 8 * SEQ * 128;
struct EpiZ {
    bf16* Z; bf16* ZH;
    __device__ __forceinline__ void operator()(const f32x4 (&acc)[2][2][4][2], const pg::Unit& u, int wr, int wc, int fr, int fq) const {
        if (u.pn >= 12) {
            const int pp = u.pn - 12, arr = pp >> 2, h0 = (pp & 3) * 2;
#pragma unroll
            for (int ai = 0; ai < 2; ++ai)
#pragma unroll
                for (int m = 0; m < 4; ++m) { const int row = u.pm * 256 + ai * 128 + wr * 64 + m * 16 + fr; const int b = row >> 13, t = row & (SEQ - 1);
#pragma unroll
                    for (int bj = 0; bj < 2; ++bj) { const f32x4 v0 = acc[ai][bj][m][0], v1 = acc[ai][bj][m][1]; u32x4 w; w.x = pk2(v0[0], v0[1]); w.y = pk2(v0[2], v0[3]); w.z = pk2(v1[0], v1[1]); w.w = pk2(v1[2], v1[3]);
                        *(u32x4*)(ZH + (size_t)arr * ZH_AS + ((size_t)((b * 8 + h0 + bj) * SEQ + t)) * 128 + wc * 32 + 8 * fq) = w; } }
            return;
        }
#pragma unroll
        for (int ai = 0; ai < 2; ++ai)
#pragma unroll
            for (int m = 0; m < 4; ++m) { const int row = u.pm * 256 + ai * 128 + wr * 64 + m * 16 + fr; bf16* rp = Z + (size_t)row * NIN + u.pn * 256 + wc * 32 + 8 * fq;
#pragma unroll
                for (int bj = 0; bj < 2; ++bj) { const f32x4 v0 = acc[ai][bj][m][0], v1 = acc[ai][bj][m][1]; u32x4 w; w.x = pk2(v0[0], v0[1]); w.y = pk2(v0[2], v0[3]); w.z = pk2(v1[0], v1[1]); w.w = pk2(v1[2], v1[3]);
                    *(u32x4*)(rp + bj * 128) = w; } }
    }
};
__device__ __forceinline__ void ph_inproj(const Ctx& c) {
    if (NAIVE_GEMM & 1) {
        const bf16* hb = WSP(bf16, WS_HB); bf16* Z = WSP(bf16, WS_Z);
        naive_gemm<false>(c, T_, NIN, 2048, [=](int r) { return hb + (size_t)r * 2048; }, c.in[4], nullptr, NIN, [=](int r, int col, float a, float) { Z[(size_t)r * NIN + col] = f2bf(a); });
    } else {
        pg::DenseSched S; S.init(WSP(bf16, WS_HB), WSP(bf16, WS_WIN), T_, NIN, 2048, c.G, c.bid);
        EpiZ E{WSP(bf16, WS_Z), WSP(bf16, WS_XB)};
        if (CONV_IN_GEMM) {
            const int slot = (c.bid >> 3) % 7; S.i1 = slot + 1; pg::gemm_phase_w(c.lds, S, E, c.wave);
            conv_slice(c, CVO_GLU, CV_GLU + CV_GU / 2, 0, 0, 0, 0);
            S.i0 = slot + 1; S.i1 = 1 << 20; pg::gemm_phase_w(c.lds, S, E, c.wave); }
        else pg::gemm_phase_w(c.lds, S, E, c.wave);
    }
}

constexpr int HS = 132;
__device__ __forceinline__ void hg_load_tile(const Ctx& c, LAS float* dst, const bf16* __restrict__ src  ) {
#pragma unroll
    for (int i = 0; i < 2; ++i) { const int vid = c.tid + i * 512, t = vid >> 4, d8 = vid & 15; const u32x4 w = *(const u32x4*)(src + (size_t)t * NIN + d8 * 8); float f[8]; unpack8(w, f);
        LAS float* p = dst + t * HS + d8 * 8;
#pragma unroll
        for (int j = 0; j < 8; ++j) p[j] = f[j]; }
}
__device__ __forceinline__ void ph_conv_hglocal(const Ctx& c) {
    const bf16* Z = WSP(bf16, WS_Z); bf16* Y = WSP(bf16, WS_YCAT);
    {
        const float* cw = c.in[5];
        const int gtid = c.bid * NTHR + c.tid, gn = c.G * NTHR;
        for (int it = gtid; it < (T_ / 8) * 128; it += gn) {
            const int c8 = it & 127, tb = it >> 7, t0 = tb * 8, ch = c8 * 8;
            float w0[8], w1[8], w2[8];
#pragma unroll
            for (int j = 0; j < 8; ++j) { w0[j] = cw[ch + j]; w1[j] = cw[1024 + ch + j]; w2[j] = cw[2048 + ch + j]; }
            float um2[8], um1[8];
#pragma unroll
            for (int j = 0; j < 8; ++j) { um2[j] = 0.f; um1[j] = 0.f; }
            if ((t0 & (SEQ - 1)) != 0) {
                float a[8], b[8];
                unpack8(*(const u32x4*)(Z + (size_t)(t0 - 2) * NIN + 1024 + ch), a); unpack8(*(const u32x4*)(Z + (size_t)(t0 - 2) * NIN + 2048 + ch), b);
#pragma unroll
                for (int j = 0; j < 8; ++j) um2[j] = a[j] * b[j];
                unpack8(*(const u32x4*)(Z + (size_t)(t0 - 1) * NIN + 1024 + ch), a); unpack8(*(const u32x4*)(Z + (size_t)(t0 - 1) * NIN + 2048 + ch), b);
#pragma unroll
                for (int j = 0; j < 8; ++j) um1[j] = a[j] * b[j];
            }
#pragma unroll
            for (int tt = 0; tt < 8; ++tt) {
                const size_t ro = (size_t)(t0 + tt) * NIN; float ab[8], ac[8], ah[8], o[8];
                unpack8(*(const u32x4*)(Z + ro + ch), ab); unpack8(*(const u32x4*)(Z + ro + 1024 + ch), ac); unpack8(*(const u32x4*)(Z + ro + 2048 + ch), ah);
#pragma unroll
                for (int j = 0; j < 8; ++j) { const float u0 = ac[j] * ah[j]; o[j] = ab[j] * (w0[j] * um2[j] + w1[j] * um1[j] + w2[j] * u0); um2[j] = um1[j]; um1[j] = u0; }
                *(u32x4*)(Y + (size_t)(t0 + tt) * D_ + ch) = pack8(o);
            }
        }
    }
    if (!HG_MFMA) {
        LAS float* B0 = (LAS float*)c.lds; LAS float* B1 = B0 + 64 * HS; LAS float* B2 = B1 + 64 * HS;
        const float* lb = WSP(float, WS_LB); float* KV = WSP(float, WS_KV); float* DEC = WSP(float, WS_HGDEC);
        for (int u = c.bid; u < 2048; u += c.G) {
            const int chunk = u & 127, bh = u >> 7, h = bh & 7, b = bh >> 3; const int t0 = b * SEQ + chunk * 64;
            hg_load_tile(c, B0, Z + (size_t)t0 * NIN + 4096 + h * 128);
            hg_load_tile(c, B2, Z + (size_t)t0 * NIN + 5120 + h * 128);
            __syncthreads();
            for (int i = c.tid; i < 64 * 128; i += 512) { const int t = i >> 7, d = i & 127; const float l = lb[h * 128 + d]; const float f = l + (1.0f - l) * sigmoidf_(B0[t * HS + d]); B0[t * HS + d] = logf(f); B1[t * HS + d] = 1.0f - f; }
            __syncthreads();
            if (c.tid < 128) { float run = 0.f; for (int t = 0; t < 64; ++t) { run += B0[t * HS + c.tid]; B0[t * HS + c.tid] = run; } }
            __syncthreads();
            for (int i = c.tid; i < 64 * 128; i += 512) { const int t = i >> 7, d = i & 127; B1[t * HS + d] *= expf(B0[63 * HS + d] - B0[t * HS + d]); }
            __syncthreads();
            const int kd0 = (c.tid >> 4) * 4, vd0 = (c.tid & 15) * 8;
            float acc[4][8];
#pragma unroll
            for (int i = 0; i < 4; ++i)
#pragma unroll
                for (int j = 0; j < 8; ++j) acc[i][j] = 0.f;
            for (int t = 0; t < 64; ++t) {
                const f32x4 kv = *(const LAS f32x4*)(B1 + t * HS + kd0), va = *(const LAS f32x4*)(B2 + t * HS + vd0), vb = *(const LAS f32x4*)(B2 + t * HS + vd0 + 4);
#pragma unroll
                for (int i = 0; i < 4; ++i) {
#pragma unroll
                    for (int j = 0; j < 4; ++j) { acc[i][j] += kv[i] * va[j]; acc[i][4 + j] += kv[i] * vb[j]; } }
            }
            float* kvp = KV + (size_t)u * 16384;
#pragma unroll
            for (int i = 0; i < 4; ++i) { *(f32x4*)(kvp + (kd0 + i) * 128 + vd0) = (f32x4){acc[i][0], acc[i][1], acc[i][2], acc[i][3]}; *(f32x4*)(kvp + (kd0 + i) * 128 + vd0 + 4) = (f32x4){acc[i][4], acc[i][5], acc[i][6], acc[i][7]}; }
            if (c.tid < 128) DEC[(size_t)u * 128 + c.tid] = expf(B0[63 * HS + c.tid]);
            __syncthreads();
        }
    }
}

__device__ __forceinline__ void ph_hgscan(const Ctx& c) {
    float* KV = WSP(float, WS_KV); const float* DEC = WSP(float, WS_HGDEC);
    const int gtid = c.bid * NTHR + c.tid, gn = c.G * NTHR;
    for (int i = gtid; i < 16 * 16384; i += gn) {
        const int bh = i >> 14, el = i & 16383, kd = el >> 7;
        float s = 0.f;
        for (int c0 = 0; c0 < 128; c0 += 8) {
            float tmp[8], dc[8];
#pragma unroll
            for (int j = 0; j < 8; ++j) { tmp[j] = KV[(size_t)(bh * 128 + c0 + j) * 16384 + el]; dc[j] = DEC[(size_t)(bh * 128 + c0 + j) * 128 + kd]; }
#pragma unroll
            for (int j = 0; j < 8; ++j) { KV[(size_t)(bh * 128 + c0 + j) * 16384 + el] = s; s = dc[j] * s + tmp[j]; }
        }
    }
}

__device__ __forceinline__ void ph_hgout(const Ctx& c) {
    const bf16* Z = WSP(bf16, WS_Z); bf16* Y = WSP(bf16, WS_YCAT);
    LAS float* B0 = (LAS float*)c.lds; LAS float* B1 = B0 + 64 * HS; LAS float* B2 = B1 + 64 * HS; LAS float* B3 = B2 + 64 * HS;
    const float* lb = WSP(float, WS_LB); const float* KV = WSP(float, WS_KV); const float* ng = c.in[7];
    for (int u = c.bid; u < 2048; u += c.G) {
        const int chunk = u & 127, bh = u >> 7, h = bh & 7, b = bh >> 3; const int t0 = b * SEQ + chunk * 64;
        hg_load_tile(c, B0, Z + (size_t)t0 * NIN + 4096 + h * 128);
        hg_load_tile(c, B1, Z + (size_t)t0 * NIN + 3072 + h * 128);
        hg_load_tile(c, B2, Z + (size_t)t0 * NIN + 5120 + h * 128);
        __syncthreads();
        for (int i = c.tid; i < 64 * 128; i += 512) { const int t = i >> 7, d = i & 127; const float l = lb[h * 128 + d]; const float f = l + (1.0f - l) * sigmoidf_(B0[t * HS + d]); B0[t * HS + d] = logf(f); B3[t * HS + d] = 1.0f - f; }
        __syncthreads();
        if (c.tid < 128) { float run = 0.f; for (int t = 0; t < 64; ++t) { run += B0[t * HS + c.tid]; B0[t * HS + c.tid] = run; } }
        __syncthreads();
        const int dd = c.tid & 127; const float ref = B0[31 * HS + dd];
        __syncthreads();
        for (int i = c.tid; i < 64 * 128; i += 512) { const int t = i >> 7; const float bb = B0[t * HS + dd], q = B1[t * HS + dd];
            B1[t * HS + dd] = q * expf(bb); B0[t * HS + dd] = q * expf(bb - ref); B3[t * HS + dd] *= expf(ref - bb); }
        __syncthreads();
        const int tg = c.tid >> 4, vg = c.tid & 15, ta = tg * 2, vd0 = vg * 8;
        float o[2][8];
#pragma unroll
        for (int i = 0; i < 2; ++i)
#pragma unroll
            for (int j = 0; j < 8; ++j) o[i][j] = 0.f;
        {
            const float* sp = KV + (size_t)u * 16384 + vd0;
            for (int kd = 0; kd < 128; kd += 4) {
                const f32x4 qa = *(const LAS f32x4*)(B1 + ta * HS + kd), qb = *(const LAS f32x4*)(B1 + (ta + 1) * HS + kd);
#pragma unroll
                for (int k2 = 0; k2 < 4; ++k2) { const f32x4 s0 = *(const f32x4*)(sp + (size_t)(kd + k2) * 128), s1 = *(const f32x4*)(sp + (size_t)(kd + k2) * 128 + 4);
#pragma unroll
                    for (int j = 0; j < 4; ++j) { o[0][j] += qa[k2] * s0[j]; o[0][4 + j] += qa[k2] * s1[j]; o[1][j] += qb[k2] * s0[j]; o[1][4 + j] += qb[k2] * s1[j]; } }
            }
        }
        __syncthreads();
        {
            const int t = c.tid >> 3, s0 = (c.tid & 7) * 8; float sc[8];
#pragma unroll
            for (int j = 0; j < 8; ++j) sc[j] = 0.f;
            for (int kd = 0; kd < 128; kd += 4) { const f32x4 q = *(const LAS f32x4*)(B0 + t * HS + kd);
#pragma unroll
                for (int j = 0; j < 8; ++j) { const f32x4 k = *(const LAS f32x4*)(B3 + (s0 + j) * HS + kd); sc[j] += q[0] * k[0] + q[1] * k[1] + q[2] * k[2] + q[3] * k[3]; } }
#pragma unroll
            for (int j = 0; j < 8; ++j) B1[t * 68 + s0 + j] = (s0 + j <= t) ? sc[j] : 0.f;
        }
        __syncthreads();
        for (int s = 0; s <= ta + 1; ++s) {
            const float p0 = B1[ta * 68 + s], p1 = B1[(ta + 1) * 68 + s];
            const f32x4 va = *(const LAS f32x4*)(B2 + s * HS + vd0), vb = *(const LAS f32x4*)(B2 + s * HS + vd0 + 4);
#pragma unroll
            for (int j = 0; j < 4; ++j) { o[0][j] += p0 * va[j]; o[0][4 + j] += p0 * vb[j]; o[1][j] += p1 * va[j]; o[1][4 + j] += p1 * vb[j]; }
        }
#pragma unroll
        for (int i = 0; i < 2; ++i) {
            float ss = 0.f;
#pragma unroll
            for (int j = 0; j < 8; ++j) ss += o[i][j] * o[i][j];
            ss += __shfl_xor(ss, 1); ss += __shfl_xor(ss, 2); ss += __shfl_xor(ss, 4); ss += __shfl_xor(ss, 8);
            const float r = rsqrtf(ss * (1.0f / 128.0f) + EPS);
            float g[8], res[8]; unpack8(*(const u32x4*)(Z + (size_t)(t0 + ta + i) * NIN + 6144 + h * 128 + vd0), g);
#pragma unroll
            for (int j = 0; j < 8; ++j) res[j] = o[i][j] * r * ng[vd0 + j] * siluf_(g[j]);
            *(u32x4*)(Y + (size_t)(t0 + ta + i) * D_ + 1024 + h * 128 + vd0) = pack8(res);
        }
        __syncthreads();
    }
}

__device__ __forceinline__ void hg_col16(const bf16* __restrict__ p, unsigned short (&o)[16]) {
#pragma unroll
    for (int i = 0; i < 16; ++i) o[i] = p[(size_t)i * NIN];
}
__device__ __forceinline__ u32x4 pk8us(unsigned short a0, unsigned short a1, unsigned short a2, unsigned short a3, unsigned short a4, unsigned short a5, unsigned short a6, unsigned short a7) {
    u32x4 w; w.x = (unsigned)a0 | ((unsigned)a1 << 16); w.y = (unsigned)a2 | ((unsigned)a3 << 16); w.z = (unsigned)a4 | ((unsigned)a5 << 16); w.w = (unsigned)a6 | ((unsigned)a7 << 16); return w;
}
__device__ __forceinline__ void ph_hgL(const Ctx& c) {
    const bf16* ZH = WSP(bf16, WS_XB); const float* lb = WSP(float, WS_LB); float* KV = WSP(float, WS_KV); float* DEC = WSP(float, WS_HGDEC);
    LAS bf16* VT = (LAS bf16*)c.lds; LAS bf16* KT = VT + 128 * 72; LAS float* SS = (LAS float*)(KT + 128 * 72); LAS bf16* ST = (LAS bf16*)(c.lds + 65536);
    const int d = c.tid & 127, seg = c.tid >> 7, r = c.lane & 31, hh = c.lane >> 5, w = c.wave;
    unsigned short fl[16], vv[16];
    LAS unsigned char* ZW = c.lds + 107520 + w * 4096;
    const int zr = c.lane >> 3, zp = c.lane & 7;
#define HGL_DMA(U) do { const int _c = (U) & 127, _bh = (U) >> 7; const bf16* _z = ZH + ((size_t)_bh * SEQ + _c * 64 + 16 * seg + zr) * 128 + 64 * (w & 1) + zp * 8; \
        _Pragma("unroll") for (int _a = 0; _a < 2; ++_a) _Pragma("unroll") for (int _hr = 0; _hr < 2; ++_hr) \
            __builtin_amdgcn_global_load_lds((const unsigned*)(_z + (size_t)(_a ? 2 : 1) * ZH_AS + (8 * _hr) * 128), (LAS unsigned*)(ZW + _a * 2048 + _hr * 1024), 16, 0, 0); } while (0)
#define HGL_COLS() do { asm volatile("s_waitcnt vmcnt(0)" ::: "memory"); _Pragma("unroll") for (int i = 0; i < 16; ++i) { fl[i] = *(const LAS unsigned short*)(ZW + i * 128 + c.lane * 2); vv[i] = *(const LAS unsigned short*)(ZW + 2048 + i * 128 + c.lane * 2); } \
        asm volatile("s_waitcnt lgkmcnt(0)" ::: "memory"); } while (0)
    if (c.bid < 2048) { HGL_DMA(c.bid); HGL_COLS(); }
    for (int u = c.bid; u < 2048; u += c.G) {
        const int bh = u >> 7, h = bh & 7;
        if (u + c.G < 2048) HGL_DMA(u + c.G);
        const float lbv = lb[h * 128 + d];
        float cs[16], kk[16]; float run = 0.f;
#pragma unroll
        for (int i = 0; i < 16; ++i) { const float f = lbv + (1.0f - lbv) * sigmoidf_(bf2f(fl[i])); kk[i] = 1.0f - f; run += __builtin_amdgcn_logf(f); cs[i] = run; }
        SS[seg * 128 + d] = run;
        __syncthreads();
        const float s0 = SS[d], s1 = SS[128 + d], s2 = SS[256 + d], s3 = SS[384 + d];
        const float prefix = (seg > 0 ? s0 : 0.f) + (seg > 1 ? s1 : 0.f) + (seg > 2 ? s2 : 0.f), total = (s0 + s1) + (s2 + s3);
        float kd[16];
#pragma unroll
        for (int i = 0; i < 16; ++i) kd[i] = kk[i] * __builtin_amdgcn_exp2f(total - prefix - cs[i]);
        { float f0[8], f1[8];
#pragma unroll
          for (int i = 0; i < 8; ++i) { f0[i] = kd[i]; f1[i] = kd[8 + i]; }
          *(LAS u32x4*)(KT + d * 72 + 16 * seg) = pack8(f0); *(LAS u32x4*)(KT + d * 72 + 16 * seg + 8) = pack8(f1);
          *(LAS u32x4*)(VT + d * 72 + 16 * seg) = pk8us(vv[0], vv[1], vv[2], vv[3], vv[4], vv[5], vv[6], vv[7]);
          *(LAS u32x4*)(VT + d * 72 + 16 * seg + 8) = pk8us(vv[8], vv[9], vv[10], vv[11], vv[12], vv[13], vv[14], vv[15]); }
        if (seg == 0) DEC[(size_t)u * 128 + d] = __builtin_amdgcn_exp2f(total);
        __syncthreads();
        const int vdt = w >> 1, kdt0 = (w & 1) * 2;
        f32x16 acc0, acc1;
#pragma unroll
        for (int i = 0; i < 16; ++i) { acc0[i] = 0.f; acc1[i] = 0.f; }
#pragma unroll
        for (int ks = 0; ks < 4; ++ks) {
            const bf16x8 a = *(const LAS bf16x8*)(VT + (32 * vdt + r) * 72 + 16 * ks + 8 * hh);
            const bf16x8 b0 = *(const LAS bf16x8*)(KT + (32 * kdt0 + r) * 72 + 16 * ks + 8 * hh), b1 = *(const LAS bf16x8*)(KT + (32 * (kdt0 + 1) + r) * 72 + 16 * ks + 8 * hh);
            acc0 = __builtin_amdgcn_mfma_f32_32x32x16_bf16(a, b0, acc0, 0, 0, 0); acc1 = __builtin_amdgcn_mfma_f32_32x32x16_bf16(a, b1, acc1, 0, 0, 0);
        }
        bf16* kvp = (bf16*)KV + (size_t)u * 16384;
#pragma unroll
        for (int i = 0; i < 16; ++i) { const int vd = 32 * vdt + (i & 3) + 8 * (i >> 2) + 4 * hh; ST[vd * 136 + 32 * kdt0 + r] = f2bf(acc0[i]); ST[vd * 136 + 32 * (kdt0 + 1) + r] = f2bf(acc1[i]); }
        __syncthreads();
        if (u + c.G < 2048) HGL_COLS();
#pragma unroll
        for (int p = 0; p < 4; ++p) { const int vd = p * 32 + (c.tid >> 4), k0 = (c.tid & 15) * 8;
            *(u32x4*)(kvp + vd * 128 + k0) = *(const LAS u32x4*)(ST + vd * 136 + k0); }
    }
}
#undef HGL_DMA
#undef HGL_COLS
__device__ __forceinline__ void ph_hgS(const Ctx& c) {
    const float* KV = WSP(float, WS_KV); const float* DEC = WSP(float, WS_HGDEC); bf16* SIN = WSP(bf16, WS_SIN);
    const int gtid = c.bid * NTHR + c.tid, gn = c.G * NTHR;
    for (int i = gtid; i < 16 * 8192; i += gn) {
        const int bh = i >> 13, e2 = i & 8191, vd = e2 >> 6, kd = (e2 & 63) * 2;
        float sa = 0.f, sb = 0.f;
        for (int c0 = 0; c0 < 128; c0 += 16) {
            f32x2 kv[16], dc[16];
#pragma unroll
            for (int j = 0; j < 16; ++j) { const unsigned wv = *(const unsigned*)((const bf16*)KV + (size_t)(bh * 128 + c0 + j) * 16384 + vd * 128 + kd); kv[j][0] = __uint_as_float(wv << 16); kv[j][1] = __uint_as_float(wv & 0xffff0000u);
                dc[j] = *(const f32x2*)(DEC + (size_t)(bh * 128 + c0 + j) * 128 + kd); }
#pragma unroll
            for (int j = 0; j < 16; ++j) { *(unsigned*)(SIN + (size_t)(bh * 128 + c0 + j) * 16384 + vd * 128 + kd) = pk2(sa, sb); sa = dc[j][0] * sa + kv[j][0]; sb = dc[j][1] * sb + kv[j][1]; }
        }
    }
}
__device__ __forceinline__ void ph_hgO(const Ctx& c) {
    const bf16* ZH = WSP(bf16, WS_XB); bf16* Y = WSP(bf16, WS_YCAT); const float* lb = WSP(float, WS_LB); const bf16* SIN = WSP(bf16, WS_SIN); const float* ng = c.in[7];
    LAS bf16* QB = (LAS bf16*)c.lds; LAS bf16* QS = QB + 64 * 136; LAS bf16* KS = QS + 64 * 136; LAS bf16* VT = KS + 64 * 136;
    LAS float* SS = (LAS float*)(c.lds + MISC_OFF + 1024); LAS float* RS = SS + 512; LAS float* OT = (LAS float*)(VT + 128 * 72);
    const int d = c.tid & 127, seg = c.tid >> 7, r = c.lane & 31, hh = c.lane >> 5, w = c.wave, vdt = w & 3, tt = w >> 2;
    bf16x8 sfr[8]; unsigned short fl[16], qq[16], vv[16]; u32x4 gn0, gn1;
    const int ot = c.tid >> 3, ovd0 = (c.tid & 7) * 8;
    LAS unsigned char* ZW = c.lds + 104448 + w * 6144;
    const int zr = c.lane >> 3, zp = c.lane & 7;
#define HGO_DMA(U) do { const int _c = (U) & 127, _bh = (U) >> 7; const bf16* _z = ZH + ((size_t)_bh * SEQ + _c * 64 + 16 * seg + zr) * 128 + 64 * (w & 1) + zp * 8; \
        _Pragma("unroll") for (int _a = 0; _a < 3; ++_a) _Pragma("unroll") for (int _hr = 0; _hr < 2; ++_hr) \
            __builtin_amdgcn_global_load_lds((const unsigned*)(_z + (size_t)(_a == 0 ? 1 : _a == 1 ? 0 : 2) * ZH_AS + (8 * _hr) * 128), (LAS unsigned*)(ZW + _a * 2048 + _hr * 1024), 16, 0, 0); } while (0)
#define HGO_LOAD_G(U) do { const int _c = (U) & 127, _bh = (U) >> 7; \
        const bf16* _gp = ZH + 3 * ZH_AS + ((size_t)_bh * SEQ + _c * 64 + ot) * 128 + ovd0; gn0 = *(const u32x4*)_gp; gn1 = *(const u32x4*)(_gp + 64); } while (0)
#define HGO_COLS(NW) do { asm volatile("s_waitcnt vmcnt(" #NW ")" ::: "memory"); _Pragma("unroll") for (int i = 0; i < 16; ++i) { fl[i] = *(const LAS unsigned short*)(ZW + i * 128 + c.lane * 2); \
        qq[i] = *(const LAS unsigned short*)(ZW + 2048 + i * 128 + c.lane * 2); vv[i] = *(const LAS unsigned short*)(ZW + 4096 + i * 128 + c.lane * 2); } asm volatile("s_waitcnt lgkmcnt(0)" ::: "memory"); } while (0)
#define HGO_LOAD_S(U) do { const bf16* _sp = SIN + (size_t)(U) * 16384 + (32 * vdt + r) * 128 + 8 * hh; _Pragma("unroll") for (int k8 = 0; k8 < 8; ++k8) sfr[k8] = *(const bf16x8*)(_sp + 16 * k8); } while (0)
    if (c.bid < 2048) { HGO_DMA(c.bid); HGO_LOAD_G(c.bid); HGO_LOAD_S(c.bid); HGO_COLS(0); }
    for (int u = c.bid; u < 2048; u += c.G) {
        const int chunk = u & 127, bh = u >> 7, h = bh & 7, b = bh >> 3; const int t0 = b * SEQ + chunk * 64;
        const u32x4 gc0 = gn0, gc1 = gn1;
        if (u + c.G < 2048) { HGO_DMA(u + c.G); HGO_LOAD_G(u + c.G); }
        const float lbv = lb[h * 128 + d];
        float cs[16], kk[16]; float run = 0.f;
#pragma unroll
        for (int i = 0; i < 16; ++i) { const float f = lbv + (1.0f - lbv) * sigmoidf_(bf2f(fl[i])); kk[i] = 1.0f - f; run += __builtin_amdgcn_logf(f); cs[i] = run; }
        SS[seg * 128 + d] = run;
        __syncthreads();
        { const float s0 = SS[d], s1 = SS[128 + d], s2 = SS[256 + d];
          const float prefix = (seg > 0 ? s0 : 0.f) + (seg > 1 ? s1 : 0.f) + (seg > 2 ? s2 : 0.f), ref = s0 + s1;
#pragma unroll
          for (int i = 0; i < 16; ++i) { const float bb = prefix + cs[i], q = bf2f(qq[i]); const int t = 16 * seg + i;
              QB[t * 136 + d] = f2bf(q * __builtin_amdgcn_exp2f(bb)); QS[t * 136 + d] = f2bf(q * __builtin_amdgcn_exp2f(bb - ref)); KS[t * 136 + d] = f2bf(kk[i] * __builtin_amdgcn_exp2f(ref - bb)); }
          *(LAS u32x4*)(VT + d * 72 + 16 * seg) = pk8us(vv[0], vv[1], vv[2], vv[3], vv[8], vv[9], vv[10], vv[11]);
          *(LAS u32x4*)(VT + d * 72 + 16 * seg + 8) = pk8us(vv[4], vv[5], vv[6], vv[7], vv[12], vv[13], vv[14], vv[15]); }
        __syncthreads();
        f32x16 acc;
#pragma unroll
        for (int i = 0; i < 16; ++i) acc[i] = 0.f;
#pragma unroll
        for (int k8 = 0; k8 < 8; ++k8) { const bf16x8 bq = *(const LAS bf16x8*)(QB + (32 * tt + r) * 136 + 16 * k8 + 8 * hh); acc = __builtin_amdgcn_mfma_f32_32x32x16_bf16(sfr[k8], bq, acc, 0, 0, 0); }
        if (u + c.G < 2048) HGO_LOAD_S(u + c.G);
        for (int st = 0; st <= tt; ++st) {
            f32x16 x;
#pragma unroll
            for (int i = 0; i < 16; ++i) x[i] = 0.f;
#pragma unroll
            for (int k8 = 0; k8 < 8; ++k8) { const bf16x8 ak = *(const LAS bf16x8*)(KS + (32 * st + r) * 136 + 16 * k8 + 8 * hh), bq = *(const LAS bf16x8*)(QS + (32 * tt + r) * 136 + 16 * k8 + 8 * hh);
                x = __builtin_amdgcn_mfma_f32_32x32x16_bf16(ak, bq, x, 0, 0, 0); }
            if (st == tt) {
#pragma unroll
                for (int i = 0; i < 16; ++i) { const int row = (i & 3) + 8 * (i >> 2) + 4 * hh; if (row > r) x[i] = 0.f; }
            }
#pragma unroll
            for (int sp = 0; sp < 2; ++sp) {
                u32x4 pw; pw.x = pk2(x[8 * sp], x[8 * sp + 1]); pw.y = pk2(x[8 * sp + 2], x[8 * sp + 3]); pw.z = pk2(x[8 * sp + 4], x[8 * sp + 5]); pw.w = pk2(x[8 * sp + 6], x[8 * sp + 7]);
                const bf16x8 pf = __builtin_bit_cast(bf16x8, pw);
                const bf16x8 av = *(const LAS bf16x8*)(VT + (32 * vdt + r) * 72 + 32 * st + 16 * sp + 8 * hh);
                acc = __builtin_amdgcn_mfma_f32_32x32x16_bf16(av, pf, acc, 0, 0, 0);
            }
        }
        { float ss = 0.f;
#pragma unroll
          for (int i = 0; i < 16; ++i) ss += acc[i] * acc[i];
          ss += __shfl_xor(ss, 32);
          if (hh == 0) RS[(tt * 4 + vdt) * 32 + r] = ss;
#pragma unroll
          for (int i4 = 0; i4 < 4; ++i4) *(LAS f32x4*)(OT + (32 * tt + r) * 132 + 32 * vdt + 8 * i4 + 4 * hh) = (f32x4){acc[4 * i4], acc[4 * i4 + 1], acc[4 * i4 + 2], acc[4 * i4 + 3]}; }
        __syncthreads();
        if (u + c.G < 2048) HGO_COLS(8);
        { const int t = ot, vd0 = ovd0;
          const float ssum = (RS[((t >> 5) * 4 + 0) * 32 + (t & 31)] + RS[((t >> 5) * 4 + 1) * 32 + (t & 31)]) + (RS[((t >> 5) * 4 + 2) * 32 + (t & 31)] + RS[((t >> 5) * 4 + 3) * 32 + (t & 31)]);
          const float rr = rsqrtf(ssum * (1.0f / 128.0f) + EPS);
#pragma unroll
          for (int hf = 0; hf < 2; ++hf) { float g[8], o[8]; unpack8(hf ? gc1 : gc0, g);
              const f32x4 oa = *(const LAS f32x4*)(OT + t * 132 + vd0 + 64 * hf), ob = *(const LAS f32x4*)(OT + t * 132 + vd0 + 64 * hf + 4);
#pragma unroll
              for (int j = 0; j < 4; ++j) { o[j] = oa[j] * rr * ng[vd0 + 64 * hf + j] * siluf_(g[j]); o[4 + j] = ob[j] * rr * ng[vd0 + 64 * hf + 4 + j] * siluf_(g[4 + j]); }
              *(u32x4*)(Y + (size_t)(t0 + t) * D_ + 1024 + h * 128 + vd0 + 64 * hf) = pack8(o); } }
    }
}

#undef HGO_DMA
#undef HGO_LOAD_G
#undef HGO_COLS
#undef HGO_LOAD_S
struct EpiRes {
    const float* R; float* O; bf16* HBo; const float* g;
    __device__ __forceinline__ void operator()(const f32x4 (&acc)[2][2][4][2], const pg::Unit& u, int wr, int wc, int fr, int fq) const {
        const int colb = u.pn * 256 + wc * 32 + 8 * fq;
        f32x4 gv[2][2];
#pragma unroll
        for (int bj = 0; bj < 2; ++bj)
#pragma unroll
            for (int n = 0; n < 2; ++n) gv[bj][n] = *(const f32x4*)(g + colb + bj * 128 + n * 4);
#pragma unroll
        for (int ai = 0; ai < 2; ++ai)
#pragma unroll
            for (int m = 0; m < 4; ++m) { const int row = u.pm * 256 + ai * 128 + wr * 64 + m * 16 + fr; const size_t off = (size_t)row * D_ + colb;
#pragma unroll
                for (int bj = 0; bj < 2; ++bj) { f32x4 o[2];
#pragma unroll
                    for (int n = 0; n < 2; ++n) { const f32x4 r = *(const f32x4*)(R + off + bj * 128 + n * 4); o[n] = r + acc[ai][bj][m][n]; *(f32x4*)(O + off + bj * 128 + n * 4) = o[n]; }
                    u32x4 w; w.x = pk2(o[0][0] * gv[bj][0][0], o[0][1] * gv[bj][0][1]); w.y = pk2(o[0][2] * gv[bj][0][2], o[0][3] * gv[bj][0][3]);
                    w.z = pk2(o[1][0] * gv[bj][1][0], o[1][1] * gv[bj][1][1]); w.w = pk2(o[1][2] * gv[bj][1][2], o[1][3] * gv[bj][1][3]);
                    *(u32x4*)(HBo + off + bj * 128) = w; } }
    }
};
__device__ __forceinline__ void ph_outproj(const Ctx& c) {
    if (NAIVE_GEMM & 2) {
        const bf16* A = WSP(bf16, WS_YCAT); const float* X = c.in[0]; float* O = WSP(float, WS_XA); bf16* HBn = WSP(bf16, WS_HB); const float* gn = c.in[2];
        naive_gemm<false>(c, T_, 2048, 2048, [=](int r) { return A + (size_t)r * 2048; }, c.in[8], nullptr, 2048, [=](int r, int col, float a, float) { const float o = X[(size_t)r * 2048 + col] + a; O[(size_t)r * 2048 + col] = o; HBn[(size_t)r * 2048 + col] = f2bf(o * gn[col]); });
    } else {
        pg::DenseSched S; S.init(WSP(bf16, WS_YCAT), WSP(bf16, WS_WOUT), T_, 2048, 2048, c.G, c.bid);
        EpiRes E{c.in[0], WSP(float, WS_XA), WSP(bf16, WS_HB), c.in[2]};
        pg::gemm_phase_w(c.lds, S, E, c.wave);
    }
}

template <int LAYER, bool DRY = false>
__device__ __forceinline__ void ph_router(const Ctx& c, const float* __restrict__ X) {
    constexpr int WST = 264, WBUF = 2 * 48 * WST;
    LAS bf16* WL = (LAS bf16*)c.lds;
    LAS float* P = (LAS float*)c.lds;
    LAS float* SSQ = P + 8 * 16 * 48;
    LAS float* LG = SSQ + 128;
    LAS float* RS = LG + 64 * 48;
    LAS int* DE = (LAS int*)(RS + 64); LAS int* DV = DE + 128; LAS int* LC = DV + 128; LAS int* LB = LC + 32; LAS float* DG = (LAS float*)(LB + 32);
    const bf16* WRS = WSP(bf16, WS_WR) + (size_t)LAYER * 48 * 2 * 2048;
    const float* bc = c.in[19] + LAYER * 4; const float* bfi = c.in[21] + LAYER * 32;
    int* rowl = WSP(int, WS_ROWL) + (size_t)LAYER * NE * CAP; float* tokg = WSP(float, WS_TOKG) + (size_t)LAYER * 2 * T_; float* tokr = WSP(float, WS_TOKR) + (size_t)LAYER * T_; u32x4* rowl16 = WSP(u32x4, WS_ROWL16) + (size_t)LAYER * NE * CAP;
    unsigned* cnt = WSP(unsigned, WS_CTL) + CW_CNT + LAYER * 32;
    const int tok = c.lane & 15, kq = c.lane >> 4, w = c.wave, tg = w & 3, kh = w >> 2;
#define RT_WSRC(idx, cc) (WRS + ((size_t)((((idx) % 1536) >> 5) * 2 + ((((idx) % 1536) & 31) >> 4)) * 2048) + 1024 * ((idx) / 1536) + 128 * (cc) + 8 * ((idx) & 15))
#define RT_WDST(idx, buf) (WL + (buf) * WBUF + (((idx) / 1536) * 48 + (((idx) % 1536) >> 5)) * WST + ((((idx) % 1536) & 31) >> 4) * 128 + 8 * ((idx) & 15))
    for (int pass = c.bid; pass < T_ / 64; pass += c.G) {
        const int t0 = pass * 64;
        const float* xr = X + (size_t)(t0 + 16 * tg + tok) * D_ + 1024 * kh + 8 * kq;
        u32x4 wst[6];
#pragma unroll
        for (int i = 0; i < 6; ++i) wst[i] = *(const u32x4*)RT_WSRC(c.tid + i * 512, 0);
#pragma unroll
        for (int i = 0; i < 6; ++i) *(LAS u32x4*)RT_WDST(c.tid + i * 512, 0) = wst[i];
        f32x4 xn[8];
#pragma unroll
        for (int i = 0; i < 4; ++i) { xn[2 * i] = *(const f32x4*)(xr + 32 * i); xn[2 * i + 1] = *(const f32x4*)(xr + 32 * i + 4); }
        __syncthreads();
        f32x4 acc[3]; acc[0] = acc[1] = acc[2] = (f32x4){0.f, 0.f, 0.f, 0.f};
        float ss = 0.f;
        for (int cc = 0; cc < 8; ++cc) {
            f32x4 xc[8];
#pragma unroll
            for (int i = 0; i < 8; ++i) xc[i] = xn[i];
            if (cc < 7) {
#pragma unroll
                for (int i = 0; i < 6; ++i) wst[i] = *(const u32x4*)RT_WSRC(c.tid + i * 512, cc + 1);
#pragma unroll
                for (int i = 0; i < 4; ++i) { xn[2 * i] = *(const f32x4*)(xr + 128 * (cc + 1) + 32 * i); xn[2 * i + 1] = *(const f32x4*)(xr + 128 * (cc + 1) + 32 * i + 4); }
            }
            const LAS bf16* wb = WL + (cc & 1) * WBUF + (kh * 48 + tok) * WST + 8 * kq;
#pragma unroll
            for (int i = 0; i < 4; ++i) {
                const f32x4 xa = xc[2 * i], xb = xc[2 * i + 1];
                u32x4 hw; hw.x = pk2(xa[0], xa[1]); hw.y = pk2(xa[2], xa[3]); hw.z = pk2(xb[0], xb[1]); hw.w = pk2(xb[2], xb[3]);
                u32x4 lw;
                lw.x = pk2(xa[0] - __uint_as_float(hw.x << 16), xa[1] - __uint_as_float(hw.x & 0xffff0000u)); lw.y = pk2(xa[2] - __uint_as_float(hw.y << 16), xa[3] - __uint_as_float(hw.y & 0xffff0000u));
                lw.z = pk2(xb[0] - __uint_as_float(hw.z << 16), xb[1] - __uint_as_float(hw.z & 0xffff0000u)); lw.w = pk2(xb[2] - __uint_as_float(hw.w << 16), xb[3] - __uint_as_float(hw.w & 0xffff0000u));
                const bf16x8 ahi = __builtin_bit_cast(bf16x8, hw), alo = __builtin_bit_cast(bf16x8, lw);
#pragma unroll
                for (int j = 0; j < 4; ++j) ss += xa[j] * xa[j] + xb[j] * xb[j];
#pragma unroll
                for (int nt = 0; nt < 3; ++nt) {
                    const bf16x8 bhi = *(const LAS bf16x8*)(wb + nt * 16 * WST + 32 * i), blo = *(const LAS bf16x8*)(wb + nt * 16 * WST + 128 + 32 * i);
                    acc[nt] = __builtin_amdgcn_mfma_f32_16x16x32_bf16(ahi, bhi, acc[nt], 0, 0, 0);
                    acc[nt] = __builtin_amdgcn_mfma_f32_16x16x32_bf16(ahi, blo, acc[nt], 0, 0, 0);
                    acc[nt] = __builtin_amdgcn_mfma_f32_16x16x32_bf16(alo, bhi, acc[nt], 0, 0, 0);
                }
            }
            if (cc < 7) {
#pragma unroll
                for (int i = 0; i < 6; ++i) *(LAS u32x4*)RT_WDST(c.tid + i * 512, (cc + 1) & 1) = wst[i];
            }
            __syncthreads();
        }
        ss += __shfl_xor(ss, 16); ss += __shfl_xor(ss, 32);
#pragma unroll
        for (int nt = 0; nt < 3; ++nt)
#pragma unroll
            for (int r = 0; r < 4; ++r) P[(w * 16 + 4 * kq + r) * 48 + 16 * nt + tok] = acc[nt][r];
        if (kq == 0) SSQ[w * 16 + tok] = ss;
        __syncthreads();
        for (int i = c.tid; i < 64 * 48; i += 512) { const int tk = i / 48, n = i % 48, g4 = tk >> 4, tl = tk & 15; LG[i] = P[(g4 * 16 + tl) * 48 + n] + P[((g4 + 4) * 16 + tl) * 48 + n]; }
        if (c.tid < 64) { const int g4 = c.tid >> 4, tl = c.tid & 15; RS[c.tid] = rsqrtf((SSQ[g4 * 16 + tl] + SSQ[(g4 + 4) * 16 + tl]) * (1.0f / 2048.0f) + EPS); }
        __syncthreads();
        if (c.tid < 64) {
            const int t = t0 + c.tid; const float rr = RS[c.tid];
            float lc[4]; int grp = 0; float mx = -3.0e38f;
#pragma unroll
            for (int i = 0; i < 4; ++i) { lc[i] = rr * LG[c.tid * 48 + i] + bc[i]; if (lc[i] > mx) { mx = lc[i]; grp = i; } }
            float den = 0.f;
#pragma unroll
            for (int i = 0; i < 4; ++i) den += expf(lc[i] - mx);
            const float ptop = 1.0f / den;
            float fv[8]; int i0 = 0; float v0 = -3.0e38f;
#pragma unroll
            for (int i = 0; i < 8; ++i) { fv[i] = rr * LG[c.tid * 48 + 4 + grp * 8 + i] + bfi[grp * 8 + i]; if (fv[i] > v0) { v0 = fv[i]; i0 = i; } }
            int i1 = 0; float v1 = -3.0e38f;
#pragma unroll
            for (int i = 0; i < 8; ++i) if (i != i0 && fv[i] > v1) { v1 = fv[i]; i1 = i; }
            const float e1 = expf(v1 - v0); const float w0 = 1.0f / (1.0f + e1), w1 = e1 / (1.0f + e1);
            DE[2 * c.tid] = grp * 8 + i0; DV[2 * c.tid] = 2 * t; DE[2 * c.tid + 1] = grp * 8 + i1; DV[2 * c.tid + 1] = 2 * t + 1;
            DG[2 * c.tid] = ptop * w0; DG[2 * c.tid + 1] = ptop * w1;
            if (!DRY) { tokg[2 * t] = ptop * w0; tokg[2 * t + 1] = ptop * w1; tokr[t] = rr; }
        }
        if (c.tid < 32) LC[c.tid] = 0;
        __syncthreads();
        int rank0 = 0;
        if (c.tid < 128) rank0 = __hip_atomic_fetch_add(&LC[DE[c.tid]], 1, __ATOMIC_RELAXED, __HIP_MEMORY_SCOPE_WORKGROUP);
        __syncthreads();
        if (!DRY && c.tid < 32) { const int n = LC[c.tid]; LB[c.tid] = n ? (int)atomicAdd(&cnt[c.tid], (unsigned)n) : 0; }
        __syncthreads();
        if (!DRY && c.tid < 128) { const int e = DE[c.tid]; const size_t pos = (size_t)e * CAP + LB[e] + rank0; rowl[pos] = DV[c.tid];
            rowl16[pos] = (u32x4){(unsigned)DV[c.tid], __float_as_uint(DG[c.tid]), __float_as_uint(RS[c.tid >> 1]), 0u}; }
        __syncthreads();
    }
}

#undef RT_WSRC
#undef RT_WDST
struct MoeTab { const LAS int* tile0; const LAS int* cnt; const LAS unsigned char* tileExp; int ntiles; };
__device__ __forceinline__ MoeTab moe_tables(const Ctx& c, int layer) {
    LAS int* tile0 = (LAS int*)(c.lds + MISC_OFF + 64); LAS int* cn = (LAS int*)(c.lds + MISC_OFF + 256); LAS unsigned char* te = (LAS unsigned char*)(c.lds + MISC_OFF + 512);
    const unsigned* cnt = WSP(unsigned, WS_CTL) + CW_CNT + layer * 32;
    __syncthreads();
    if (c.tid < 64) {
        const int e = c.tid & 31; const int ce = (int)__hip_atomic_load(cnt + e, __ATOMIC_RELAXED, __HIP_MEMORY_SCOPE_AGENT); const int nt = (ce + 255) >> 8;
        int incl = nt;
#pragma unroll
        for (int o = 1; o < 32; o <<= 1) { const int v = __shfl_up(incl, o, 32); if (e >= o) incl += v; }
        if (c.tid < 32) { const int start = incl - nt; cn[e] = ce; tile0[e] = start; for (int j = 0; j < nt; ++j) te[start + j] = (unsigned char)e; if (e == 31) tile0[NE] = incl; }
    }
    __syncthreads();
    MoeTab t; t.tile0 = tile0; t.cnt = cn; t.tileExp = te; t.ntiles = tile0[NE]; return t;
}
struct EpiGU {
    bf16* H; const LAS unsigned char* lds;
    __device__ __forceinline__ void operator()(const f32x4 (&acc)[2][2][4][2], const pg::Unit& u, int wr, int wc, int fr, int fq) const {
        const LAS u32x4* lst = (const LAS u32x4*)(lds + LIST_OFF + u.lbuf * 4096);
#pragma unroll
        for (int ai = 0; ai < 2; ++ai)
#pragma unroll
            for (int m = 0; m < 4; ++m) { const int r = ai * 128 + wr * 64 + m * 16 + fr; const int slot = u.pm * 256 + r;
                const float rs = r < u.nvalid ? *(const LAS float*)((const LAS unsigned char*)lst + r * 16 + 8) : 0.f;
                u32x4 w = (u32x4){0u, 0u, 0u, 0u};
                if (r < u.nvalid) { float f[8];
#pragma unroll
                    for (int n = 0; n < 2; ++n)
#pragma unroll
                        for (int j = 0; j < 4; ++j) { const float a = rs * acc[ai][0][m][n][j]; f[n * 4 + j] = a * (rs * acc[ai][1][m][n][j]) * __builtin_amdgcn_rcpf(1.0f + __builtin_amdgcn_exp2f(-1.4426950408889634f * a)); }
                    w = pack8(f); }
                *(u32x4*)(H + (size_t)slot * FF + u.pn * 128 + wc * 32 + 8 * fq) = w; }
    }
};
struct EpiDown {
    bf16* Y; const LAS unsigned char* lds;
    __device__ __forceinline__ void operator()(const f32x4 (&acc)[2][2][4][2], const pg::Unit& u, int wr, int wc, int fr, int fq) const {
        const LAS u32x4* lst = (const LAS u32x4*)(lds + LIST_OFF + u.lbuf * 4096);
#pragma unroll
        for (int ai = 0; ai < 2; ++ai)
#pragma unroll
            for (int m = 0; m < 4; ++m) { const int r = ai * 128 + wr * 64 + m * 16 + fr;
                if (r < u.nvalid) { const u32x2 en = *(const LAS u32x2*)((const LAS unsigned char*)lst + r * 16); const int v = (int)en.x; const float g = __uint_as_float(en.y); bf16* rp = Y + (size_t)v * D_ + u.pn * 256 + wc * 32 + 8 * fq;
#pragma unroll
                    for (int bj = 0; bj < 2; ++bj) { float f[8];
#pragma unroll
                        for (int n = 0; n < 2; ++n)
#pragma unroll
                            for (int j = 0; j < 4; ++j) f[n * 4 + j] = g * acc[ai][bj][m][n][j];
                        *(u32x4*)(rp + bj * 128) = pack8(f); } } }
    }
};
template <int LAYER>
__device__ __forceinline__ void ph_moe_gu(const Ctx& c) {
    const MoeTab tb = moe_tables(c, LAYER);
    const int* rowl = WSP(int, WS_ROWL) + (size_t)LAYER * NE * CAP;
    if (NAIVE_GEMM & 4) {
        const bf16* hb = WSP(bf16, WS_HB); bf16* H = WSP(bf16, WS_HID); const float* tokr = WSP(float, WS_TOKR) + (size_t)LAYER * T_;
        for (int rt = 0; rt < tb.ntiles; ++rt) {
            const int e = tb.tileExp[rt], lt = rt - tb.tile0[e], nv = tb.cnt[e] - lt * 256; const int M = nv < 256 ? nv : 256;
            const float* Wg = c.in[22] + ((size_t)LAYER * 32 + e) * 2048 * 1024; const float* Wu = c.in[23] + ((size_t)LAYER * 32 + e) * 2048 * 1024;
            naive_gemm<true>(c, M, 1024, 2048, [=](int r) { return hb + (size_t)(rowl[(size_t)e * CAP + lt * 256 + r] >> 1) * 2048; }, Wg, Wu, 1024,
                             [=](int r, int col, float a, float b) { const float rs = tokr[rowl[(size_t)e * CAP + lt * 256 + r] >> 1]; H[(size_t)(rt * 256 + r) * FF + col] = f2bf(siluf_(rs * a) * (rs * b)); });
        }
    } else {
        pg::MoeSched<true> S; S.A = (const char*)WSP(bf16, WS_HB); S.B = (const char*)(WSP(bf16, WS_WGU) + (size_t)LAYER * 32 * 2048 * 2048); S.nt1 = 32; S.nt2 = 0; S.i0 = 0; S.i1 = 1 << 20; S.nN = 8; S.nwg = tb.ntiles * 8; S.G = c.G; S.c = c.bid;
        S.pitchA = 4096; S.pitchB = 4096; S.hA = 128 * 4096; S.hA2 = 0; S.hB2 = 0; S.A2 = S.A; S.B2 = S.B; S.expStrideB = 2048u * 2048u * 2u; S.tile0 = tb.tile0; S.cnt = tb.cnt; S.tileExp = tb.tileExp; S.rowl = rowl;
        S.rowl16 = WSP(u32x4, WS_ROWL16) + (size_t)LAYER * NE * CAP;
        EpiGU E{WSP(bf16, WS_HID), c.lds};
        if (CONV_IN_GEMM) {
            const int slot = (c.bid >> 3) % 4; S.i1 = slot + 1; pg::gemm_phase_w(c.lds, S, E, c.wave);
            conv_slice_moe(c, CVO_DN + LAYER * (CV_DN / 2), CV_DN / 2, S.nwg, 12);
            S.i0 = slot + 1; S.i1 = 1 << 20; pg::gemm_phase_w(c.lds, S, E, c.wave); }
        else pg::gemm_phase_w(c.lds, S, E, c.wave);
    }
}
template <int LAYER>
__device__ __forceinline__ void ph_moe_down(const Ctx& c) {
    const MoeTab tb = moe_tables(c, LAYER);
    const int* rowl = WSP(int, WS_ROWL) + (size_t)LAYER * NE * CAP; const float* tokg = WSP(float, WS_TOKG) + (size_t)LAYER * 2 * T_;
    bf16* Y = WSP(bf16, WS_KV);
    if (NAIVE_GEMM & 8) {
        const bf16* H = WSP(bf16, WS_HID);
        for (int rt = 0; rt < tb.ntiles; ++rt) {
            const int e = tb.tileExp[rt], lt = rt - tb.tile0[e], nv = tb.cnt[e] - lt * 256; const int M = nv < 256 ? nv : 256;
            const float* Wd = c.in[24] + ((size_t)LAYER * 32 + e) * 1024 * 2048;
            naive_gemm<false>(c, M, 2048, 1024, [=](int r) { return H + (size_t)(rt * 256 + r) * FF; }, Wd, nullptr, 2048,
                              [=](int r, int col, float a, float) { const int v = rowl[(size_t)e * CAP + lt * 256 + r]; Y[(size_t)v * D_ + col] = f2bf(tokg[v] * a); });
        }
    } else {
        pg::MoeSched<false> S; S.A = (const char*)WSP(bf16, WS_HID); S.B = (const char*)(WSP(bf16, WS_WD) + (size_t)LAYER * 32 * 2048 * 1024); S.nt1 = 16; S.nt2 = 0; S.i0 = 0; S.i1 = 1 << 20; S.nN = 8; S.nwg = tb.ntiles * 8; S.G = c.G; S.c = c.bid;
        S.pitchA = 2048; S.pitchB = 2048; S.hA = 128 * 2048; S.hA2 = 0; S.hB2 = 0; S.A2 = S.A; S.B2 = S.B; S.expStrideB = 2048u * 1024u * 2u; S.tile0 = tb.tile0; S.cnt = tb.cnt; S.tileExp = tb.tileExp; S.rowl = rowl;
        S.rowl16 = WSP(u32x4, WS_ROWL16) + (size_t)LAYER * NE * CAP;
        EpiDown E{Y, c.lds};
        if (CONV_IN_GEMM && LAYER == 0) {
            const int slot = (c.bid >> 3) % 4; S.i1 = slot + 1; pg::gemm_phase_w(c.lds, S, E, c.wave);
            conv_slice_moe(c, CVO_GU + CV_GU / 2, CV_GU1_SPLIT * 256, S.nwg, 7);
            S.i0 = slot + 1; S.i1 = 1 << 20; pg::gemm_phase_w(c.lds, S, E, c.wave); }
        else pg::gemm_phase_w(c.lds, S, E, c.wave);
    }
}

template <bool U2L>
__device__ __forceinline__ void ph_res_norm(const Ctx& c, const float* __restrict__ Xin, float* __restrict__ Xout, const float* __restrict__ g, bf16* __restrict__ U) {
    const bf16* Ys = WSP(bf16, WS_KV);
    const int gw = c.bid * NWAVE + c.wave, nw = c.G * NWAVE;
    for (int rb = gw; rb < T_ / 4; rb += nw) {
#pragma unroll 1
        for (int r4 = 0; r4 < 4; ++r4) {
            const int row = rb * 4 + r4;
            float v[32]; row_load32(Xin + (size_t)row * D_, c.lane, v);
            row_add_bf16(Ys + (size_t)(2 * row) * D_, c.lane, v); row_add_bf16(Ys + (size_t)(2 * row + 1) * D_, c.lane, v);
            if (Xout) {
#pragma unroll
            for (int cch = 0; cch < 4; ++cch) { *(f32x4*)(Xout + (size_t)row * D_ + cch * 512 + c.lane * 8) = (f32x4){v[cch * 8], v[cch * 8 + 1], v[cch * 8 + 2], v[cch * 8 + 3]};
                *(f32x4*)(Xout + (size_t)row * D_ + cch * 512 + c.lane * 8 + 4) = (f32x4){v[cch * 8 + 4], v[cch * 8 + 5], v[cch * 8 + 6], v[cch * 8 + 7]}; } }
            const float r = row_rstd(v);
            if (!U2L) row_store_norm_bf16(U + (size_t)row * D_, g, c.lane, v, r);
            else {
#pragma unroll
                for (int cch = 0; cch < 4; ++cch) { const f32x4 ga = *(const f32x4*)(g + cch * 512 + c.lane * 8), gb = *(const f32x4*)(g + cch * 512 + c.lane * 8 + 4); float f[8];
#pragma unroll
                    for (int j = 0; j < 4; ++j) { f[j] = v[cch * 8 + j] * r * ga[j]; f[4 + j] = v[cch * 8 + 4 + j] * r * gb[j]; }
                    *(LAS u32x4*)(c.lds + c.wave * 16640 + r4 * 4160 + cch * 1024 + c.lane * 16) = pack8(f); }
            }
        }
        if (U2L) {
#pragma unroll 4
            for (int it = 0; it < 16; ++it) { const int grp = it * 8 + (c.lane >> 3), r4 = (c.lane >> 1) & 3, hf = c.lane & 1;
                const u32x4 w = *(const LAS u32x4*)(c.lds + c.wave * 16640 + r4 * 4160 + grp * 32 + hf * 16);
                *(u32x4*)(U + ((size_t)grp * T_ + rb * 4 + r4) * 16 + hf * 8) = w; }
        }
    }
}

struct S5aSched {
    static constexpr bool GATHER = false, SEG2 = false, LIST = false, HALFN = true; static constexpr int KSA = 128;
    const char* A; const char* B; const char* A2; const char* B2; int zoff; int nt1, nt2, G, c; int hA, hA2, hB2;
    __device__ __forceinline__ unsigned voffA(int R, int C) const { return (unsigned)(R * 1024 + C * 2); }
    __device__ __forceinline__ unsigned voffB(int R, int C) const { return (unsigned)(R * 1024 + C * 2); }
    __device__ __forceinline__ unsigned voffA2(int, int) const { return 0u; }
    __device__ __forceinline__ unsigned voffB2(int, int) const { return 0u; }
    __device__ __forceinline__ bool next(int i, pg::Unit& u) const {
        const int L = i * G + c; if (L >= 256) return false;
        const int g = L >> 1, pm = L & 1; u.pm = pm; u.pn = 0; u.e = g; u.nvalid = 256;
        u.oA = (unsigned)g * 524288u + (unsigned)pm * 262144u; u.oB = (unsigned)g * 131072u; u.oA2 = 0u; u.oB2 = 0u; u.hB = zoff - (int)u.oB; return true;
    }
    __device__ __forceinline__ unsigned grow(const pg::Unit&, int) const { return 0u; }
    __device__ __forceinline__ void list_issue(const pg::Unit&, LAS unsigned char*, int, int, int) const {}
};
constexpr int LSW = 132;
struct EpiS5Loc {
    float* L; LAS float* LS; int to_lds;
    __device__ __forceinline__ void operator()(const f32x4 (&acc)[2][2][4][2], const pg::Unit& u, int wr, int wc, int fr, int fq) const {
        if (to_lds) {
            asm volatile("s_waitcnt vmcnt(0)" ::: "memory");
            __builtin_amdgcn_s_barrier();
#pragma unroll
            for (int ai = 0; ai < 2; ++ai)
#pragma unroll
                for (int m = 0; m < 4; ++m) { LAS float* rp = LS + (ai * 128 + wr * 64 + m * 16 + fr) * LSW + wc * 32 + 8 * fq;
                    *(LAS f32x4*)rp = acc[ai][0][m][0]; *(LAS f32x4*)(rp + 4) = acc[ai][0][m][1]; }
            return;
        }
#pragma unroll
        for (int ai = 0; ai < 2; ++ai)
#pragma unroll
            for (int m = 0; m < 4; ++m) { const int n = u.pm * 256 + ai * 128 + wr * 64 + m * 16 + fr; float* rp = L + ((size_t)u.e * 512 + n) * 128 + wc * 32 + 8 * fq;
                *(f32x4*)rp = acc[ai][0][m][0]; *(f32x4*)(rp + 4) = acc[ai][0][m][1]; }
    }
};
struct S5cSched {
    static constexpr bool GATHER = false, SEG2 = true, LIST = false, HALFN = false; static constexpr int KSA = 128;
    const char* A; const char* A2; const char* B; const char* B2; int nt1, nt2, G, c; int hA, hA2, hB2; int pnf;
    __device__ __forceinline__ unsigned voffA(int R_, int C) const { return (unsigned)(R_ * 1024 + C * 2); }
    __device__ __forceinline__ unsigned voffA2(int R_, int C) const { return (unsigned)(R_ * 256 + C * 2); }
    __device__ __forceinline__ unsigned voffB(int R_, int C) const { const int pj = perm32(R_ & 31), co = pj & 15, tl = 2 * (R_ >> 5) + (pj >> 4); return (unsigned)(co * 2048 + (31 - tl) * 32 + C * 2); }
    __device__ __forceinline__ unsigned voffB2(int R_, int C) const { return (unsigned)(R_ * 256 + C * 2); }
    __device__ __forceinline__ bool next(int i, pg::Unit& u) const {
        const int L = i * G + c; if (L >= 256) return false;
        const int wgid = (L & 7) * 32 + (L >> 3); const int g = wgid >> 1, pm = wgid & 1, pn = pnf;
        u.pm = pm; u.pn = pn; u.e = g; u.nvalid = 256;
        u.oA = (unsigned)g * 524288u + (unsigned)pm * 262144u; u.oA2 = (unsigned)g * 131072u + (unsigned)pm * 65536u;
        u.oB = (unsigned)(g * 32768 - pn * 512); u.hB = -256; u.oB2 = (unsigned)g * 131072u + (unsigned)pn * 65536u; return true;
    }
    __device__ __forceinline__ unsigned grow(const pg::Unit&, int) const { return 0u; }
    __device__ __forceinline__ void list_issue(const pg::Unit&, LAS unsigned char*, int, int, int) const {}
};
struct EpiS5Out {
    bf16* V; const bf16* U2; const float* dsk;
    __device__ __forceinline__ void operator()(const f32x4 (&acc)[2][2][4][2], const pg::Unit& u, int wr, int wc, int fr, int fq) const {
        const int g = u.e, ch0 = (fq & 1) * 8; float dv[8];
#pragma unroll
        for (int q = 0; q < 8; ++q) dv[q] = dsk[g * 16 + ch0 + q];
#pragma unroll
        for (int ai = 0; ai < 2; ++ai)
#pragma unroll
            for (int m = 0; m < 4; ++m) { const int n = u.pm * 256 + ai * 128 + wr * 64 + m * 16 + fr;
#pragma unroll
                for (int bj = 0; bj < 2; ++bj) { const int t = u.pn * 16 + 8 * bj + 2 * wc + (fq >> 1); const int token = n * 32 + t;
                    float uu[8], o[8]; unpack8(*(const u32x4*)(U2 + ((size_t)g * T_ + token) * 16 + ch0), uu);
#pragma unroll
                    for (int q = 0; q < 8; ++q) o[q] = gelu_tanh(acc[ai][bj][m][q >> 2][q & 3] + dv[q] * uu[q]);
                    *(u32x4*)(V + (((size_t)n * 128 + g) * 32 + t) * 16 + ch0) = pack8(o); } }
    }
};
__device__ __forceinline__ void ph_s5a(const Ctx& c) {
    S5aSched S; S.A = (const char*)WSP(bf16, WS_HB); S.B = (const char*)WSP(bf16, WS_S5WST); S.A2 = S.A; S.B2 = S.B; S.zoff = (int)(WS_S5ZERO - WS_S5WST); S.nt1 = 8; S.nt2 = 0; S.G = c.G; S.c = c.bid; S.hA = 128 * 1024; S.hA2 = 0; S.hB2 = 0;
    EpiS5Loc E{WSP(float, WS_S5LOC), (LAS float*)c.lds, (S5_MERGE && c.G == 256) ? 1 : 0};
    pg::gemm_phase_w(c.lds, S, E, c.wave);
}
__device__ __forceinline__ void ph_s5b(const Ctx& c, bool from_lds) {
    const float* L = WSP(float, WS_S5LOC); bf16* H = WSP(bf16, WS_S5HIN); const float* A32 = WSP(float, WS_S5A32);
    LAS float* LS = (LAS float*)c.lds;
    const int p = c.tid & 63, seg = c.tid >> 6;
    for (int item = c.bid; item < 256; item += c.G) {
        const int g = item >> 1, b = item & 1;
        const size_t base = ((size_t)g * 512 + b * 256) * 128;
        if (!from_lds) {
#pragma unroll
            for (int i = 0; i < 16; ++i) { const int e4 = (i * 512 + c.tid) * 4; const f32x4 v = *(const f32x4*)(L + base + e4); *(LAS f32x4*)(LS + (e4 >> 7) * LSW + (e4 & 127)) = v; }
        }
        const float er = A32[(size_t)(g * 64 + p) * 2], ei = A32[(size_t)(g * 64 + p) * 2 + 1];
        __syncthreads();
        float hr = 0.f, hi = 0.f;
        for (int i = 0; i < 32; ++i) { const int n = seg * 32 + i; const float lr = LS[n * LSW + p], li = LS[n * LSW + 64 + p];
            const float nr = er * hr - ei * hi + lr, ni = er * hi + ei * hr + li; hr = nr; hi = ni; LS[n * LSW + p] = hr; LS[n * LSW + 64 + p] = hi; }
        __syncthreads();
        float pr = er, pi = ei;
#pragma unroll
        for (int q = 0; q < 5; ++q) { const float nr = pr * pr - pi * pi, ni = 2.0f * pr * pi; pr = nr; pi = ni; }
        float cr = 0.f, ci = 0.f;
        for (int sp = 0; sp < seg; ++sp) { const float fr = LS[(sp * 32 + 31) * LSW + p], fi = LS[(sp * 32 + 31) * LSW + 64 + p];
            const float nr = pr * cr - pi * ci + fr, ni = pr * ci + pi * cr + fi; cr = nr; ci = ni; }
        __syncthreads();
        float wr = er, wi = ei;
        for (int i = 0; i < 32; ++i) { const int n = seg * 32 + i;
            const float vr = LS[n * LSW + p] + (wr * cr - wi * ci), vi = LS[n * LSW + 64 + p] + (wr * ci + wi * cr);
            LAS bf16* hb = (LAS bf16*)(LS + n * LSW); hb[p] = f2bf(vr); hb[64 + p] = f2bf(vi);
            const float nr = wr * er - wi * ei, ni = wr * ei + wi * er; wr = nr; wi = ni; }
        __syncthreads();
        bf16* hp = H + base;
#pragma unroll
        for (int ps = 0; ps < 8; ++ps) { const int row = ps * 32 + (c.tid >> 4), piece = c.tid & 15;
            if (row < 255) *(u32x4*)(hp + (size_t)(row + 1) * 128 + piece * 8) = *(const LAS u32x4*)((const LAS unsigned char*)(LS + row * LSW) + piece * 16); }
        if (c.tid < 16) *(u32x4*)(hp + c.tid * 8) = (u32x4){0u, 0u, 0u, 0u};
        __syncthreads();
    }
}
__device__ __forceinline__ void ph_s5c(const Ctx& c) {
    S5cSched S; S.A = (const char*)WSP(bf16, WS_HB); S.A2 = (const char*)WSP(bf16, WS_S5HIN); S.B = (const char*)WSP(bf16, WS_S5R); S.B2 = (const char*)WSP(bf16, WS_S5WC);
    S.nt1 = 8; S.nt2 = 2; S.G = c.G; S.c = c.bid; S.hA = 128 * 1024; S.hA2 = 128 * 256; S.hB2 = 128 * 256;
    EpiS5Out E{WSP(bf16, WS_YCAT), WSP(bf16, WS_HB), c.in[16]};
#pragma unroll 1
    for (int hp = 0; hp < 2; ++hp) { S.pnf = hp; S.nt1 = 4 + 4 * hp; pg::gemm_phase_w(c.lds, S, E, c.wave); }
}

__device__ __forceinline__ void s5_load_u(LAS float* ut, const bf16* __restrict__ U, int tbase, int g, int lane) {
    const bf16* p = U + (size_t)(tbase + lane) * D_ + g * 16; float f0[8], f1[8]; unpack8(*(const u32x4*)p, f0); unpack8(*(const u32x4*)(p + 8), f1);
    LAS float* q = ut + lane * 16;
#pragma unroll
    for (int j = 0; j < 8; ++j) { q[j] = f0[j]; q[8 + j] = f1[j]; }
}
template <int MODE>
__device__ __forceinline__ void ph_s5_chunks(const Ctx& c) {
    const bf16* U = WSP(bf16, WS_HB); bf16* V = WSP(bf16, WS_YCAT); float* LOC = WSP(float, WS_S5L);
    const float* A4 = WSP(float, WS_S5A); const float* BB = WSP(float, WS_S5B);
    LAS float* CR = (LAS float*)c.lds;
    LAS float* CI = CR + 16 * 65;
    LAS float* UT = CI + 16 * 65 + c.wave * 1024;
    LAS float* HR = (LAS float*)c.lds + 2 * 16 * 65 + 8 * 1024 + c.wave * (2 * 16 * 65);
    LAS float* HI = HR + 16 * 65;
    const int p = c.lane;
    for (int item = c.bid; item < 256; item += c.G) {
        const int g = item >> 1, b = item & 1;
        __syncthreads();
        if (MODE == 1) { for (int i = c.tid; i < 1024; i += 512) { const int co = i >> 6, pp = i & 63; CR[co * 65 + pp] = c.in[14][(size_t)g * 1024 + i]; CI[co * 65 + pp] = c.in[15][(size_t)g * 1024 + i]; } }
        __syncthreads();
        const float ar = A4[(size_t)(g * 64 + p) * 4], ai = A4[(size_t)(g * 64 + p) * 4 + 1];
        float br[16], bi[16];
#pragma unroll
        for (int j = 0; j < 16; ++j) { br[j] = BB[(size_t)(g * 64 + p) * 32 + j]; bi[j] = BB[(size_t)(g * 64 + p) * 32 + 16 + j]; }
        for (int chunk = c.wave; chunk < NCH; chunk += NWAVE) {
            const int tbase = b * SEQ + chunk * 64;
            s5_load_u(UT, U, tbase, g, c.lane);
            float hr = 0.f, hi = 0.f;
            const size_t li = ((size_t)((b * NCH + chunk) * 128 + g) * 64 + p) * 2;
            if (MODE == 1) { hr = LOC[li]; hi = LOC[li + 1]; }
            for (int sub = 0; sub < 4; ++sub) {
#pragma unroll 4
                for (int tt = 0; tt < 16; ++tt) {
                    const LAS float* up = UT + (sub * 16 + tt) * 16; float xr = 0.f, xi = 0.f;
#pragma unroll
                    for (int q4 = 0; q4 < 4; ++q4) { const f32x4 u4 = *(const LAS f32x4*)(up + q4 * 4);
#pragma unroll
                        for (int j = 0; j < 4; ++j) { xr += br[q4 * 4 + j] * u4[j]; xi += bi[q4 * 4 + j] * u4[j]; } }
                    const float nr = ar * hr - ai * hi + xr, ni = ar * hi + ai * hr + xi; hr = nr; hi = ni;
                    if (MODE == 1) { HR[tt * 65 + p] = hr; HI[tt * 65 + p] = hi; }
                }
                if (MODE == 1) {
                    const int tl = c.lane & 15, cq = c.lane >> 4; float y[4] = {0.f, 0.f, 0.f, 0.f};
                    for (int pp = 0; pp < 64; ++pp) { const float h_r = HR[tl * 65 + pp], h_i = HI[tl * 65 + pp];
#pragma unroll
                        for (int j = 0; j < 4; ++j) y[j] += CR[(cq * 4 + j) * 65 + pp] * h_r - CI[(cq * 4 + j) * 65 + pp] * h_i; }
                    const int t = tbase + sub * 16 + tl; const LAS float* up = UT + (sub * 16 + tl) * 16 + cq * 4;
                    float o[4];
#pragma unroll
                    for (int j = 0; j < 4; ++j) o[j] = gelu_tanh(y[j] + c.in[16][g * 16 + cq * 4 + j] * up[j]);
                    u32x2 w; w.x = pk2(o[0], o[1]); w.y = pk2(o[2], o[3]);
                    *(u32x2*)(V + (size_t)t * D_ + g * 16 + cq * 4) = w;
                }
            }
            if (MODE == 0) { LOC[li] = hr; LOC[li + 1] = hi; }
        }
    }
}
__device__ __forceinline__ void ph_s5_scan(const Ctx& c) {
    float* LOC = WSP(float, WS_S5L); const float* A4 = WSP(float, WS_S5A);
    const int gtid = c.bid * NTHR + c.tid, gn = c.G * NTHR;
    for (int i = gtid; i < 2 * 128 * 64; i += gn) {
        const int b = i >> 13, gp = i & 8191;
        const float er = A4[(size_t)gp * 4 + 2], ei = A4[(size_t)gp * 4 + 3];
        float hr = 0.f, hi = 0.f;
        for (int ch = 0; ch < NCH; ++ch) { const size_t li = ((size_t)(b * NCH + ch) * 8192 + gp) * 2; const float lr = LOC[li], lim = LOC[li + 1]; LOC[li] = hr; LOC[li + 1] = hi;
            const float nr = er * hr - ei * hi + lr, ni = er * hi + ei * hr + lim; hr = nr; hi = ni; }
    }
}

struct EpiGlu {
    const float* R; float* O; bf16* HBo; const float* g; const bf16* Ys;
    __device__ __forceinline__ void operator()(const f32x4 (&acc)[2][2][4][2], const pg::Unit& u, int wr, int wc, int fr, int fq) const {
        const int colb = u.pn * 128 + wc * 32 + 8 * fq;
        const f32x4 g0 = *(const f32x4*)(g + colb), g1 = *(const f32x4*)(g + colb + 4);
#pragma unroll
        for (int ai = 0; ai < 2; ++ai) {
            f32x4 rv[4][2]; u32x4 ya[4], yb[4];
#pragma unroll
            for (int m = 0; m < 4; ++m) { const size_t row = (size_t)(u.pm * 256 + ai * 128 + wr * 64 + m * 16 + fr);
#pragma unroll
                for (int n = 0; n < 2; ++n) rv[m][n] = *(const f32x4*)(R + row * D_ + colb + n * 4);
                if (Ys) { ya[m] = *(const u32x4*)(Ys + (2 * row) * D_ + colb); yb[m] = *(const u32x4*)(Ys + (2 * row + 1) * D_ + colb); } }
            asm volatile("" ::: "memory");
#pragma unroll
            for (int m = 0; m < 4; ++m) { const size_t off = (size_t)(u.pm * 256 + ai * 128 + wr * 64 + m * 16 + fr) * D_ + colb; f32x4 o[2];
                if (Ys) { float fa[8], fb[8]; unpack8(ya[m], fa); unpack8(yb[m], fb);
#pragma unroll
                    for (int j = 0; j < 4; ++j) { rv[m][0][j] += fa[j] + fb[j]; rv[m][1][j] += fa[4 + j] + fb[4 + j]; } }
#pragma unroll
                for (int n = 0; n < 2; ++n) {
#pragma unroll
                    for (int j = 0; j < 4; ++j) o[n][j] = rv[m][n][j] + acc[ai][0][m][n][j] * sigmoidf_(acc[ai][1][m][n][j]);
                    *(f32x4*)(O + off + n * 4) = o[n]; }
                u32x4 w; w.x = pk2(o[0][0] * g0[0], o[0][1] * g0[1]); w.y = pk2(o[0][2] * g0[2], o[0][3] * g0[3]); w.z = pk2(o[1][0] * g1[0], o[1][1] * g1[1]); w.w = pk2(o[1][2] * g1[2], o[1][3] * g1[3]);
                *(u32x4*)(HBo + off) = w; }
            asm volatile("" ::: "memory");
        }
    }
};
struct GluSched : pg::DenseSched {
    static constexpr int KSA = 4096;
    __device__ __forceinline__ unsigned voffA(int R, int C) const { return (unsigned)((R >> 5) * 131072 + (C >> 4) * 1024 + (R & 31) * 32 + (C & 15) * 2); }
};
__device__ __forceinline__ void ph_glu(const Ctx& c) {
    if (NAIVE_GEMM & 16) {
        const bf16* A = WSP(bf16, WS_YCAT); const float* X = WSP(float, WS_XB); float* O = WSP(float, WS_XA); bf16* HBn = WSP(bf16, WS_HB); const float* gn = c.in[2] + 2048;
        naive_gemm<true>(c, T_, 2048, 2048, [=](int r) { return A + (size_t)r * 2048; }, c.in[17], c.in[17] + 2048, 4096, [=](int r, int col, float a, float b) { const float o = X[(size_t)r * 2048 + col] + a * sigmoidf_(b); O[(size_t)r * 2048 + col] = o; HBn[(size_t)r * 2048 + col] = f2bf(o * gn[col]); });
    } else {
        GluSched S; S.init(WSP(bf16, WS_YCAT), WSP(bf16, WS_WGLU), T_, 4096, 2048, c.G, c.bid);
        EpiGlu E{SKIP_X2 ? WSP(float, WS_XA) : WSP(float, WS_XB), WSP(float, WS_XA), WSP(bf16, WS_HB), c.in[2] + 2048, SKIP_X2 ? WSP(bf16, WS_KV) : (const bf16*)nullptr};
        if (CONV_IN_GEMM) {
            const int slot = (c.bid >> 3) % 4; S.i1 = slot + 1; pg::gemm_phase_w(c.lds, S, E, c.wave);
            conv_slice(c, CVO_GU + CV_GU / 2 + CV_GU1_SPLIT * 256, CV_GU / 2 - CV_GU1_SPLIT * 256, 0, 0, 0, 0);
            S.i0 = slot + 1; S.i1 = 1 << 20; pg::gemm_phase_w(c.lds, S, E, c.wave); }
        else pg::gemm_phase_w(c.lds, S, E, c.wave);
    }
}

__device__ __forceinline__ void ph_final(const Ctx& c) {
    const bf16* Ys = WSP(bf16, WS_KV); const float* X = WSP(float, WS_XA); const float* g = c.in[3];
    const int gw = c.bid * NWAVE + c.wave, nw = c.G * NWAVE;
    for (int row = gw; row < T_; row += nw) {
        float v[32]; row_load32(X + (size_t)row * D_, c.lane, v);
        row_add_bf16(Ys + (size_t)(2 * row) * D_, c.lane, v); row_add_bf16(Ys + (size_t)(2 * row + 1) * D_, c.lane, v);
        const float r = row_rstd(v);
#pragma unroll
        for (int cch = 0; cch < 4; ++cch) { const f32x4 ga = *(const f32x4*)(g + cch * 512 + c.lane * 8), gb = *(const f32x4*)(g + cch * 512 + c.lane * 8 + 4);
            *(f32x4*)(c.out + (size_t)row * D_ + cch * 512 + c.lane * 8) = (f32x4){v[cch * 8] * r * ga[0], v[cch * 8 + 1] * r * ga[1], v[cch * 8 + 2] * r * ga[2], v[cch * 8 + 3] * r * ga[3]};
            *(f32x4*)(c.out + (size_t)row * D_ + cch * 512 + c.lane * 8 + 4) = (f32x4){v[cch * 8 + 4] * r * gb[0], v[cch * 8 + 5] * r * gb[1], v[cch * 8 + 6] * r * gb[2], v[cch * 8 + 7] * r * gb[3]}; }
    }
}

constexpr int NPHASE = 18;
__global__ void __launch_bounds__(NTHR, 2) mk_fwd(Args args) {
    extern __shared__ __attribute__((aligned(16))) unsigned char lds_raw[];
    Ctx c;
#pragma unroll
    for (int i = 0; i < 25; ++i) c.in[i] = args.in[i];
    c.out = args.out; c.ws = args.ws; c.lds = (LAS unsigned char*)lds_raw;
    c.wave = __builtin_amdgcn_readfirstlane((int)threadIdx.x >> 6); c.lane = lane_id(); c.tid = c.wave * 64 + c.lane;     c.G = gridDim.x; c.bid = blockIdx.x;
    const int lo = args.ph_lo, hi = args.ph_hi;
    volatile LAS unsigned* st = (volatile LAS unsigned*)(c.lds + MISC_OFF);
    if (c.tid < 4) st[c.tid] = 0u;
    __syncthreads();
    XcdBarrier bar; bar.bar = WSP(unsigned, WS_CTL) + CW_BAR; bar.x = 0; bar.st = st;
    if (hi - lo > 1) bar = xcd_barrier_post(WSP(unsigned, WS_CTL) + CW_BAR, st, c.tid == 0);
#define IN(k) (lo <= (k) && (k) < hi)
#define SEAM(k) do { c.lane = lane_id(); c.tid = c.wave * 64 + c.lane; if (IN(k) && IN((k) + 1)) { xcd_barrier(bar, c.tid == 0); if (PROBE_DUP & (1 << 30)) xcd_barrier(bar, c.tid == 0); } } while (0)
    if (IN(0)) { ph_prologue(c); if (PROBE_DUP & (1 << 0)) { __syncthreads(); ph_prologue(c); } }
    SEAM(0);
    if (IN(1)) { ph_inproj(c); if (PROBE_DUP & (1 << 1)) { __syncthreads(); ph_inproj(c); } }
    SEAM(1);
    if (IN(2)) { ph_conv_hglocal(c); if (HG_MFMA) ph_hgL(c); if (PROBE_DUP & (1 << 2)) { __syncthreads(); ph_conv_hglocal(c); if (HG_MFMA) ph_hgL(c); } }
    SEAM(2);
    if (IN(3)) { if (HG_MFMA) ph_hgS(c); else ph_hgscan(c); if (PROBE_DUP & (1 << 3)) { __syncthreads(); if (HG_MFMA) ph_hgS(c); else ph_hgscan(c); } }
    SEAM(3);
    if (IN(4)) { if (HG_MFMA) ph_hgO(c); else ph_hgout(c); if (PROBE_DUP & (1 << 4)) { __syncthreads(); if (HG_MFMA) ph_hgO(c); else ph_hgout(c); } }
    SEAM(4);
    if (IN(5)) { ph_outproj(c); if (PROBE_DUP & (1 << 5)) { __syncthreads(); ph_outproj(c); } }
    SEAM(5);
    if (IN(6)) { ph_router<0>(c, WSP(float, WS_XA)); if (PROBE_DUP & (1 << 6)) { __syncthreads(); ph_router<0, true>(c, WSP(float, WS_XA)); } }
    SEAM(6);
    if (IN(7)) { ph_moe_gu<0>(c); if (PROBE_DUP & (1 << 7)) { __syncthreads(); ph_moe_gu<0>(c); } }
    SEAM(7);
    if (IN(8)) { ph_moe_down<0>(c); if (PROBE_DUP & (1 << 8)) { __syncthreads(); ph_moe_down<0>(c); } }
    SEAM(8);
    if (IN(9)) { ph_res_norm<S5_MFMA != 0>(c, WSP(float, WS_XA), (SKIP_X2 && !(NAIVE_GEMM & 16)) ? (float*)nullptr : WSP(float, WS_XB), c.in[1] + 2048, WSP(bf16, WS_HB)); if (PROBE_DUP & (1 << 9)) { __syncthreads(); ph_res_norm<S5_MFMA != 0>(c, WSP(float, WS_XA), (SKIP_X2 && !(NAIVE_GEMM & 16)) ? (float*)nullptr : WSP(float, WS_XB), c.in[1] + 2048, WSP(bf16, WS_HB)); } }
    SEAM(9);
    if (IN(10)) { if (S5_MFMA) { ph_s5a(c); if (S5_MERGE && c.G == 256) { asm volatile("s_waitcnt vmcnt(0)" ::: "memory"); __syncthreads(); ph_s5b(c, true); } } else ph_s5_chunks<0>(c); if (PROBE_DUP & (1 << 10)) { __syncthreads(); if (S5_MFMA) ph_s5a(c); else ph_s5_chunks<0>(c); } }
    if (!(S5_MFMA && S5_MERGE && c.G == 256)) SEAM(10);
    if (IN(11)) { if (S5_MFMA) { if (!(S5_MERGE && c.G == 256)) ph_s5b(c, false); } else ph_s5_scan(c); if (PROBE_DUP & (1 << 11)) { __syncthreads(); if (S5_MFMA) ph_s5b(c, false); else ph_s5_scan(c); } }
    SEAM(11);
    if (IN(12)) { if (S5_MFMA) ph_s5c(c); else ph_s5_chunks<1>(c); if (PROBE_DUP & (1 << 12)) { __syncthreads(); if (S5_MFMA) ph_s5c(c); else ph_s5_chunks<1>(c); } }
    SEAM(12);
    if (IN(13)) { ph_glu(c); if (PROBE_DUP & (1 << 13)) { __syncthreads(); ph_glu(c); } }
    SEAM(13);
    if (IN(14)) { ph_router<1>(c, WSP(float, WS_XA)); if (PROBE_DUP & (1 << 14)) { __syncthreads(); ph_router<1, true>(c, WSP(float, WS_XA)); } }
    SEAM(14);
    if (IN(15)) { ph_moe_gu<1>(c); if (PROBE_DUP & (1 << 15)) { __syncthreads(); ph_moe_gu<1>(c); } }
    SEAM(15);
    if (IN(16)) { ph_moe_down<1>(c); if (PROBE_DUP & (1 << 16)) { __syncthreads(); ph_moe_down<1>(c); } }
    SEAM(16);
    if (IN(17)) { ph_final(c); if (PROBE_DUP & (1 << 17)) { __syncthreads(); ph_final(c); } }
#undef IN
#undef SEAM
}

extern "C" void kernel_launch(void* const* d_in, const int* in_sizes, int n_in, void* d_out, int out_size, void* d_ws, size_t ws_size, hipStream_t stream) {
    static int grid = 0;
    if (grid == 0) {
        if (n_in != 25 || out_size != T_ * D_ || ws_size < WS_END) { fprintf(stderr, "kernel_launch: unexpected shapes (n_in %d out %d ws %zu)\n", n_in, out_size, ws_size); grid = -1; return; }
        int dev = 0, cus = 0, per_cu = 0;
        if (hipGetDevice(&dev) != hipSuccess || hipDeviceGetAttribute(&cus, hipDeviceAttributeMultiprocessorCount, dev) != hipSuccess) { grid = -1; return; }
        if (hipFuncSetAttribute((const void*)mk_fwd, hipFuncAttributeMaxDynamicSharedMemorySize, LDS_BYTES) != hipSuccess) { fprintf(stderr, "kernel_launch: hipFuncSetAttribute failed\n"); grid = -1; return; }
        if (hipOccupancyMaxActiveBlocksPerMultiprocessor(&per_cu, (const void*)mk_fwd, NTHR, LDS_BYTES) != hipSuccess || per_cu < 1) fprintf(stderr, "kernel_launch: occupancy query says %d\n", per_cu);
        (void)hipGetLastError();
        grid = cus;
    }
    if (grid < 0) return;
    (void)hipMemsetAsync((char*)d_ws + WS_CTL, 0, CTL_BYTES, stream);
    Args a{};
    for (int i = 0; i < 25; ++i) a.in[i] = (const float*)d_in[i];
    a.out = (float*)d_out; a.ws = (unsigned char*)d_ws;
#if N_LAUNCH_MODE == 1
    a.ph_lo = 0; a.ph_hi = NPHASE;
    hipLaunchKernelGGL(mk_fwd, dim3(grid), dim3(NTHR), LDS_BYTES, stream, a);
#else
    for (int p = 0; p < NPHASE; ++p) { a.ph_lo = p; a.ph_hi = p + 1; hipLaunchKernelGGL(mk_fwd, dim3(grid), dim3(NTHR), LDS_BYTES, stream, a); }
#endif
}
```

```cpp
#include <hip/hip_runtime.h>
#include <cstdio>
#include <cstdint>

#ifndef N_LAUNCH_MODE
#define N_LAUNCH_MODE 1
#endif
#ifndef NAIVE_GEMM
#define NAIVE_GEMM 0
#endif

#ifndef S5_MFMA
#define S5_MFMA 1
#endif
#ifndef HG_MFMA
#define HG_MFMA 1
#endif
#ifndef S5_MERGE
#define S5_MERGE 1
#endif
#ifndef SKIP_X2
#define SKIP_X2 1
#endif
#ifndef PROBE_DUP
#define PROBE_DUP 0
#endif
#define LAS __attribute__((address_space(3)))
typedef unsigned short bf16;
typedef short bf16x8 __attribute__((ext_vector_type(8)));
typedef float f32x4 __attribute__((ext_vector_type(4)));
typedef float f32x2 __attribute__((ext_vector_type(2)));
typedef float f32x16 __attribute__((ext_vector_type(16)));
typedef unsigned u32x4 __attribute__((ext_vector_type(4)));
typedef unsigned u32x2 __attribute__((ext_vector_type(2)));

constexpr int T_ = 16384, SEQ = 8192, D_ = 2048, NIN = 7168, FF = 1024, NE = 32, CAP = 16384, HSLOT = 40960;
constexpr int NCH = 128;
constexpr float EPS = 1e-6f;
constexpr int NTHR = 512, NWAVE = 8;

constexpr size_t MiB = 1u << 20;
constexpr size_t WS_CTL = 0, CTL_BYTES = 1 * MiB;
constexpr size_t WS_WIN = 1 * MiB;
constexpr size_t WS_WOUT = 29 * MiB;
constexpr size_t WS_WGLU = 37 * MiB;
constexpr size_t WS_WGU = 53 * MiB;
constexpr size_t WS_WD = 565 * MiB;
constexpr size_t WS_HB = 821 * MiB;
constexpr size_t WS_YCAT = 885 * MiB;
constexpr size_t WS_XA = 949 * MiB;
constexpr size_t WS_XB = 1077 * MiB;
constexpr size_t WS_Z = 1205 * MiB;
constexpr size_t WS_KV = 1429 * MiB;
constexpr size_t WS_HID = 1557 * MiB;
constexpr size_t WS_ROWL = 1637 * MiB;
constexpr size_t WS_TOKG = 1641 * MiB;
constexpr size_t WS_TOKR = 1641 * MiB + 262144;
constexpr size_t WS_HGDEC = 1642 * MiB;
constexpr size_t WS_LB = 1643 * MiB;
constexpr size_t WS_S5A = 1643 * MiB + 65536;
constexpr size_t WS_S5B = 1644 * MiB;
constexpr size_t WS_S5L = 1645 * MiB;
constexpr size_t WS_WR = 1661 * MiB;
constexpr size_t WS_S5R = 1662 * MiB;
constexpr size_t WS_S5WST = 1666 * MiB;
constexpr size_t WS_S5WC = 1682 * MiB;
constexpr size_t WS_S5ZERO = 1698 * MiB;
constexpr size_t WS_S5A32 = 1698 * MiB + 524288;
constexpr size_t WS_S5LOC = 1699 * MiB;
constexpr size_t WS_S5HIN = 1731 * MiB;
constexpr size_t WS_SIN = 1747 * MiB;
constexpr size_t WS_ROWL16 = 1811 * MiB;
constexpr size_t WS_END = 1827 * MiB;

constexpr int CW_BAR = 4096;
constexpr int CW_CNT = 8192;

constexpr int LDS_BYTES = 163840;
constexpr int CONV_OFF = 131072;
constexpr int LIST_OFF = 131072;
constexpr int MISC_OFF = 155648;

__device__ __forceinline__ float bf2f(bf16 b) { return __uint_as_float(((unsigned)b) << 16); }
typedef __bf16 bf16x2_t __attribute__((ext_vector_type(2)));
__device__ __forceinline__ unsigned pk2(float lo, float hi) { const f32x2 v = {lo, hi}; return __builtin_bit_cast(unsigned, __builtin_convertvector(v, bf16x2_t)); }
__device__ __forceinline__ bf16 f2bf(float f) { return __builtin_bit_cast(bf16, (__bf16)f); }
__device__ __forceinline__ float sigmoidf_(float x) { return __builtin_amdgcn_rcpf(1.0f + __builtin_amdgcn_exp2f(-1.4426950408889634f * x)); }
__device__ __forceinline__ float siluf_(float x) { return x * __builtin_amdgcn_rcpf(1.0f + __builtin_amdgcn_exp2f(-1.4426950408889634f * x)); }
__device__ __forceinline__ float gelu_tanh(float x) { const float t = x * x; const float p = __builtin_fmaf(t, -0.10294324f, -2.3022082f); return x * __builtin_amdgcn_rcpf(1.0f + __builtin_amdgcn_exp2f(x * p)); }
__device__ __forceinline__ void unpack8(const u32x4 w, float (&o)[8]) {
    o[0] = __uint_as_float(w.x << 16); o[1] = __uint_as_float(w.x & 0xffff0000u); o[2] = __uint_as_float(w.y << 16); o[3] = __uint_as_float(w.y & 0xffff0000u);
    o[4] = __uint_as_float(w.z << 16); o[5] = __uint_as_float(w.z & 0xffff0000u); o[6] = __uint_as_float(w.w << 16); o[7] = __uint_as_float(w.w & 0xffff0000u);
}
__device__ __forceinline__ u32x4 pack8(const float (&v)[8]) { u32x4 w; w.x = pk2(v[0], v[1]); w.y = pk2(v[2], v[3]); w.z = pk2(v[4], v[5]); w.w = pk2(v[6], v[7]); return w; }
__host__ __device__ __forceinline__ int perm32(int rho) { const int n = rho >> 4, i = rho & 15; return 8 * (i >> 2) + 4 * n + (i & 3); }
__device__ __forceinline__ int lane_id() { unsigned z = 0u; asm volatile("" : "+v"(z)); return (int)__builtin_amdgcn_mbcnt_hi(~0u, __builtin_amdgcn_mbcnt_lo(~0u, z)); }
__device__ __forceinline__ float wave_sum(float v) {
#pragma unroll
    for (int o = 32; o >= 1; o >>= 1) v += __shfl_xor(v, o);
    return v;
}

#define XB_TMO      128
#define XB_XCNT(j)  (256  + 64 * (j))
#define XB_XSUB(j)  (1280 + 64 * (j))
#define XB_XGEN(j)  (2304 + 64 * (j))
#define XB_TOP      3328
#define XB_TOPGEN   3392
#define XCD_BAR_WORDS 3456
#define XB_SPIN_CAP (1u << 24)
__device__ __forceinline__ unsigned xb_ld(unsigned* p)              { return __hip_atomic_load(p, __ATOMIC_RELAXED, __HIP_MEMORY_SCOPE_AGENT); }
__device__ __forceinline__ unsigned xb_add(unsigned* p, unsigned v) { return __hip_atomic_fetch_add(p, v, __ATOMIC_RELAXED, __HIP_MEMORY_SCOPE_AGENT); }
__device__ __forceinline__ unsigned xb_xcc_id() { return (unsigned)__builtin_amdgcn_s_getreg((3 << 11) | 20) & 0xFu; }
#define XB_SPIN(cond, bar) do { unsigned _sp = 0; while (cond) { __builtin_amdgcn_s_sleep(1); \
    if ((++_sp & 255u) == 0u) { if (xb_ld(&(bar)[XB_TMO])) break; if (_sp > XB_SPIN_CAP) { atomicAdd(&(bar)[XB_TMO], 1u); break; } } } } while (0)
struct XcdBarrier { unsigned* bar; unsigned x; volatile LAS unsigned* st; };
__device__ __forceinline__ XcdBarrier xcd_barrier_post(unsigned* bar, volatile LAS unsigned* st, bool t0) {
    XcdBarrier b; b.bar = bar; b.x = xb_xcc_id(); b.st = st;
    if (t0) (void)xb_add(&bar[XB_XCNT(b.x)], 1u);
    return b;
}
__device__ __forceinline__ void xcd_barrier_complete(unsigned* bar, unsigned x, unsigned& nloc, unsigned& nx) {
    const unsigned G = gridDim.x * gridDim.y * gridDim.z;
    unsigned sum, cnt, mine, sp = 0u;
    for (;;) {
        sum = 0u; cnt = 0u; mine = 0u;
#pragma unroll
        for (unsigned j = 0; j < 16; ++j) { const unsigned c = xb_ld(&bar[XB_XCNT(j)]); sum += c; cnt += (c > 0u) ? 1u : 0u; mine = (j == x) ? c : mine; }
        if (sum == G) break;
        __builtin_amdgcn_s_sleep(1);
        if ((++sp & 255u) == 0u) { if (xb_ld(&bar[XB_TMO])) break; if (sp > XB_SPIN_CAP) { atomicAdd(&bar[XB_TMO], 1u); break; } }
    }
    nloc = mine > 0u ? mine : 1u; nx = cnt > 0u ? cnt : 1u;
}
__device__ __forceinline__ void xcd_barrier(const XcdBarrier& b, bool t0) {
    asm volatile("s_waitcnt vmcnt(0)" ::: "memory");
    __syncthreads();
    if (t0) {
        unsigned* bar = b.bar;
        __builtin_amdgcn_s_waitcnt(0);
        unsigned nloc = b.st[0], nx = b.st[1];
        if (nloc == 0u) { xcd_barrier_complete(bar, b.x, nloc, nx); b.st[0] = nloc; b.st[1] = nx; }
        const unsigned old = xb_add(&bar[XB_XSUB(b.x)], 1u);
        const unsigned gen = old / nloc;
        if (old + 1u == (gen + 1u) * nloc) {
            __builtin_amdgcn_fence(__ATOMIC_RELEASE, "agent");
            asm volatile("s_waitcnt vmcnt(0)" ::: "memory");
            const unsigned og = xb_add(&bar[XB_TOP], 1u);
            const unsigned tg = og / nx;
            if (og + 1u == (tg + 1u) * nx) xb_add(&bar[XB_TOPGEN], 1u);
            else XB_SPIN(xb_ld(&bar[XB_TOPGEN]) == tg, bar);
            __builtin_amdgcn_fence(__ATOMIC_ACQUIRE, "agent");
            xb_add(&bar[XB_XGEN(b.x)], 1u);
            asm volatile("s_waitcnt vmcnt(0)" ::: "memory");
        } else {
            XB_SPIN(xb_ld(&bar[XB_XGEN(b.x)]) == gen, bar);
            __builtin_amdgcn_fence(__ATOMIC_ACQUIRE, "agent");
            asm volatile("s_waitcnt vmcnt(0)" ::: "memory");
        }
    }
    __syncthreads();
}

namespace pg {
constexpr int BM = 256, BK = 64, HALF = 128, HTB = HALF * BK * 2, STAGE_BYTES = 8 * HTB, NXCD = 8, WGM = 8;
__host__ __device__ __forceinline__ int lds_byte(int r, int c) { const int st = (r >> 4) * 2 + (c >> 5), rr = r & 15, cc = c & 31, ob = rr * 64 + cc * 2; return st * 1024 + (ob ^ (((ob >> 9) & 1) << 5)); }
__host__ __device__ __forceinline__ void stage_rc(int b, int& R, int& C) { const int st = b / 1024, sb = b % 1024, swz = sb ^ (((sb >> 9) & 1) << 5); R = (st >> 1) * 16 + swz / 64; C = (st & 1) * 32 + (swz % 64) / 2; }

struct Unit { unsigned oA, oB, oA2, oB2; int hB, pm, pn, e, nvalid, lbuf; };

struct DenseSched {
    static constexpr bool GATHER = false, SEG2 = false, LIST = false, HALFN = false; static constexpr int KSA = 128;
    const char* A; const char* B; const char* A2; const char* B2; int nt1, nt2, nM, nN, nwg, G, c, i0, i1;
    int pitchA, pitchB, hA, hA2, hB2;
    __device__ __forceinline__ void init(const bf16* A_, const bf16* B_, int M, int N, int K_, int G_, int c_) { A = (const char*)A_; B = (const char*)B_; A2 = A; B2 = B; nt1 = K_ / BK; nt2 = 0; nM = M / BM; nN = N / BM; nwg = nM * nN; G = G_; c = c_; pitchA = K_ * 2; pitchB = K_ * 2; hA = 128 * pitchA; hA2 = 0; hB2 = 0; i0 = 0; i1 = 1 << 20; }
    __device__ __forceinline__ unsigned voffA(int R, int C) const { return (unsigned)(R * pitchA + C * 2); }
    __device__ __forceinline__ unsigned voffB(int R, int C) const { return (unsigned)(R * pitchB + C * 2); }
    __device__ __forceinline__ unsigned voffA2(int, int) const { return 0u; }
    __device__ __forceinline__ unsigned voffB2(int, int) const { return 0u; }
    __device__ __forceinline__ bool next(int i, Unit& u) const {
        if (i0 + i >= i1) return false;
        const long L = (long)(i0 + i) * G + c; if (L >= nwg) return false;
        int wgid = (int)L; { const int q = nwg / NXCD, r = nwg % NXCD, xcd = wgid % NXCD, off = wgid / NXCD; wgid = (xcd < r ? xcd * (q + 1) : r * (q + 1) + (xcd - r) * q) + off; }
        const int nig = WGM * nN, gid = wgid / nig, fm = gid * WGM, gsz = (nM - fm) < WGM ? (nM - fm) : WGM;
        u.pm = fm + ((wgid % nig) % gsz); u.pn = (wgid % nig) / gsz; u.e = 0; u.nvalid = 256;
        u.oA = (unsigned)u.pm * 256u * (unsigned)pitchA; u.oB = (unsigned)u.pn * 256u * (unsigned)pitchB; u.oA2 = 0u; u.oB2 = 0u; u.hB = 128 * pitchB; return true;
    }
    __device__ __forceinline__ unsigned grow(const Unit&, int) const { return 0u; }
    __device__ __forceinline__ void list_issue(const Unit&, LAS unsigned char*, int, int, int) const {}
};

template <bool GATHER_> struct MoeSched {
    static constexpr bool GATHER = GATHER_, SEG2 = false, LIST = true, HALFN = false; static constexpr int KSA = GATHER_ ? 128 : 32768;
    const u32x4* rowl16;
    const char* A; const char* B; const char* A2; const char* B2; int nt1, nt2, nN, nwg, G, c, i0, i1; int pitchA, pitchB, hA, hA2, hB2; unsigned expStrideB;
    const LAS int* tile0; const LAS int* cnt; const LAS unsigned char* tileExp; const int* rowl;
    __device__ __forceinline__ unsigned voffA(int R, int C) const { return (unsigned)(R * pitchA + C * 2); }
    __device__ __forceinline__ unsigned voffB(int R, int C) const { return (unsigned)(R * pitchB + C * 2); }
    __device__ __forceinline__ unsigned voffA2(int, int) const { return 0u; }
    __device__ __forceinline__ unsigned voffB2(int, int) const { return 0u; }
    __device__ __forceinline__ bool next(int i, Unit& u) const {
        if (i0 + i >= i1) return false;
        const long L = (long)(i0 + i) * G + c; if (L >= nwg) return false;
        int wgid = (int)L; { const int q = nwg / NXCD, xcd = wgid % NXCD, off = wgid / NXCD; wgid = xcd * q + off; }
        const int rt = wgid / nN, nt = wgid % nN;
        const int e = __builtin_amdgcn_readfirstlane((int)tileExp[rt]);
        const int lt = rt - __builtin_amdgcn_readfirstlane(tile0[e]);
        const int ce = __builtin_amdgcn_readfirstlane(cnt[e]);
        u.pm = rt; u.pn = nt; u.e = e; u.nvalid = ce - lt * 256;
        u.oA = GATHER ? 0u : (unsigned)rt * 524288u;
        u.oB = (unsigned)e * expStrideB + (unsigned)nt * 256u * (unsigned)pitchB; u.oA2 = 0u; u.oB2 = 0u; u.hB = 128 * pitchB; return true;
    }
    __device__ __forceinline__ void list_issue(const Unit& u, LAS unsigned char* lds, int buf, int wid, int lane) const {
        if (wid < 4) { const u32x4* src = rowl16 + (size_t)u.e * CAP + (size_t)(u.pm - tile0[u.e]) * 256 + wid * 64 + lane;
            __builtin_amdgcn_global_load_lds((const unsigned*)src, (LAS unsigned*)(lds + LIST_OFF + buf * 4096 + wid * 1024), 16, 0, 0); }
    }
    __device__ __forceinline__ unsigned grow_l(const Unit& u, const LAS unsigned char* lds, int buf, int r) const {
        const int v = *(const LAS int*)(lds + LIST_OFF + buf * 4096 + r * 16);
        const int tok = r < u.nvalid ? (v >> 1) : 0;
        return (unsigned)tok * (unsigned)pitchA;
    }
};

struct NoHook { __device__ __forceinline__ void operator()(int) const {} };
template <class Epi, class Sched, class Hook = NoHook>
__device__ __forceinline__ void gemm_phase_w(LAS unsigned char* lds, const Sched& S, const Epi& E, int wave_id, const Hook& HK = Hook()) {
    constexpr bool GATHER = Sched::GATHER, SEG2 = Sched::SEG2, LIST = Sched::LIST, HALFN = Sched::HALFN;
    const int lane = lane_id(), wid = wave_id, tid = wid * 64 + lane, wr = wid >> 2, wc = wid & 3, fr = lane & 15, fq = lane >> 4;
    const int nt1 = S.nt1, nt = S.nt1 + S.nt2;
    int R0, C0, R1, C1; stage_rc(tid * 16, R0, C0); stage_rc(tid * 16 + 8192, R1, C1);
    const unsigned voffA_0 = S.voffA(R0, C0), voffA_1 = S.voffA(R1, C1), voffB_0 = S.voffB(R0, C0), voffB_1 = S.voffB(R1, C1);
    const unsigned voffA2_0 = SEG2 ? S.voffA2(R0, C0) : 0u, voffA2_1 = SEG2 ? S.voffA2(R1, C1) : 0u, voffB2_0 = SEG2 ? S.voffB2(R0, C0) : 0u, voffB2_1 = SEG2 ? S.voffB2(R1, C1) : 0u;
    const int hA = S.hA, hA2 = S.hA2, hB2 = S.hB2;
    const unsigned ldsw = (unsigned)wid * 1024u;
    const int aoff = lds_byte(wr * 64 + fr, fq * 8), boff = lds_byte(wc * 32 + fr, fq * 8);
    unsigned gcur_00 = 0u, gcur_01 = 0u, gcur_10 = 0u, gcur_11 = 0u, gnxt_00 = 0u, gnxt_01 = 0u, gnxt_10 = 0u, gnxt_11 = 0u;
#define PG_SA(b, h) (((b) * 2 + (h)) * HTB)
#define PG_SB(b, h) ((4 + (b) * 2 + (h)) * HTB)
#define PG_GLDS(gp, bufoff, _i) __builtin_amdgcn_global_load_lds((const unsigned*)(gp), (LAS unsigned*)(lds + (bufoff) + ldsw + (_i) * 8192), 16, 0, 0)
#define PG_STAGE_B(bufoff, oB_, oB2_, hB_, kt, h, S2) do { \
        const char* _b = (S2) ? S.B2 + (long)(int)((oB2_) + (unsigned)(((kt) - nt1) * 128 + (h) * hB2)) : S.B + (long)(int)((oB_) + (unsigned)((kt) * 128 + (h) * (hB_))); \
        PG_GLDS(_b + ((S2) ? voffB2_0 : voffB_0), bufoff, 0); PG_GLDS(_b + ((S2) ? voffB2_1 : voffB_1), bufoff, 1); } while (0)
#define PG_STAGE_A(bufoff, oA_, oA2_, kt, h, GV, S2) do { \
        const char* _b = (S2) ? S.A2 + (size_t)((oA2_) + (unsigned)(((kt) - nt1) * 128 + (h) * hA2)) : S.A + (size_t)((oA_) + (unsigned)((kt) * S.KSA + (GATHER ? 0 : (h) * hA))); \
        if constexpr (GATHER) { PG_GLDS(_b + (GV##_##h##0), bufoff, 0); PG_GLDS(_b + (GV##_##h##1), bufoff, 1); } \
        else { PG_GLDS(_b + ((S2) ? voffA2_0 : voffA_0), bufoff, 0); PG_GLDS(_b + ((S2) ? voffA2_1 : voffA_1), bufoff, 1); } } while (0)
#define PG_SB_CUR(bufoff, kt, h, S2) PG_STAGE_B(bufoff, cur.oB, cur.oB2, cur.hB, kt, h, S2)
#define PG_SA_CUR(bufoff, kt, h, S2) PG_STAGE_A(bufoff, cur.oA, cur.oA2, kt, h, gcur, S2)
#define PG_SB_SEL(bufoff, kt, h, S2) PG_STAGE_B(bufoff, s_oB, s_oB2, s_hB, kt, h, S2)
#define PG_SA_SEL(bufoff, kt, h, S2) PG_STAGE_A(bufoff, s_oA, s_oA2, kt, h, gsel, S2)
#define PG_LDA(dst, b, h) do { _Pragma("unroll") for (int m = 0; m < 4; ++m) _Pragma("unroll") for (int k = 0; k < 2; ++k) dst[m][k] = *(const LAS bf16x8*)(lds + PG_SA(b, h) + aoff + m * 2048 + k * 1024); } while (0)
#define PG_LDB(dst, b, h) do { _Pragma("unroll") for (int n = 0; n < 2; ++n) _Pragma("unroll") for (int k = 0; k < 2; ++k) dst[n][k] = *(const LAS bf16x8*)(lds + PG_SB(b, h) + boff + n * 2048 + k * 1024); } while (0)
#define PG_MMA(ai, bj, At, Bt) do { __builtin_amdgcn_s_setprio(1); _Pragma("unroll") for (int m = 0; m < 4; ++m) _Pragma("unroll") for (int n = 0; n < 2; ++n) _Pragma("unroll") for (int k = 0; k < 2; ++k) \
        acc[ai][bj][m][n] = __builtin_amdgcn_mfma_f32_16x16x32_bf16(Bt[n][k], At[m][k], acc[ai][bj][m][n], 0, 0, 0); __builtin_amdgcn_s_setprio(0); } while (0)
#define PG_WAIT_V(n) asm volatile("s_waitcnt vmcnt(" #n ")" ::: "memory")
#define PG_WAIT_L(n) asm volatile("s_waitcnt lgkmcnt(" #n ")" ::: "memory")
#define PG_BAR __builtin_amdgcn_s_barrier()
#define PG_SCHED __builtin_amdgcn_sched_barrier(0)
    Unit cur, nxt; int ui = 0;
    if (!S.next(0, cur)) return;
    f32x4 acc[2][2][4][2];
#pragma unroll
    for (int a = 0; a < 2; ++a)
#pragma unroll
        for (int b = 0; b < 2; ++b)
#pragma unroll
            for (int m = 0; m < 4; ++m)
#pragma unroll
                for (int n = 0; n < 2; ++n) acc[a][b][m][n] = (f32x4){0.f, 0.f, 0.f, 0.f};
    bf16x8 At[4][2], B0[2][2], B1[2][2];
    cur.lbuf = 0;
    if constexpr (LIST) {
        S.list_issue(cur, lds, 0, wid, lane);
        asm volatile("s_waitcnt vmcnt(0)" ::: "memory"); __builtin_amdgcn_s_barrier(); asm volatile("" ::: "memory");
    }
    if constexpr (GATHER) {
        gcur_00 = S.grow_l(cur, lds, 0, R0) + (unsigned)(C0 * 2); gcur_01 = S.grow_l(cur, lds, 0, R1) + (unsigned)(C1 * 2); gcur_10 = S.grow_l(cur, lds, 0, 128 + R0) + (unsigned)(C0 * 2); gcur_11 = S.grow_l(cur, lds, 0, 128 + R1) + (unsigned)(C1 * 2);
    }
    PG_SB_CUR(PG_SB(0, 0), 0, 0, false); PG_SB_CUR(PG_SB(0, 1), 0, 1, false); PG_SA_CUR(PG_SA(0, 0), 0, 0, false); PG_SA_CUR(PG_SA(0, 1), 0, 1, false);
    if (wr == 1) PG_BAR;
    PG_WAIT_V(2); PG_BAR;
    PG_SB_CUR(PG_SB(1, 0), 1, 0, false); PG_SA_CUR(PG_SA(1, 0), 1, 0, false); PG_SB_CUR(PG_SB(1, 1), 1, 1, false);
    PG_WAIT_V(6); PG_BAR;
    for (;;) {
        const bool has_next = S.next(ui + 1, nxt);
        if (!has_next) nxt = cur;
        const int nbuf = (ui + 1) % 3; nxt.lbuf = has_next ? nbuf : cur.lbuf;
        if constexpr (LIST) { if (has_next) S.list_issue(nxt, lds, nbuf, wid, lane); }
#define PG_TRIP(T, A1S2, K23S2, LAST) do { const int t = (T); const bool last = (t == nt - 2); (void)(LAST); \
            const unsigned s_oA = last ? nxt.oA : cur.oA, s_oB = last ? nxt.oB : cur.oB, s_oA2 = last ? nxt.oA2 : cur.oA2, s_oB2 = last ? nxt.oB2 : cur.oB2; const int s_hB = last ? nxt.hB : cur.hB; \
            const int k2 = last ? 0 : t + 2, k3 = k2 + 1; \
            const unsigned gsel_00 = last ? gnxt_00 : gcur_00, gsel_01 = last ? gnxt_01 : gcur_01, gsel_10 = last ? gnxt_10 : gcur_10, gsel_11 = last ? gnxt_11 : gcur_11; \
            (void)s_oA2; (void)s_oB2; (void)gsel_00; (void)gsel_01; (void)gsel_10; (void)gsel_11; \
              \
            PG_LDB(B0, 0, 0); if constexpr (!HALFN) PG_LDB(B1, 0, 1); PG_SCHED; PG_LDA(At, 0, 0); PG_SA_CUR(PG_SA(1, 1), t + 1, 1, A1S2); \
            PG_WAIT_V(8); PG_WAIT_L(0); PG_BAR; PG_MMA(0, 0, At, B0); if constexpr (!HALFN) PG_MMA(0, 1, At, B1); PG_BAR; PG_SCHED; \
              \
            PG_LDA(At, 0, 1); PG_SB_SEL(PG_SB(0, 0), k2, 0, K23S2); PG_SB_SEL(PG_SB(0, 1), k2, 1, K23S2); PG_SA_SEL(PG_SA(0, 0), k2, 0, K23S2); \
            PG_WAIT_V(8); PG_WAIT_L(0); PG_BAR; PG_MMA(1, 0, At, B0); if constexpr (!HALFN) PG_MMA(1, 1, At, B1); PG_BAR; PG_SCHED; \
              \
            PG_LDB(B0, 1, 0); if constexpr (!HALFN) PG_LDB(B1, 1, 1); PG_SCHED; PG_LDA(At, 1, 0); PG_SA_SEL(PG_SA(0, 1), k2, 1, K23S2); \
            PG_WAIT_V(8); PG_WAIT_L(0); PG_BAR; PG_MMA(0, 0, At, B0); if constexpr (!HALFN) PG_MMA(0, 1, At, B1); PG_BAR; PG_SCHED; \
              \
            PG_LDA(At, 1, 1); PG_SB_SEL(PG_SB(1, 0), k3, 0, K23S2); PG_SB_SEL(PG_SB(1, 1), k3, 1, K23S2); PG_SA_SEL(PG_SA(1, 0), k3, 0, K23S2); \
            PG_WAIT_V(8); PG_WAIT_L(0); PG_BAR; PG_MMA(1, 0, At, B0); if constexpr (!HALFN) PG_MMA(1, 1, At, B1); PG_BAR; PG_SCHED; } while (0)
        if constexpr (!SEG2) {
            for (int tt = 0; tt < nt; tt += 2) {
                if constexpr (GATHER) { if (tt == nt - 2) {
                    if (has_next) { gnxt_00 = S.grow_l(nxt, lds, nbuf, R0) + (unsigned)(C0 * 2); gnxt_01 = S.grow_l(nxt, lds, nbuf, R1) + (unsigned)(C1 * 2); gnxt_10 = S.grow_l(nxt, lds, nbuf, 128 + R0) + (unsigned)(C0 * 2); gnxt_11 = S.grow_l(nxt, lds, nbuf, 128 + R1) + (unsigned)(C1 * 2); }
                    else { gnxt_00 = gcur_00; gnxt_01 = gcur_01; gnxt_10 = gcur_10; gnxt_11 = gcur_11; } } }
                PG_TRIP(tt, false, false, false);
            }
        } else {
            for (int tt = 0; tt < nt - 4; tt += 2) PG_TRIP(tt, false, false, false);
            PG_TRIP(nt - 4, false, true, false);
            PG_TRIP(nt - 2, true, false, true);
        }
#undef PG_TRIP
        if (wr == 0) PG_BAR;
        E(acc, cur, wr, wc, fr, fq);
        HK(ui);
        if (!has_next) break;
#pragma unroll
        for (int a = 0; a < 2; ++a)
#pragma unroll
            for (int b = 0; b < 2; ++b)
#pragma unroll
                for (int m = 0; m < 4; ++m)
#pragma unroll
                    for (int n = 0; n < 2; ++n) acc[a][b][m][n] = (f32x4){0.f, 0.f, 0.f, 0.f};
        cur = nxt; ++ui;
        if constexpr (GATHER) { gcur_00 = gnxt_00; gcur_01 = gnxt_01; gcur_10 = gnxt_10; gcur_11 = gnxt_11; }
        if (wr == 1) PG_BAR;
    }
    PG_WAIT_V(0);
    PG_BAR;
#undef PG_SA
#undef PG_SB
#undef PG_GLDS
#undef PG_STAGE_A
#undef PG_STAGE_B
#undef PG_SB_CUR
#undef PG_SA_CUR
#undef PG_SB_SEL
#undef PG_SA_SEL
#undef PG_LDA
#undef PG_LDB
#undef PG_MMA
#undef PG_WAIT_V
#undef PG_WAIT_L
#undef PG_BAR
#undef PG_SCHED
}
}


struct Args { const float* in[25]; float* out; unsigned char* ws; int ph_lo, ph_hi; };

struct Ctx {
    const float* in[25]; float* out; unsigned char* ws; LAS unsigned char* lds;
    int tid, lane, wave, G, bid;
};
#define WSP(T, off) ((T*)(c.ws + (off)))

struct ConvJob { const float* src; bf16* dst; int ld, k0, col0, dK, drow0; };
__device__ __forceinline__ ConvJob conv_job(const Ctx& c, int t);
__device__ __forceinline__ void conv_load(const ConvJob& j, f32x4 (&v)[8]) {
    const int tid = threadIdx.x;
#pragma unroll
    for (int it = 0; it < 8; ++it) { const int kk = it * 16 + (tid >> 5), c4 = tid & 31; v[it] = __builtin_nontemporal_load((const f32x4*)(j.src + (size_t)(j.k0 + kk) * j.ld + j.col0 + c4 * 4)); }
}
__device__ __forceinline__ void conv_to_lds(LAS float* L, const f32x4 (&v)[8]) {
    const int tid = threadIdx.x;
#pragma unroll
    for (int it = 0; it < 8; ++it) { const int kk = it * 16 + (tid >> 5), c4 = tid & 31; LAS float* p = L + kk * 129 + c4 * 4; p[0] = v[it][0]; p[1] = v[it][1]; p[2] = v[it][2]; p[3] = v[it][3]; }
}
__device__ __forceinline__ void conv_store(const LAS float* L, const ConvJob& j) {
    const int tid = threadIdx.x;
    const int rr = tid >> 2, kq = tid & 3; const int sc = (rr & ~31) + perm32(rr & 31);
#pragma unroll
    for (int j8 = 0; j8 < 4; ++j8) {
        float f[8];
#pragma unroll
        for (int q = 0; q < 8; ++q) f[q] = L[(kq * 32 + j8 * 8 + q) * 129 + sc];
        *(u32x4*)(j.dst + (size_t)(j.drow0 + rr) * j.dK + j.k0 + kq * 32 + j8 * 8) = pack8(f);
    }
}

__device__ __forceinline__ void row_load32(const float* __restrict__ p, int lane, float (&v)[32]) {
#pragma unroll
    for (int cch = 0; cch < 4; ++cch) { const f32x4 a = *(const f32x4*)(p + cch * 512 + lane * 8), b = *(const f32x4*)(p + cch * 512 + lane * 8 + 4);
        v[cch * 8 + 0] = a[0]; v[cch * 8 + 1] = a[1]; v[cch * 8 + 2] = a[2]; v[cch * 8 + 3] = a[3]; v[cch * 8 + 4] = b[0]; v[cch * 8 + 5] = b[1]; v[cch * 8 + 6] = b[2]; v[cch * 8 + 7] = b[3]; }
}
__device__ __forceinline__ void row_add_bf16(const bf16* __restrict__ p, int lane, float (&v)[32]) {
#pragma unroll
    for (int cch = 0; cch < 4; ++cch) { const u32x4 w = *(const u32x4*)(p + cch * 512 + lane * 8); float f[8]; unpack8(w, f);
#pragma unroll
        for (int j = 0; j < 8; ++j) v[cch * 8 + j] += f[j]; }
}
__device__ __forceinline__ float row_rstd(const float (&v)[32]) {
    float ss = 0.f;
#pragma unroll
    for (int j = 0; j < 32; ++j) ss += v[j] * v[j];
    ss = wave_sum(ss);
    return rsqrtf(ss * (1.0f / 2048.0f) + EPS);
}
__device__ __forceinline__ void row_store_norm_bf16(bf16* __restrict__ o, const float* __restrict__ g, int lane, const float (&v)[32], float r) {
#pragma unroll
    for (int cch = 0; cch < 4; ++cch) { const f32x4 ga = *(const f32x4*)(g + cch * 512 + lane * 8), gb = *(const f32x4*)(g + cch * 512 + lane * 8 + 4); float f[8];
#pragma unroll
        for (int j = 0; j < 4; ++j) { f[j] = v[cch * 8 + j] * r * ga[j]; f[4 + j] = v[cch * 8 + 4 + j] * r * gb[j]; }
        *(u32x4*)(o + cch * 512 + lane * 8) = pack8(f); }
}

constexpr int CV_IN = 16 * 56, CV_OUT = 16 * 16, CV_GLU = 16 * 32, CV_GU = 2 * 32 * 2 * 128, CV_DN = 2 * 32 * 128;
constexpr int CONV_TOT = CV_IN + CV_OUT + CV_GLU + CV_GU + CV_DN;
#ifndef CONV_IN_GEMM
#define CONV_IN_GEMM 1
#endif
constexpr int CONV_PRO = CONV_IN_GEMM ? CV_IN + CV_OUT : CONV_TOT;
constexpr int CVO_GLU = CV_IN + CV_OUT, CVO_GU = CVO_GLU + CV_GLU, CVO_DN = CVO_GU + CV_GU;
constexpr int CV_GU1_SPLIT = 13;
__device__ __forceinline__ ConvJob conv_job(const Ctx& c, int t) {
    ConvJob j; int i = t;
    if (i < CV_IN) { const int kb = i % 16, cb = i / 16; j.src = c.in[4]; j.ld = NIN; j.k0 = kb * 128; j.col0 = cb * 128; j.dst = WSP(bf16, WS_WIN); j.dK = 2048; j.drow0 = cb * 128; return j; }
    i -= CV_IN;
    if (i < CV_OUT) { const int kb = i % 16, cb = i / 16; j.src = c.in[8]; j.ld = 2048; j.k0 = kb * 128; j.col0 = cb * 128; j.dst = WSP(bf16, WS_WOUT); j.dK = 2048; j.drow0 = cb * 128; return j; }
    i -= CV_OUT;
    if (i < CV_GLU) { const int kb = i % 16, cb = i / 16; j.src = c.in[17]; j.ld = 4096; j.k0 = kb * 128; j.col0 = cb * 128; j.dst = WSP(bf16, WS_WGLU); j.dK = 2048; j.drow0 = cb < 16 ? cb * 256 : (cb - 16) * 256 + 128; return j; }
    i -= CV_GLU;
    if (i < CV_GU) { const int kb = i % 16, cb = (i / 16) % 8, gu = (i / 128) % 2, le = i / 256;
        j.src = (gu ? c.in[23] : c.in[22]) + (size_t)le * 2048 * 1024; j.ld = 1024; j.k0 = kb * 128; j.col0 = cb * 128; j.dst = WSP(bf16, WS_WGU) + (size_t)le * 2048 * 2048; j.dK = 2048; j.drow0 = cb * 256 + gu * 128; return j; }
    i -= CV_GU;
    { const int kb = i % 8, cb = (i / 8) % 16, le = i / 128;
        j.src = c.in[24] + (size_t)le * 1024 * 2048; j.ld = 2048; j.k0 = kb * 128; j.col0 = cb * 128; j.dst = WSP(bf16, WS_WD) + (size_t)le * 2048 * 1024; j.dK = 1024; j.drow0 = cb * 128; return j; }
}

__device__ __forceinline__ int cv_fz(int k) { return (k >> 3) & 7; }
__device__ __forceinline__ void conv_slice(const Ctx& c, int lo0, int n0, int lo1, int n1, int lo2, int n2) {
    const int tot = n0 + n1 + n2, G = c.G;
    const int mine = (tot - c.bid + G - 1) / G;
    if (mine <= 0) return;
    const int tid = c.tid, w = c.wave, lrow = c.lane >> 5, gp = c.lane & 31;
    const int rr0 = tid >> 3, kq = tid & 7;
#define CV_JOB(i) conv_job(c, [&](int ii) { const int v = c.bid + (ii < mine ? ii : mine - 1) * G; return v < n0 ? lo0 + v : (v < n0 + n1 ? lo1 + (v - n0) : lo2 + (v - n0 - n1)); }(i))
#define CV_ISSUE(i, buf) do { const ConvJob _j = CV_JOB(i); _Pragma("unroll") for (int _q = 0; _q < 8; ++_q) { const int _row = 2 * (_q * 8 + w) + lrow; const int _g = gp ^ cv_fz(_row); \
        __builtin_amdgcn_global_load_lds((const unsigned*)(_j.src + (size_t)(_j.k0 + _row) * _j.ld + _j.col0 + _g * 4), (LAS unsigned*)(c.lds + (buf) * 65536 + (_q * 8 + w) * 1024), 16, 0, 2); } } while (0)
    CV_ISSUE(0, 0); CV_ISSUE(1, 1);
    for (int i = 0; i < mine; ++i) {
        if (i == 0) asm volatile("s_waitcnt vmcnt(8)" ::: "memory"); else if (i == 1) asm volatile("s_waitcnt vmcnt(12)" ::: "memory"); else asm volatile("s_waitcnt vmcnt(16)" ::: "memory");
        __builtin_amdgcn_s_barrier();
        asm volatile("" ::: "memory");
        const LAS float* B = (const LAS float*)(c.lds + (i & 1) * 65536);
        u32x4 o[4];
#pragma unroll
        for (int p = 0; p < 2; ++p) { const int rr = rr0 + 64 * p, sc = (rr & ~31) + perm32(rr & 31), scg = sc >> 2, scl = sc & 3;
#pragma unroll
            for (int h = 0; h < 2; ++h) { float f[8];
#pragma unroll
                for (int q = 0; q < 8; ++q) { const int k = 64 * h + kq * 8 + q; f[q] = B[k * 128 + ((scg ^ kq) << 2) + scl]; }
                o[p * 2 + h] = pack8(f); } }
        asm volatile("s_waitcnt lgkmcnt(0)" ::: "memory");
        __builtin_amdgcn_s_barrier();
        asm volatile("" ::: "memory");
        if ((i & 1) == 0) CV_ISSUE(i + 2, 0); else CV_ISSUE(i + 2, 1);
        asm volatile("" ::: "memory");
        { const ConvJob j = CV_JOB(i);
#pragma unroll
          for (int p = 0; p < 2; ++p) { bf16* d = j.dst + (size_t)(j.drow0 + rr0 + 64 * p) * j.dK + j.k0 + kq * 8;
#pragma unroll
              for (int h = 0; h < 2; ++h) *(u32x4*)(d + 64 * h) = o[p * 2 + h]; } }
        asm volatile("" ::: "memory");
    }
    asm volatile("s_waitcnt vmcnt(0)" ::: "memory");
    __builtin_amdgcn_s_barrier();
#undef CV_ISSUE
#undef CV_JOB
}

__device__ __forceinline__ void conv_slice_moe(const Ctx& c, int lo, int n, int nwg, int per_light) {
    const int extra = nwg % c.G, n_light = extra ? c.G - extra : 0;
    int nb = n_light * per_light; if (nb > n) nb = n;
    if (n_light > 0 && c.bid >= extra && nb > 0) { Ctx c2 = c; c2.bid = c.bid - extra; c2.G = n_light; conv_slice(c2, lo, nb, 0, 0, 0, 0); }
    conv_slice(c, lo + nb, n - nb, 0, 0, 0, 0);
}

__device__ __forceinline__ void s5_precompute_group(const Ctx& c, int g) {
    LAS float* AR = (LAS float*)c.lds; LAS float* AI = AR + 64; LAS float* BBR = AI + 64; LAS float* BBI = BBR + 1024;
    LAS float* PR = BBI + 1024; LAS float* PI = PR + 33 * 64; LAS float* CRE = PI + 33 * 64; LAS float* CIM = CRE + 1024;
    const int tid = c.tid;
    if (tid < 64) {
        const int p = tid, i = g * 64 + p;
        const float dt = expf(c.in[11][g]), lr = c.in[9][i], li = c.in[10][i];
        const float mag = expf(lr * dt), ar = mag * cosf(li * dt), ai = mag * sinf(li * dt);
        const float den = lr * lr + li * li;
        const float cr = ((ar - 1.0f) * lr + ai * li) / den, ci = (ai * lr - (ar - 1.0f) * li) / den;
        AR[p] = ar; AI[p] = ai;
        for (int ch = 0; ch < 16; ++ch) { const float br = c.in[12][(size_t)i * 16 + ch], bi = c.in[13][(size_t)i * 16 + ch]; BBR[p * 16 + ch] = cr * br - ci * bi; BBI[p * 16 + ch] = cr * bi + ci * br; }
        float pr = 1.0f, pi = 0.0f; PR[p] = pr; PI[p] = pi;
        for (int tau = 1; tau <= 32; ++tau) { const float nr = pr * ar - pi * ai, ni = pr * ai + pi * ar; pr = nr; pi = ni; PR[tau * 64 + p] = pr; PI[tau * 64 + p] = pi; }
        float* A32 = WSP(float, WS_S5A32) + (size_t)i * 2; A32[0] = pr; A32[1] = pi;
        *(u32x4*)(WSP(bf16, WS_S5ZERO) + (size_t)g * 512 + p * 8) = (u32x4){0u, 0u, 0u, 0u};
    }
    for (int i = tid; i < 1024; i += NTHR) { CRE[i] = c.in[14][(size_t)g * 1024 + i]; CIM[i] = c.in[15][(size_t)g * 1024 + i]; }
    __syncthreads();
    bf16* Rg = WSP(bf16, WS_S5R) + (size_t)g * 16 * 1024;
    for (int idx = tid; idx < 16 * 32 * 16; idx += NTHR) {
        const int co = idx >> 9, tau = (idx >> 4) & 31, ci = idx & 15; float acc = 0.f;
        for (int p = 0; p < 64; ++p) { const float pr = PR[tau * 64 + p], pi = PI[tau * 64 + p], br = BBR[p * 16 + ci], bi = BBI[p * 16 + ci];
            const float wr = pr * br - pi * bi, wi = pr * bi + pi * br; acc += CRE[co * 64 + p] * wr - CIM[co * 64 + p] * wi; }
        Rg[co * 1024 + (31 - tau) * 16 + ci] = f2bf(acc);
    }
    for (int idx = tid; idx < 16 * 64; idx += NTHR) { const int co = idx >> 6, q = idx & 63; *(u32x4*)(Rg + co * 1024 + 512 + q * 8) = (u32x4){0u, 0u, 0u, 0u}; }
    bf16* Wst = WSP(bf16, WS_S5WST) + (size_t)g * 128 * 512;
    for (int idx = tid; idx < 128 * 64; idx += NTHR) {
        const int r = idx >> 6, k8 = idx & 63, sI = k8 >> 1, ci0 = (k8 & 1) * 8; const int j = (r & ~31) + perm32(r & 31), ri = j >> 6, p = j & 63, tau = 31 - sI;
        const float pr = PR[tau * 64 + p], pi = PI[tau * 64 + p]; float f[8];
#pragma unroll
        for (int q = 0; q < 8; ++q) { const float br = BBR[p * 16 + ci0 + q], bi = BBI[p * 16 + ci0 + q]; f[q] = ri ? (pr * bi + pi * br) : (pr * br - pi * bi); }
        *(u32x4*)(Wst + (size_t)r * 512 + k8 * 8) = pack8(f);
    }
    bf16* Wc = WSP(bf16, WS_S5WC) + (size_t)g * 512 * 128;
    for (int idx = tid; idx < 512 * 16; idx += NTHR) {
        const int r = idx >> 4, k8 = idx & 15, ri = k8 >> 3, p0 = (k8 & 7) * 8; const int j = (r & ~31) + perm32(r & 31), t = j >> 4, co = j & 15, n = t + 1; float f[8];
#pragma unroll
        for (int q = 0; q < 8; ++q) { const int p = p0 + q; const float pr = PR[n * 64 + p], pi = PI[n * 64 + p], cr = CRE[co * 64 + p], ci = CIM[co * 64 + p]; f[q] = ri ? (-cr * pi - ci * pr) : (cr * pr - ci * pi); }
        *(u32x4*)(Wc + (size_t)r * 128 + k8 * 8) = pack8(f);
    }
    __syncthreads();
}
__device__ __forceinline__ void ph_prologue(const Ctx& c) {
    LAS float* L = (LAS float*)c.lds;
    if (S5_MFMA) { for (int g = c.bid; g < 128; g += c.G) s5_precompute_group(c, g); }
    conv_slice(c, 0, CONV_PRO, 0, 0, 0, 0);
    __syncthreads();
    {
        const bool bal = S5_MFMA && c.G == 256; const int heavy = c.bid < 128;
        const int nrow = bal ? (heavy ? 6 : 10) : (T_ + c.G * NWAVE - 1) / (c.G * NWAVE);
        const int row0 = bal ? (heavy ? (c.bid * NWAVE + c.wave) * 6 : 128 * NWAVE * 6 + ((c.bid - 128) * NWAVE + c.wave) * 10) : (c.bid * NWAVE + c.wave) * nrow;
        for (int i = 0; i < nrow; ++i) { const int row = row0 + i; if (row >= T_) break;
            float v[32]; row_load32(c.in[0] + (size_t)row * D_, c.lane, v);
            const float r = row_rstd(v);
            row_store_norm_bf16(WSP(bf16, WS_HB) + (size_t)row * D_, c.in[1], c.lane, v, r);
        }
    }
    const int gtid = c.bid * NTHR + c.tid, gn = c.G * NTHR;
    for (int i = gtid; i < 1024; i += gn) { const float a = c.in[6][i], b = c.in[6][1024 + i], m = fmaxf(a, b); const float ea = expf(a - m), eb = expf(b - m); WSP(float, WS_LB)[i] = ea / (ea + eb); }
    for (int i = gtid; i < 128 * 64; i += gn) {
        const int g = i >> 6;
        const float dt = expf(c.in[11][g]), lr = c.in[9][i], li = c.in[10][i];
        const float mag = expf(lr * dt), ar = mag * cosf(li * dt), ai = mag * sinf(li * dt);
        const float den = lr * lr + li * li;
        const float cr = ((ar - 1.0f) * lr + ai * li) / den, ci = (ai * lr - (ar - 1.0f) * li) / den;
        float pr = ar, pi = ai;
#pragma unroll
        for (int s = 0; s < 6; ++s) { const float nr = pr * pr - pi * pi, ni = 2.0f * pr * pi; pr = nr; pi = ni; }
        float* A4 = WSP(float, WS_S5A) + (size_t)i * 4; A4[0] = ar; A4[1] = ai; A4[2] = pr; A4[3] = pi;
        float* Bo = WSP(float, WS_S5B) + (size_t)i * 32;
        for (int ch = 0; ch < 16; ++ch) { const float br = c.in[12][(size_t)i * 16 + ch], bi = c.in[13][(size_t)i * 16 + ch]; Bo[ch] = cr * br - ci * bi; Bo[16 + ch] = cr * bi + ci * br; }
    }
    for (int i = gtid; i < 2 * 48 * 2048; i += gn) {
        const int k = i % 2048, n = (i / 2048) % 48, l = i / (48 * 2048);
        float w = 0.f;
        if (n < 4) w = c.in[18][((size_t)l * 2048 + k) * 4 + n]; else if (n < 36) w = c.in[20][((size_t)l * 2048 + k) * 32 + (n - 4)];
        w *= c.in[2][l * 2048 + k];
        const bf16 hi = f2bf(w), lo = f2bf(w - bf2f(hi));
        bf16* d = WSP(bf16, WS_WR) + ((size_t)(l * 48 + n) * 2) * 2048 + k; d[0] = hi; d[2048] = lo;
    }
}

template <bool PAIRED, class ARow, class Epi>
__device__ __forceinline__ void naive_gemm(const Ctx& c, int M, int N, int K, const ARow& arow, const float* __restrict__ W, const float* __restrict__ W2, int ldw, const Epi& epi) {
    LAS float* As = (LAS float*)c.lds;
    LAS float* Ws = As + 16 * 68;
    LAS float* Ws2 = Ws + 16 * 132;
    const int tid = c.tid, ty = tid >> 5, tx = tid & 31;
    const int ntm = (M + 63) / 64, ntn = N / 128;
    for (int tile = c.bid; tile < ntm * ntn; tile += c.G) {
        const int tm = tile / ntn, tn = tile % ntn, r0 = tm * 64, c0 = tn * 128;
        float a1[4][4], a2[4][4];
#pragma unroll
        for (int i = 0; i < 4; ++i)
#pragma unroll
            for (int j = 0; j < 4; ++j) { a1[i][j] = 0.f; a2[i][j] = 0.f; }
        const int lr = tid >> 3, lk = (tid & 7) * 2;
        const bf16* ap = (r0 + lr < M) ? arow(r0 + lr) : nullptr;
        for (int k0 = 0; k0 < K; k0 += 16) {
            { float x0 = 0.f, x1 = 0.f; if (ap) { const unsigned w = *(const unsigned*)(ap + k0 + lk); x0 = __uint_as_float(w << 16); x1 = __uint_as_float(w & 0xffff0000u); }
              As[lk * 68 + lr] = x0; As[(lk + 1) * 68 + lr] = x1; }
            { const int wk = tid >> 5, w4 = tid & 31; const f32x4 wv = *(const f32x4*)(W + (size_t)(k0 + wk) * ldw + c0 + w4 * 4);
              LAS float* p = Ws + wk * 132 + w4 * 4; p[0] = bf2f(f2bf(wv[0])); p[1] = bf2f(f2bf(wv[1])); p[2] = bf2f(f2bf(wv[2])); p[3] = bf2f(f2bf(wv[3]));
              if (PAIRED) { const f32x4 wv2 = *(const f32x4*)(W2 + (size_t)(k0 + wk) * ldw + c0 + w4 * 4); LAS float* p2 = Ws2 + wk * 132 + w4 * 4;
                  p2[0] = bf2f(f2bf(wv2[0])); p2[1] = bf2f(f2bf(wv2[1])); p2[2] = bf2f(f2bf(wv2[2])); p2[3] = bf2f(f2bf(wv2[3])); } }
            __syncthreads();
#pragma unroll
            for (int kk = 0; kk < 16; ++kk) {
                float av[4], wv[4], wv2[4];
#pragma unroll
                for (int i = 0; i < 4; ++i) av[i] = As[kk * 68 + ty * 4 + i];
#pragma unroll
                for (int j = 0; j < 4; ++j) { wv[j] = Ws[kk * 132 + tx * 4 + j]; if (PAIRED) wv2[j] = Ws2[kk * 132 + tx * 4 + j]; }
#pragma unroll
                for (int i = 0; i < 4; ++i)
#pragma unroll
                    for (int j = 0; j < 4; ++j) { a1[i][j] += av[i] * wv[j]; if (PAIRED) a2[i][j] += av[i] * wv2[j]; }
            }
            __syncthreads();
        }
#pragma unroll
        for (int i = 0; i < 4; ++i) { const int r = r0 + ty * 4 + i; if (r < M)
#pragma unroll
            for (int j = 0; j < 4; ++j) epi(r, c0 + tx * 4 + j, a1[i][j], a2[i][j]); }
    }
}

constexpr size_t ZH_AS = (size_t)2 * 8 * SEQ * 128;
struct EpiZ {
    bf16* Z; bf16* ZH;
    __device__ __forceinline__ void operator()(const f32x4 (&acc)[2][2][4][2], const pg::Unit& u, int wr, int wc, int fr, int fq) const {
        if (u.pn >= 12) {
            const int pp = u.pn - 12, arr = pp >> 2, h0 = (pp & 3) * 2;
#pragma unroll
            for (int ai = 0; ai < 2; ++ai)
#pragma unroll
                for (int m = 0; m < 4; ++m) { const int row = u.pm * 256 + ai * 128 + wr * 64 + m * 16 + fr; const int b = row >> 13, t = row & (SEQ - 1);
#pragma unroll
                    for (int bj = 0; bj < 2; ++bj) { const f32x4 v0 = acc[ai][bj][m][0], v1 = acc[ai][bj][m][1]; u32x4 w; w.x = pk2(v0[0], v0[1]); w.y = pk2(v0[2], v0[3]); w.z = pk2(v1[0], v1[1]); w.w = pk2(v1[2], v1[3]);
                        *(u32x4*)(ZH + (size_t)arr * ZH_AS + ((size_t)((b * 8 + h0 + bj) * SEQ + t)) * 128 + wc * 32 + 8 * fq) = w; } }
            return;
        }
#pragma unroll
        for (int ai = 0; ai < 2; ++ai)
#pragma unroll
            for (int m = 0; m < 4; ++m) { const int row = u.pm * 256 + ai * 128 + wr * 64 + m * 16 + fr; bf16* rp = Z + (size_t)row * NIN + u.pn * 256 + wc * 32 + 8 * fq;
#pragma unroll
                for (int bj = 0; bj < 2; ++bj) { const f32x4 v0 = acc[ai][bj][m][0], v1 = acc[ai][bj][m][1]; u32x4 w; w.x = pk2(v0[0], v0[1]); w.y = pk2(v0[2], v0[3]); w.z = pk2(v1[0], v1[1]); w.w = pk2(v1[2], v1[3]);
                    *(u32x4*)(rp + bj * 128) = w; } }
    }
};
__device__ __forceinline__ void ph_inproj(const Ctx& c) {
    if (NAIVE_GEMM & 1) {
        const bf16* hb = WSP(bf16, WS_HB); bf16* Z = WSP(bf16, WS_Z);
        naive_gemm<false>(c, T_, NIN, 2048, [=](int r) { return hb + (size_t)r * 2048; }, c.in[4], nullptr, NIN, [=](int r, int col, float a, float) { Z[(size_t)r * NIN + col] = f2bf(a); });
    } else {
        pg::DenseSched S; S.init(WSP(bf16, WS_HB), WSP(bf16, WS_WIN), T_, NIN, 2048, c.G, c.bid);
        EpiZ E{WSP(bf16, WS_Z), WSP(bf16, WS_XB)};
        if (CONV_IN_GEMM) {
            const int slot = (c.bid >> 3) % 7; S.i1 = slot + 1; pg::gemm_phase_w(c.lds, S, E, c.wave);
            conv_slice(c, CVO_GLU, CV_GLU + CV_GU / 2, 0, 0, 0, 0);
            S.i0 = slot + 1; S.i1 = 1 << 20; pg::gemm_phase_w(c.lds, S, E, c.wave); }
        else pg::gemm_phase_w(c.lds, S, E, c.wave);
    }
}

constexpr int HS = 132;
__device__ __forceinline__ void hg_load_tile(const Ctx& c, LAS float* dst, const bf16* __restrict__ src  ) {
#pragma unroll
    for (int i = 0; i < 2; ++i) { const int vid = c.tid + i * 512, t = vid >> 4, d8 = vid & 15; const u32x4 w = *(const u32x4*)(src + (size_t)t * NIN + d8 * 8); float f[8]; unpack8(w, f);
        LAS float* p = dst + t * HS + d8 * 8;
#pragma unroll
        for (int j = 0; j < 8; ++j) p[j] = f[j]; }
}
__device__ __forceinline__ void ph_conv_hglocal(const Ctx& c) {
    const bf16* Z = WSP(bf16, WS_Z); bf16* Y = WSP(bf16, WS_YCAT);
    {
        const float* cw = c.in[5];
        const int gtid = c.bid * NTHR + c.tid, gn = c.G * NTHR;
        for (int it = gtid; it < (T_ / 8) * 128; it += gn) {
            const int c8 = it & 127, tb = it >> 7, t0 = tb * 8, ch = c8 * 8;
            float w0[8], w1[8], w2[8];
#pragma unroll
            for (int j = 0; j < 8; ++j) { w0[j] = cw[ch + j]; w1[j] = cw[1024 + ch + j]; w2[j] = cw[2048 + ch + j]; }
            float um2[8], um1[8];
#pragma unroll
            for (int j = 0; j < 8; ++j) { um2[j] = 0.f; um1[j] = 0.f; }
            if ((t0 & (SEQ - 1)) != 0) {
                float a[8], b[8];
                unpack8(*(const u32x4*)(Z + (size_t)(t0 - 2) * NIN + 1024 + ch), a); unpack8(*(const u32x4*)(Z + (size_t)(t0 - 2) * NIN + 2048 + ch), b);
#pragma unroll
                for (int j = 0; j < 8; ++j) um2[j] = a[j] * b[j];
                unpack8(*(const u32x4*)(Z + (size_t)(t0 - 1) * NIN + 1024 + ch), a); unpack8(*(const u32x4*)(Z + (size_t)(t0 - 1) * NIN + 2048 + ch), b);
#pragma unroll
                for (int j = 0; j < 8; ++j) um1[j] = a[j] * b[j];
            }
#pragma unroll
            for (int tt = 0; tt < 8; ++tt) {
                const size_t ro = (size_t)(t0 + tt) * NIN; float ab[8], ac[8], ah[8], o[8];
                unpack8(*(const u32x4*)(Z + ro + ch), ab); unpack8(*(const u32x4*)(Z + ro + 1024 + ch), ac); unpack8(*(const u32x4*)(Z + ro + 2048 + ch), ah);
#pragma unroll
                for (int j = 0; j < 8; ++j) { const float u0 = ac[j] * ah[j]; o[j] = ab[j] * (w0[j] * um2[j] + w1[j] * um1[j] + w2[j] * u0); um2[j] = um1[j]; um1[j] = u0; }
                *(u32x4*)(Y + (size_t)(t0 + tt) * D_ + ch) = pack8(o);
            }
        }
    }
    if (!HG_MFMA) {
        LAS float* B0 = (LAS float*)c.lds; LAS float* B1 = B0 + 64 * HS; LAS float* B2 = B1 + 64 * HS;
        const float* lb = WSP(float, WS_LB); float* KV = WSP(float, WS_KV); float* DEC = WSP(float, WS_HGDEC);
        for (int u = c.bid; u < 2048; u += c.G) {
            const int chunk = u & 127, bh = u >> 7, h = bh & 7, b = bh >> 3; const int t0 = b * SEQ + chunk * 64;
            hg_load_tile(c, B0, Z + (size_t)t0 * NIN + 4096 + h * 128);
            hg_load_tile(c, B2, Z + (size_t)t0 * NIN + 5120 + h * 128);
            __syncthreads();
            for (int i = c.tid; i < 64 * 128; i += 512) { const int t = i >> 7, d = i & 127; const float l = lb[h * 128 + d]; const float f = l + (1.0f - l) * sigmoidf_(B0[t * HS + d]); B0[t * HS + d] = logf(f); B1[t * HS + d] = 1.0f - f; }
            __syncthreads();
            if (c.tid < 128) { float run = 0.f; for (int t = 0; t < 64; ++t) { run += B0[t * HS + c.tid]; B0[t * HS + c.tid] = run; } }
            __syncthreads();
            for (int i = c.tid; i < 64 * 128; i += 512) { const int t = i >> 7, d = i & 127; B1[t * HS + d] *= expf(B0[63 * HS + d] - B0[t * HS + d]); }
            __syncthreads();
            const int kd0 = (c.tid >> 4) * 4, vd0 = (c.tid & 15) * 8;
            float acc[4][8];
#pragma unroll
            for (int i = 0; i < 4; ++i)
#pragma unroll
                for (int j = 0; j < 8; ++j) acc[i][j] = 0.f;
            for (int t = 0; t < 64; ++t) {
                const f32x4 kv = *(const LAS f32x4*)(B1 + t * HS + kd0), va = *(const LAS f32x4*)(B2 + t * HS + vd0), vb = *(const LAS f32x4*)(B2 + t * HS + vd0 + 4);
#pragma unroll
                for (int i = 0; i < 4; ++i) {
#pragma unroll
                    for (int j = 0; j < 4; ++j) { acc[i][j] += kv[i] * va[j]; acc[i][4 + j] += kv[i] * vb[j]; } }
            }
            float* kvp = KV + (size_t)u * 16384;
#pragma unroll
            for (int i = 0; i < 4; ++i) { *(f32x4*)(kvp + (kd0 + i) * 128 + vd0) = (f32x4){acc[i][0], acc[i][1], acc[i][2], acc[i][3]}; *(f32x4*)(kvp + (kd0 + i) * 128 + vd0 + 4) = (f32x4){acc[i][4], acc[i][5], acc[i][6], acc[i][7]}; }
            if (c.tid < 128) DEC[(size_t)u * 128 + c.tid] = expf(B0[63 * HS + c.tid]);
            __syncthreads();
        }
    }
}

__device__ __forceinline__ void ph_hgscan(const Ctx& c) {
    float* KV = WSP(float, WS_KV); const float* DEC = WSP(float, WS_HGDEC);
    const int gtid = c.bid * NTHR + c.tid, gn = c.G * NTHR;
    for (int i = gtid; i < 16 * 16384; i += gn) {
        const int bh = i >> 14, el = i & 16383, kd = el >> 7;
        float s = 0.f;
        for (int c0 = 0; c0 < 128; c0 += 8) {
            float tmp[8], dc[8];
#pragma unroll
            for (int j = 0; j < 8; ++j) { tmp[j] = KV[(size_t)(bh * 128 + c0 + j) * 16384 + el]; dc[j] = DEC[(size_t)(bh * 128 + c0 + j) * 128 + kd]; }
#pragma unroll
            for (int j = 0; j < 8; ++j) { KV[(size_t)(bh * 128 + c0 + j) * 16384 + el] = s; s = dc[j] * s + tmp[j]; }
        }
    }
}

__device__ __forceinline__ void ph_hgout(const Ctx& c) {
    const bf16* Z = WSP(bf16, WS_Z); bf16* Y = WSP(bf16, WS_YCAT);
    LAS float* B0 = (LAS float*)c.lds; LAS float* B1 = B0 + 64 * HS; LAS float* B2 = B1 + 64 * HS; LAS float* B3 = B2 + 64 * HS;
    const float* lb = WSP(float, WS_LB); const float* KV = WSP(float, WS_KV); const float* ng = c.in[7];
    for (int u = c.bid; u < 2048; u += c.G) {
        const int chunk = u & 127, bh = u >> 7, h = bh & 7, b = bh >> 3; const int t0 = b * SEQ + chunk * 64;
        hg_load_tile(c, B0, Z + (size_t)t0 * NIN + 4096 + h * 128);
        hg_load_tile(c, B1, Z + (size_t)t0 * NIN + 3072 + h * 128);
        hg_load_tile(c, B2, Z + (size_t)t0 * NIN + 5120 + h * 128);
        __syncthreads();
        for (int i = c.tid; i < 64 * 128; i += 512) { const int t = i >> 7, d = i & 127; const float l = lb[h * 128 + d]; const float f = l + (1.0f - l) * sigmoidf_(B0[t * HS + d]); B0[t * HS + d] = logf(f); B3[t * HS + d] = 1.0f - f; }
        __syncthreads();
        if (c.tid < 128) { float run = 0.f; for (int t = 0; t < 64; ++t) { run += B0[t * HS + c.tid]; B0[t * HS + c.tid] = run; } }
        __syncthreads();
        const int dd = c.tid & 127; const float ref = B0[31 * HS + dd];
        __syncthreads();
        for (int i = c.tid; i < 64 * 128; i += 512) { const int t = i >> 7; const float bb = B0[t * HS + dd], q = B1[t * HS + dd];
            B1[t * HS + dd] = q * expf(bb); B0[t * HS + dd] = q * expf(bb - ref); B3[t * HS + dd] *= expf(ref - bb); }
        __syncthreads();
        const int tg = c.tid >> 4, vg = c.tid & 15, ta = tg * 2, vd0 = vg * 8;
        float o[2][8];
#pragma unroll
        for (int i = 0; i < 2; ++i)
#pragma unroll
            for (int j = 0; j < 8; ++j) o[i][j] = 0.f;
        {
            const float* sp = KV + (size_t)u * 16384 + vd0;
            for (int kd = 0; kd < 128; kd += 4) {
                const f32x4 qa = *(const LAS f32x4*)(B1 + ta * HS + kd), qb = *(const LAS f32x4*)(B1 + (ta + 1) * HS + kd);
#pragma unroll
                for (int k2 = 0; k2 < 4; ++k2) { const f32x4 s0 = *(const f32x4*)(sp + (size_t)(kd + k2) * 128), s1 = *(const f32x4*)(sp + (size_t)(kd + k2) * 128 + 4);
#pragma unroll
                    for (int j = 0; j < 4; ++j) { o[0][j] += qa[k2] * s0[j]; o[0][4 + j] += qa[k2] * s1[j]; o[1][j] += qb[k2] * s0[j]; o[1][4 + j] += qb[k2] * s1[j]; } }
            }
        }
        __syncthreads();
        {
            const int t = c.tid >> 3, s0 = (c.tid & 7) * 8; float sc[8];
#pragma unroll
            for (int j = 0; j < 8; ++j) sc[j] = 0.f;
            for (int kd = 0; kd < 128; kd += 4) { const f32x4 q = *(const LAS f32x4*)(B0 + t * HS + kd);
#pragma unroll
                for (int j = 0; j < 8; ++j) { const f32x4 k = *(const LAS f32x4*)(B3 + (s0 + j) * HS + kd); sc[j] += q[0] * k[0] + q[1] * k[1] + q[2] * k[2] + q[3] * k[3]; } }
#pragma unroll
            for (int j = 0; j < 8; ++j) B1[t * 68 + s0 + j] = (s0 + j <= t) ? sc[j] : 0.f;
        }
        __syncthreads();
        for (int s = 0; s <= ta + 1; ++s) {
            const float p0 = B1[ta * 68 + s], p1 = B1[(ta + 1) * 68 + s];
            const f32x4 va = *(const LAS f32x4*)(B2 + s * HS + vd0), vb = *(const LAS f32x4*)(B2 + s * HS + vd0 + 4);
#pragma unroll
            for (int j = 0; j < 4; ++j) { o[0][j] += p0 * va[j]; o[0][4 + j] += p0 * vb[j]; o[1][j] += p1 * va[j]; o[1][4 + j] += p1 * vb[j]; }
        }
#pragma unroll
        for (int i = 0; i < 2; ++i) {
            float ss = 0.f;
#pragma unroll
            for (int j = 0; j < 8; ++j) ss += o[i][j] * o[i][j];
            ss += __shfl_xor(ss, 1); ss += __shfl_xor(ss, 2); ss += __shfl_xor(ss, 4); ss += __shfl_xor(ss, 8);
            const float r = rsqrtf(ss * (1.0f / 128.0f) + EPS);
            float g[8], res[8]; unpack8(*(const u32x4*)(Z + (size_t)(t0 + ta + i) * NIN + 6144 + h * 128 + vd0), g);
#pragma unroll
            for (int j = 0; j < 8; ++j) res[j] = o[i][j] * r * ng[vd0 + j] * siluf_(g[j]);
            *(u32x4*)(Y + (size_t)(t0 + ta + i) * D_ + 1024 + h * 128 + vd0) = pack8(res);
        }
        __syncthreads();
    }
}

__device__ __forceinline__ void hg_col16(const bf16* __restrict__ p, unsigned short (&o)[16]) {
#pragma unroll
    for (int i = 0; i < 16; ++i) o[i] = p[(size_t)i * NIN];
}
__device__ __forceinline__ u32x4 pk8us(unsigned short a0, unsigned short a1, unsigned short a2, unsigned short a3, unsigned short a4, unsigned short a5, unsigned short a6, unsigned short a7) {
    u32x4 w; w.x = (unsigned)a0 | ((unsigned)a1 << 16); w.y = (unsigned)a2 | ((unsigned)a3 << 16); w.z = (unsigned)a4 | ((unsigned)a5 << 16); w.w = (unsigned)a6 | ((unsigned)a7 << 16); return w;
}
__device__ __forceinline__ void ph_hgL(const Ctx& c) {
    const bf16* ZH = WSP(bf16, WS_XB); const float* lb = WSP(float, WS_LB); float* KV = WSP(float, WS_KV); float* DEC = WSP(float, WS_HGDEC);
    LAS bf16* VT = (LAS bf16*)c.lds; LAS bf16* KT = VT + 128 * 72; LAS float* SS = (LAS float*)(KT + 128 * 72); LAS bf16* ST = (LAS bf16*)(c.lds + 65536);
    const int d = c.tid & 127, seg = c.tid >> 7, r = c.lane & 31, hh = c.lane >> 5, w = c.wave;
    unsigned short fl[16], vv[16];
    LAS unsigned char* ZW = c.lds + 107520 + w * 4096;
    const int zr = c.lane >> 3, zp = c.lane & 7;
#define HGL_DMA(U) do { const int _c = (U) & 127, _bh = (U) >> 7; const bf16* _z = ZH + ((size_t)_bh * SEQ + _c * 64 + 16 * seg + zr) * 128 + 64 * (w & 1) + zp * 8; \
        _Pragma("unroll") for (int _a = 0; _a < 2; ++_a) _Pragma("unroll") for (int _hr = 0; _hr < 2; ++_hr) \
            __builtin_amdgcn_global_load_lds((const unsigned*)(_z + (size_t)(_a ? 2 : 1) * ZH_AS + (8 * _hr) * 128), (LAS unsigned*)(ZW + _a * 2048 + _hr * 1024), 16, 0, 0); } while (0)
#define HGL_COLS() do { asm volatile("s_waitcnt vmcnt(0)" ::: "memory"); _Pragma("unroll") for (int i = 0; i < 16; ++i) { fl[i] = *(const LAS unsigned short*)(ZW + i * 128 + c.lane * 2); vv[i] = *(const LAS unsigned short*)(ZW + 2048 + i * 128 + c.lane * 2); } \
        asm volatile("s_waitcnt lgkmcnt(0)" ::: "memory"); } while (0)
    if (c.bid < 2048) { HGL_DMA(c.bid); HGL_COLS(); }
    for (int u = c.bid; u < 2048; u += c.G) {
        const int bh = u >> 7, h = bh & 7;
        if (u + c.G < 2048) HGL_DMA(u + c.G);
        const float lbv = lb[h * 128 + d];
        float cs[16], kk[16]; float run = 0.f;
#pragma unroll
        for (int i = 0; i < 16; ++i) { const float f = lbv + (1.0f - lbv) * sigmoidf_(bf2f(fl[i])); kk[i] = 1.0f - f; run += __builtin_amdgcn_logf(f); cs[i] = run; }
        SS[seg * 128 + d] = run;
        __syncthreads();
        const float s0 = SS[d], s1 = SS[128 + d], s2 = SS[256 + d], s3 = SS[384 + d];
        const float prefix = (seg > 0 ? s0 : 0.f) + (seg > 1 ? s1 : 0.f) + (seg > 2 ? s2 : 0.f), total = (s0 + s1) + (s2 + s3);
        float kd[16];
#pragma unroll
        for (int i = 0; i < 16; ++i) kd[i] = kk[i] * __builtin_amdgcn_exp2f(total - prefix - cs[i]);
        { float f0[8], f1[8];
#pragma unroll
          for (int i = 0; i < 8; ++i) { f0[i] = kd[i]; f1[i] = kd[8 + i]; }
          *(LAS u32x4*)(KT + d * 72 + 16 * seg) = pack8(f0); *(LAS u32x4*)(KT + d * 72 + 16 * seg + 8) = pack8(f1);
          *(LAS u32x4*)(VT + d * 72 + 16 * seg) = pk8us(vv[0], vv[1], vv[2], vv[3], vv[4], vv[5], vv[6], vv[7]);
          *(LAS u32x4*)(VT + d * 72 + 16 * seg + 8) = pk8us(vv[8], vv[9], vv[10], vv[11], vv[12], vv[13], vv[14], vv[15]); }
        if (seg == 0) DEC[(size_t)u * 128 + d] = __builtin_amdgcn_exp2f(total);
        __syncthreads();
        const int vdt = w >> 1, kdt0 = (w & 1) * 2;
        f32x16 acc0, acc1;
#pragma unroll
        for (int i = 0; i < 16; ++i) { acc0[i] = 0.f; acc1[i] = 0.f; }
#pragma unroll
        for (int ks = 0; ks < 4; ++ks) {
            const bf16x8 a = *(const LAS bf16x8*)(VT + (32 * vdt + r) * 72 + 16 * ks + 8 * hh);
            const bf16x8 b0 = *(const LAS bf16x8*)(KT + (32 * kdt0 + r) * 72 + 16 * ks + 8 * hh), b1 = *(const LAS bf16x8*)(KT + (32 * (kdt0 + 1) + r) * 72 + 16 * ks + 8 * hh);
            acc0 = __builtin_amdgcn_mfma_f32_32x32x16_bf16(a, b0, acc0, 0, 0, 0); acc1 = __builtin_amdgcn_mfma_f32_32x32x16_bf16(a, b1, acc1, 0, 0, 0);
        }
        bf16* kvp = (bf16*)KV + (size_t)u * 16384;
#pragma unroll
        for (int i = 0; i < 16; ++i) { const int vd = 32 * vdt + (i & 3) + 8 * (i >> 2) + 4 * hh; ST[vd * 136 + 32 * kdt0 + r] = f2bf(acc0[i]); ST[vd * 136 + 32 * (kdt0 + 1) + r] = f2bf(acc1[i]); }
        __syncthreads();
        if (u + c.G < 2048) HGL_COLS();
#pragma unroll
        for (int p = 0; p < 4; ++p) { const int vd = p * 32 + (c.tid >> 4), k0 = (c.tid & 15) * 8;
            *(u32x4*)(kvp + vd * 128 + k0) = *(const LAS u32x4*)(ST + vd * 136 + k0); }
    }
}
#undef HGL_DMA
#undef HGL_COLS
__device__ __forceinline__ void ph_hgS(const Ctx& c) {
    const float* KV = WSP(float, WS_KV); const float* DEC = WSP(float, WS_HGDEC); bf16* SIN = WSP(bf16, WS_SIN);
    const int gtid = c.bid * NTHR + c.tid, gn = c.G * NTHR;
    for (int i = gtid; i < 16 * 8192; i += gn) {
        const int bh = i >> 13, e2 = i & 8191, vd = e2 >> 6, kd = (e2 & 63) * 2;
        float sa = 0.f, sb = 0.f;
        for (int c0 = 0; c0 < 128; c0 += 16) {
            f32x2 kv[16], dc[16];
#pragma unroll
            for (int j = 0; j < 16; ++j) { const unsigned wv = *(const unsigned*)((const bf16*)KV + (size_t)(bh * 128 + c0 + j) * 16384 + vd * 128 + kd); kv[j][0] = __uint_as_float(wv << 16); kv[j][1] = __uint_as_float(wv & 0xffff0000u);
                dc[j] = *(const f32x2*)(DEC + (size_t)(bh * 128 + c0 + j) * 128 + kd); }
#pragma unroll
            for (int j = 0; j < 16; ++j) { *(unsigned*)(SIN + (size_t)(bh * 128 + c0 + j) * 16384 + vd * 128 + kd) = pk2(sa, sb); sa = dc[j][0] * sa + kv[j][0]; sb = dc[j][1] * sb + kv[j][1]; }
        }
    }
}
__device__ __forceinline__ void ph_hgO(const Ctx& c) {
    const bf16* ZH = WSP(bf16, WS_XB); bf16* Y = WSP(bf16, WS_YCAT); const float* lb = WSP(float, WS_LB); const bf16* SIN = WSP(bf16, WS_SIN); const float* ng = c.in[7];
    LAS bf16* QB = (LAS bf16*)c.lds; LAS bf16* QS = QB + 64 * 136; LAS bf16* KS = QS + 64 * 136; LAS bf16* VT = KS + 64 * 136;
    LAS float* SS = (LAS float*)(c.lds + MISC_OFF + 1024); LAS float* RS = SS + 512; LAS float* OT = (LAS float*)(VT + 128 * 72);
    const int d = c.tid & 127, seg = c.tid >> 7, r = c.lane & 31, hh = c.lane >> 5, w = c.wave, vdt = w & 3, tt = w >> 2;
    bf16x8 sfr[8]; unsigned short fl[16], qq[16], vv[16]; u32x4 gn0, gn1;
    const int ot = c.tid >> 3, ovd0 = (c.tid & 7) * 8;
    LAS unsigned char* ZW = c.lds + 104448 + w * 6144;
    const int zr = c.lane >> 3, zp = c.lane & 7;
#define HGO_DMA(U) do { const int _c = (U) & 127, _bh = (U) >> 7; const bf16* _z = ZH + ((size_t)_bh * SEQ + _c * 64 + 16 * seg + zr) * 128 + 64 * (w & 1) + zp * 8; \
        _Pragma("unroll") for (int _a = 0; _a < 3; ++_a) _Pragma("unroll") for (int _hr = 0; _hr < 2; ++_hr) \
            __builtin_amdgcn_global_load_lds((const unsigned*)(_z + (size_t)(_a == 0 ? 1 : _a == 1 ? 0 : 2) * ZH_AS + (8 * _hr) * 128), (LAS unsigned*)(ZW + _a * 2048 + _hr * 1024), 16, 0, 0); } while (0)
#define HGO_LOAD_G(U) do { const int _c = (U) & 127, _bh = (U) >> 7; \
        const bf16* _gp = ZH + 3 * ZH_AS + ((size_t)_bh * SEQ + _c * 64 + ot) * 128 + ovd0; gn0 = *(const u32x4*)_gp; gn1 = *(const u32x4*)(_gp + 64); } while (0)
#define HGO_COLS(NW) do { asm volatile("s_waitcnt vmcnt(" #NW ")" ::: "memory"); _Pragma("unroll") for (int i = 0; i < 16; ++i) { fl[i] = *(const LAS unsigned short*)(ZW + i * 128 + c.lane * 2); \
        qq[i] = *(const LAS unsigned short*)(ZW + 2048 + i * 128 + c.lane * 2); vv[i] = *(const LAS unsigned short*)(ZW + 4096 + i * 128 + c.lane * 2); } asm volatile("s_waitcnt lgkmcnt(0)" ::: "memory"); } while (0)
#define HGO_LOAD_S(U) do { const bf16* _sp = SIN + (size_t)(U) * 16384 + (32 * vdt + r) * 128 + 8 * hh; _Pragma("unroll") for (int k8 = 0; k8 < 8; ++k8) sfr[k8] = *(const bf16x8*)(_sp + 16 * k8); } while (0)
    if (c.bid < 2048) { HGO_DMA(c.bid); HGO_LOAD_G(c.bid); HGO_LOAD_S(c.bid); HGO_COLS(0); }
    for (int u = c.bid; u < 2048; u += c.G) {
        const int chunk = u & 127, bh = u >> 7, h = bh & 7, b = bh >> 3; const int t0 = b * SEQ + chunk * 64;
        const u32x4 gc0 = gn0, gc1 = gn1;
        if (u + c.G < 2048) { HGO_DMA(u + c.G); HGO_LOAD_G(u + c.G); }
        const float lbv = lb[h * 128 + d];
        float cs[16], kk[16]; float run = 0.f;
#pragma unroll
        for (int i = 0; i < 16; ++i) { const float f = lbv + (1.0f - lbv) * sigmoidf_(bf2f(fl[i])); kk[i] = 1.0f - f; run += __builtin_amdgcn_logf(f); cs[i] = run; }
        SS[seg * 128 + d] = run;
        __syncthreads();
        { const float s0 = SS[d], s1 = SS[128 + d], s2 = SS[256 + d];
          const float prefix = (seg > 0 ? s0 : 0.f) + (seg > 1 ? s1 : 0.f) + (seg > 2 ? s2 : 0.f), ref = s0 + s1;
#pragma unroll
          for (int i = 0; i < 16; ++i) { const float bb = prefix + cs[i], q = bf2f(qq[i]); const int t = 16 * seg + i;
              QB[t * 136 + d] = f2bf(q * __builtin_amdgcn_exp2f(bb)); QS[t * 136 + d] = f2bf(q * __builtin_amdgcn_exp2f(bb - ref)); KS[t * 136 + d] = f2bf(kk[i] * __builtin_amdgcn_exp2f(ref - bb)); }
          *(LAS u32x4*)(VT + d * 72 + 16 * seg) = pk8us(vv[0], vv[1], vv[2], vv[3], vv[8], vv[9], vv[10], vv[11]);
          *(LAS u32x4*)(VT + d * 72 + 16 * seg + 8) = pk8us(vv[4], vv[5], vv[6], vv[7], vv[12], vv[13], vv[14], vv[15]); }
        __syncthreads();
        f32x16 acc;
#pragma unroll
        for (int i = 0; i < 16; ++i) acc[i] = 0.f;
#pragma unroll
        for (int k8 = 0; k8 < 8; ++k8) { const bf16x8 bq = *(const LAS bf16x8*)(QB + (32 * tt + r) * 136 + 16 * k8 + 8 * hh); acc = __builtin_amdgcn_mfma_f32_32x32x16_bf16(sfr[k8], bq, acc, 0, 0, 0); }
        if (u + c.G < 2048) HGO_LOAD_S(u + c.G);
        for (int st = 0; st <= tt; ++st) {
            f32x16 x;
#pragma unroll
            for (int i = 0; i < 16; ++i) x[i] = 0.f;
#pragma unroll
            for (int k8 = 0; k8 < 8; ++k8) { const bf16x8 ak = *(const LAS bf16x8*)(KS + (32 * st + r) * 136 + 16 * k8 + 8 * hh), bq = *(const LAS bf16x8*)(QS + (32 * tt + r) * 136 + 16 * k8 + 8 * hh);
                x = __builtin_amdgcn_mfma_f32_32x32x16_bf16(ak, bq, x, 0, 0, 0); }
            if (st == tt) {
#pragma unroll
                for (int i = 0; i < 16; ++i) { const int row = (i & 3) + 8 * (i >> 2) + 4 * hh; if (row > r) x[i] = 0.f; }
            }
#pragma unroll
            for (int sp = 0; sp < 2; ++sp) {
                u32x4 pw; pw.x = pk2(x[8 * sp], x[8 * sp + 1]); pw.y = pk2(x[8 * sp + 2], x[8 * sp + 3]); pw.z = pk2(x[8 * sp + 4], x[8 * sp + 5]); pw.w = pk2(x[8 * sp + 6], x[8 * sp + 7]);
                const bf16x8 pf = __builtin_bit_cast(bf16x8, pw);
                const bf16x8 av = *(const LAS bf16x8*)(VT + (32 * vdt + r) * 72 + 32 * st + 16 * sp + 8 * hh);
                acc = __builtin_amdgcn_mfma_f32_32x32x16_bf16(av, pf, acc, 0, 0, 0);
            }
        }
        { float ss = 0.f;
#pragma unroll
          for (int i = 0; i < 16; ++i) ss += acc[i] * acc[i];
          ss += __shfl_xor(ss, 32);
          if (hh == 0) RS[(tt * 4 + vdt) * 32 + r] = ss;
#pragma unroll
          for (int i4 = 0; i4 < 4; ++i4) *(LAS f32x4*)(OT + (32 * tt + r) * 132 + 32 * vdt + 8 * i4 + 4 * hh) = (f32x4){acc[4 * i4], acc[4 * i4 + 1], acc[4 * i4 + 2], acc[4 * i4 + 3]}; }
        __syncthreads();
        if (u + c.G < 2048) HGO_COLS(8);
        { const int t = ot, vd0 = ovd0;
          const float ssum = (RS[((t >> 5) * 4 + 0) * 32 + (t & 31)] + RS[((t >> 5) * 4 + 1) * 32 + (t & 31)]) + (RS[((t >> 5) * 4 + 2) * 32 + (t & 31)] + RS[((t >> 5) * 4 + 3) * 32 + (t & 31)]);
          const float rr = rsqrtf(ssum * (1.0f / 128.0f) + EPS);
#pragma unroll
          for (int hf = 0; hf < 2; ++hf) { float g[8], o[8]; unpack8(hf ? gc1 : gc0, g);
              const f32x4 oa = *(const LAS f32x4*)(OT + t * 132 + vd0 + 64 * hf), ob = *(const LAS f32x4*)(OT + t * 132 + vd0 + 64 * hf + 4);
#pragma unroll
              for (int j = 0; j < 4; ++j) { o[j] = oa[j] * rr * ng[vd0 + 64 * hf + j] * siluf_(g[j]); o[4 + j] = ob[j] * rr * ng[vd0 + 64 * hf + 4 + j] * siluf_(g[4 + j]); }
              *(u32x4*)(Y + (size_t)(t0 + t) * D_ + 1024 + h * 128 + vd0 + 64 * hf) = pack8(o); } }
    }
}

#undef HGO_DMA
#undef HGO_LOAD_G
#undef HGO_COLS
#undef HGO_LOAD_S
struct EpiRes {
    const float* R; float* O; bf16* HBo; const float* g;
    __device__ __forceinline__ void operator()(const f32x4 (&acc)[2][2][4][2], const pg::Unit& u, int wr, int wc, int fr, int fq) const {
        const int colb = u.pn * 256 + wc * 32 + 8 * fq;
        f32x4 gv[2][2];
#pragma unroll
        for (int bj = 0; bj < 2; ++bj)
#pragma unroll
            for (int n = 0; n < 2; ++n) gv[bj][n] = *(const f32x4*)(g + colb + bj * 128 + n * 4);
#pragma unroll
        for (int ai = 0; ai < 2; ++ai)
#pragma unroll
            for (int m = 0; m < 4; ++m) { const int row = u.pm * 256 + ai * 128 + wr * 64 + m * 16 + fr; const size_t off = (size_t)row * D_ + colb;
#pragma unroll
                for (int bj = 0; bj < 2; ++bj) { f32x4 o[2];
#pragma unroll
                    for (int n = 0; n < 2; ++n) { const f32x4 r = *(const f32x4*)(R + off + bj * 128 + n * 4); o[n] = r + acc[ai][bj][m][n]; *(f32x4*)(O + off + bj * 128 + n * 4) = o[n]; }
                    u32x4 w; w.x = pk2(o[0][0] * gv[bj][0][0], o[0][1] * gv[bj][0][1]); w.y = pk2(o[0][2] * gv[bj][0][2], o[0][3] * gv[bj][0][3]);
                    w.z = pk2(o[1][0] * gv[bj][1][0], o[1][1] * gv[bj][1][1]); w.w = pk2(o[1][2] * gv[bj][1][2], o[1][3] * gv[bj][1][3]);
                    *(u32x4*)(HBo + off + bj * 128) = w; } }
    }
};
__device__ __forceinline__ void ph_outproj(const Ctx& c) {
    if (NAIVE_GEMM & 2) {
        const bf16* A = WSP(bf16, WS_YCAT); const float* X = c.in[0]; float* O = WSP(float, WS_XA); bf16* HBn = WSP(bf16, WS_HB); const float* gn = c.in[2];
        naive_gemm<false>(c, T_, 2048, 2048, [=](int r) { return A + (size_t)r * 2048; }, c.in[8], nullptr, 2048, [=](int r, int col, float a, float) { const float o = X[(size_t)r * 2048 + col] + a; O[(size_t)r * 2048 + col] = o; HBn[(size_t)r * 2048 + col] = f2bf(o * gn[col]); });
    } else {
        pg::DenseSched S; S.init(WSP(bf16, WS_YCAT), WSP(bf16, WS_WOUT), T_, 2048, 2048, c.G, c.bid);
        EpiRes E{c.in[0], WSP(float, WS_XA), WSP(bf16, WS_HB), c.in[2]};
        pg::gemm_phase_w(c.lds, S, E, c.wave);
    }
}

template <int LAYER, bool DRY = false>
__device__ __forceinline__ void ph_router(const Ctx& c, const float* __restrict__ X) {
    constexpr int WST = 264, WBUF = 2 * 48 * WST;
    LAS bf16* WL = (LAS bf16*)c.lds;
    LAS float* P = (LAS float*)c.lds;
    LAS float* SSQ = P + 8 * 16 * 48;
    LAS float* LG = SSQ + 128;
    LAS float* RS = LG + 64 * 48;
    LAS int* DE = (LAS int*)(RS + 64); LAS int* DV = DE + 128; LAS int* LC = DV + 128; LAS int* LB = LC + 32; LAS float* DG = (LAS float*)(LB + 32);
    const bf16* WRS = WSP(bf16, WS_WR) + (size_t)LAYER * 48 * 2 * 2048;
    const float* bc = c.in[19] + LAYER * 4; const float* bfi = c.in[21] + LAYER * 32;
    int* rowl = WSP(int, WS_ROWL) + (size_t)LAYER * NE * CAP; float* tokg = WSP(float, WS_TOKG) + (size_t)LAYER * 2 * T_; float* tokr = WSP(float, WS_TOKR) + (size_t)LAYER * T_; u32x4* rowl16 = WSP(u32x4, WS_ROWL16) + (size_t)LAYER * NE * CAP;
    unsigned* cnt = WSP(unsigned, WS_CTL) + CW_CNT + LAYER * 32;
    const int tok = c.lane & 15, kq = c.lane >> 4, w = c.wave, tg = w & 3, kh = w >> 2;
#define RT_WSRC(idx, cc) (WRS + ((size_t)((((idx) % 1536) >> 5) * 2 + ((((idx) % 1536) & 31) >> 4)) * 2048) + 1024 * ((idx) / 1536) + 128 * (cc) + 8 * ((idx) & 15))
#define RT_WDST(idx, buf) (WL + (buf) * WBUF + (((idx) / 1536) * 48 + (((idx) % 1536) >> 5)) * WST + ((((idx) % 1536) & 31) >> 4) * 128 + 8 * ((idx) & 15))
    for (int pass = c.bid; pass < T_ / 64; pass += c.G) {
        const int t0 = pass * 64;
        const float* xr = X + (size_t)(t0 + 16 * tg + tok) * D_ + 1024 * kh + 8 * kq;
        u32x4 wst[6];
#pragma unroll
        for (int i = 0; i < 6; ++i) wst[i] = *(const u32x4*)RT_WSRC(c.tid + i * 512, 0);
#pragma unroll
        for (int i = 0; i < 6; ++i) *(LAS u32x4*)RT_WDST(c.tid + i * 512, 0) = wst[i];
        f32x4 xn[8];
#pragma unroll
        for (int i = 0; i < 4; ++i) { xn[2 * i] = *(const f32x4*)(xr + 32 * i); xn[2 * i + 1] = *(const f32x4*)(xr + 32 * i + 4); }
        __syncthreads();
        f32x4 acc[3]; acc[0] = acc[1] = acc[2] = (f32x4){0.f, 0.f, 0.f, 0.f};
        float ss = 0.f;
        for (int cc = 0; cc < 8; ++cc) {
            f32x4 xc[8];
#pragma unroll
            for (int i = 0; i < 8; ++i) xc[i] = xn[i];
            if (cc < 7) {
#pragma unroll
                for (int i = 0; i < 6; ++i) wst[i] = *(const u32x4*)RT_WSRC(c.tid + i * 512, cc + 1);
#pragma unroll
                for (int i = 0; i < 4; ++i) { xn[2 * i] = *(const f32x4*)(xr + 128 * (cc + 1) + 32 * i); xn[2 * i + 1] = *(const f32x4*)(xr + 128 * (cc + 1) + 32 * i + 4); }
            }
            const LAS bf16* wb = WL + (cc & 1) * WBUF + (kh * 48 + tok) * WST + 8 * kq;
#pragma unroll
            for (int i = 0; i < 4; ++i) {
                const f32x4 xa = xc[2 * i], xb = xc[2 * i + 1];
                u32x4 hw; hw.x = pk2(xa[0], xa[1]); hw.y = pk2(xa[2], xa[3]); hw.z = pk2(xb[0], xb[1]); hw.w = pk2(xb[2], xb[3]);
                u32x4 lw;
                lw.x = pk2(xa[0] - __uint_as_float(hw.x << 16), xa[1] - __uint_as_float(hw.x & 0xffff0000u)); lw.y = pk2(xa[2] - __uint_as_float(hw.y << 16), xa[3] - __uint_as_float(hw.y & 0xffff0000u));
                lw.z = pk2(xb[0] - __uint_as_float(hw.z << 16), xb[1] - __uint_as_float(hw.z & 0xffff0000u)); lw.w = pk2(xb[2] - __uint_as_float(hw.w << 16), xb[3] - __uint_as_float(hw.w & 0xffff0000u));
                const bf16x8 ahi = __builtin_bit_cast(bf16x8, hw), alo = __builtin_bit_cast(bf16x8, lw);
#pragma unroll
                for (int j = 0; j < 4; ++j) ss += xa[j] * xa[j] + xb[j] * xb[j];
#pragma unroll
                for (int nt = 0; nt < 3; ++nt) {
                    const bf16x8 bhi = *(const LAS bf16x8*)(wb + nt * 16 * WST + 32 * i), blo = *(const LAS bf16x8*)(wb + nt * 16 * WST + 128 + 32 * i);
                    acc[nt] = __builtin_amdgcn_mfma_f32_16x16x32_bf16(ahi, bhi, acc[nt], 0, 0, 0);
                    acc[nt] = __builtin_amdgcn_mfma_f32_16x16x32_bf16(ahi, blo, acc[nt], 0, 0, 0);
                    acc[nt] = __builtin_amdgcn_mfma_f32_16x16x32_bf16(alo, bhi, acc[nt], 0, 0, 0);
                }
            }
            if (cc < 7) {
#pragma unroll
                for (int i = 0; i < 6; ++i) *(LAS u32x4*)RT_WDST(c.tid + i * 512, (cc + 1) & 1) = wst[i];
            }
            __syncthreads();
        }
        ss += __shfl_xor(ss, 16); ss += __shfl_xor(ss, 32);
#pragma unroll
        for (int nt = 0; nt < 3; ++nt)
#pragma unroll
            for (int r = 0; r < 4; ++r) P[(w * 16 + 4 * kq + r) * 48 + 16 * nt + tok] = acc[nt][r];
        if (kq == 0) SSQ[w * 16 + tok] = ss;
        __syncthreads();
        for (int i = c.tid; i < 64 * 48; i += 512) { const int tk = i / 48, n = i % 48, g4 = tk >> 4, tl = tk & 15; LG[i] = P[(g4 * 16 + tl) * 48 + n] + P[((g4 + 4) * 16 + tl) * 48 + n]; }
        if (c.tid < 64) { const int g4 = c.tid >> 4, tl = c.tid & 15; RS[c.tid] = rsqrtf((SSQ[g4 * 16 + tl] + SSQ[(g4 + 4) * 16 + tl]) * (1.0f / 2048.0f) + EPS); }
        __syncthreads();
        if (c.tid < 64) {
            const int t = t0 + c.tid; const float rr = RS[c.tid];
            float lc[4]; int grp = 0; float mx = -3.0e38f;
#pragma unroll
            for (int i = 0; i < 4; ++i) { lc[i] = rr * LG[c.tid * 48 + i] + bc[i]; if (lc[i] > mx) { mx = lc[i]; grp = i; } }
            float den = 0.f;
#pragma unroll
            for (int i = 0; i < 4; ++i) den += expf(lc[i] - mx);
            const float ptop = 1.0f / den;
            float fv[8]; int i0 = 0; float v0 = -3.0e38f;
#pragma unroll
            for (int i = 0; i < 8; ++i) { fv[i] = rr * LG[c.tid * 48 + 4 + grp * 8 + i] + bfi[grp * 8 + i]; if (fv[i] > v0) { v0 = fv[i]; i0 = i; } }
            int i1 = 0; float v1 = -3.0e38f;
#pragma unroll
            for (int i = 0; i < 8; ++i) if (i != i0 && fv[i] > v1) { v1 = fv[i]; i1 = i; }
            const float e1 = expf(v1 - v0); const float w0 = 1.0f / (1.0f + e1), w1 = e1 / (1.0f + e1);
            DE[2 * c.tid] = grp * 8 + i0; DV[2 * c.tid] = 2 * t; DE[2 * c.tid + 1] = grp * 8 + i1; DV[2 * c.tid + 1] = 2 * t + 1;
            DG[2 * c.tid] = ptop * w0; DG[2 * c.tid + 1] = ptop * w1;
            if (!DRY) { tokg[2 * t] = ptop * w0; tokg[2 * t + 1] = ptop * w1; tokr[t] = rr; }
        }
        if (c.tid < 32) LC[c.tid] = 0;
        __syncthreads();
        int rank0 = 0;
        if (c.tid < 128) rank0 = __hip_atomic_fetch_add(&LC[DE[c.tid]], 1, __ATOMIC_RELAXED, __HIP_MEMORY_SCOPE_WORKGROUP);
        __syncthreads();
        if (!DRY && c.tid < 32) { const int n = LC[c.tid]; LB[c.tid] = n ? (int)atomicAdd(&cnt[c.tid], (unsigned)n) : 0; }
        __syncthreads();
        if (!DRY && c.tid < 128) { const int e = DE[c.tid]; const size_t pos = (size_t)e * CAP + LB[e] + rank0; rowl[pos] = DV[c.tid];
            rowl16[pos] = (u32x4){(unsigned)DV[c.tid], __float_as_uint(DG[c.tid]), __float_as_uint(RS[c.tid >> 1]), 0u}; }
        __syncthreads();
    }
}

#undef RT_WSRC
#undef RT_WDST
struct MoeTab { const LAS int* tile0; const LAS int* cnt; const LAS unsigned char* tileExp; int ntiles; };
__device__ __forceinline__ MoeTab moe_tables(const Ctx& c, int layer) {
    LAS int* tile0 = (LAS int*)(c.lds + MISC_OFF + 64); LAS int* cn = (LAS int*)(c.lds + MISC_OFF + 256); LAS unsigned char* te = (LAS unsigned char*)(c.lds + MISC_OFF + 512);
    const unsigned* cnt = WSP(unsigned, WS_CTL) + CW_CNT + layer * 32;
    __syncthreads();
    if (c.tid < 64) {
        const int e = c.tid & 31; const int ce = (int)__hip_atomic_load(cnt + e, __ATOMIC_RELAXED, __HIP_MEMORY_SCOPE_AGENT); const int nt = (ce + 255) >> 8;
        int incl = nt;
#pragma unroll
        for (int o = 1; o < 32; o <<= 1) { const int v = __shfl_up(incl, o, 32); if (e >= o) incl += v; }
        if (c.tid < 32) { const int start = incl - nt; cn[e] = ce; tile0[e] = start; for (int j = 0; j < nt; ++j) te[start + j] = (unsigned char)e; if (e == 31) tile0[NE] = incl; }
    }
    __syncthreads();
    MoeTab t; t.tile0 = tile0; t.cnt = cn; t.tileExp = te; t.ntiles = tile0[NE]; return t;
}
struct EpiGU {
    bf16* H; const LAS unsigned char* lds;
    __device__ __forceinline__ void operator()(const f32x4 (&acc)[2][2][4][2], const pg::Unit& u, int wr, int wc, int fr, int fq) const {
        const LAS u32x4* lst = (const LAS u32x4*)(lds + LIST_OFF + u.lbuf * 4096);
        const unsigned hoff = ((unsigned)(u.pm * 16 + u.pn * 2 + (wc >> 1)) << 14) + (unsigned)((wc & 1) * 32 + 8 * fq);
#pragma unroll
        for (int ai = 0; ai < 2; ++ai)
#pragma unroll
            for (int m = 0; m < 4; ++m) { const int r = ai * 128 + wr * 64 + m * 16 + fr;
                const float rs = r < u.nvalid ? *(const LAS float*)((const LAS unsigned char*)lst + r * 16 + 8) : 0.f;
                u32x4 w = (u32x4){0u, 0u, 0u, 0u};
                if (r < u.nvalid) { float f[8];
#pragma unroll
                    for (int n = 0; n < 2; ++n)
#pragma unroll
                        for (int j = 0; j < 4; ++j) { const float a = rs * acc[ai][0][m][n][j]; f[n * 4 + j] = a * (rs * acc[ai][1][m][n][j]) * __builtin_amdgcn_rcpf(1.0f + __builtin_amdgcn_exp2f(-1.4426950408889634f * a)); }
                    w = pack8(f); }
                *(u32x4*)(H + (hoff + (unsigned)r * 64u)) = w; }
    }
};
struct EpiDown {
    bf16* Y; const LAS unsigned char* lds;
    __device__ __forceinline__ void operator()(const f32x4 (&acc)[2][2][4][2], const pg::Unit& u, int wr, int wc, int fr, int fq) const {
        const LAS u32x4* lst = (const LAS u32x4*)(lds + LIST_OFF + u.lbuf * 4096);
#pragma unroll
        for (int ai = 0; ai < 2; ++ai)
#pragma unroll
            for (int m = 0; m < 4; ++m) { const int r = ai * 128 + wr * 64 + m * 16 + fr;
                if (r < u.nvalid) { const u32x2 en = *(const LAS u32x2*)((const LAS unsigned char*)lst + r * 16); const int v = (int)en.x; const float g = __uint_as_float(en.y); bf16* rp = Y + (size_t)v * D_ + u.pn * 256 + wc * 32 + 8 * fq;
#pragma unroll
                    for (int bj = 0; bj < 2; ++bj) { float f[8];
#pragma unroll
                        for (int n = 0; n < 2; ++n)
#pragma unroll
                            for (int j = 0; j < 4; ++j) f[n * 4 + j] = g * acc[ai][bj][m][n][j];
                        *(u32x4*)(rp + bj * 128) = pack8(f); } } }
    }
};
template <int LAYER>
__device__ __forceinline__ void ph_moe_gu(const Ctx& c) {
    const MoeTab tb = moe_tables(c, LAYER);
    const int* rowl = WSP(int, WS_ROWL) + (size_t)LAYER * NE * CAP;
    if (NAIVE_GEMM & 4) {
        const bf16* hb = WSP(bf16, WS_HB); bf16* H = WSP(bf16, WS_HID); const float* tokr = WSP(float, WS_TOKR) + (size_t)LAYER * T_;
        for (int rt = 0; rt < tb.ntiles; ++rt) {
            const int e = tb.tileExp[rt], lt = rt - tb.tile0[e], nv = tb.cnt[e] - lt * 256; const int M = nv < 256 ? nv : 256;
            const float* Wg = c.in[22] + ((size_t)LAYER * 32 + e) * 2048 * 1024; const float* Wu = c.in[23] + ((size_t)LAYER * 32 + e) * 2048 * 1024;
            naive_gemm<true>(c, M, 1024, 2048, [=](int r) { return hb + (size_t)(rowl[(size_t)e * CAP + lt * 256 + r] >> 1) * 2048; }, Wg, Wu, 1024,
                             [=](int r, int col, float a, float b) { const float rs = tokr[rowl[(size_t)e * CAP + lt * 256 + r] >> 1]; H[(size_t)(rt * 256 + r) * FF + col] = f2bf(siluf_(rs * a) * (rs * b)); });
        }
    } else {
        pg::MoeSched<true> S; S.A = (const char*)WSP(bf16, WS_HB); S.B = (const char*)(WSP(bf16, WS_WGU) + (size_t)LAYER * 32 * 2048 * 2048); S.nt1 = 32; S.nt2 = 0; S.i0 = 0; S.i1 = 1 << 20; S.nN = 8; S.nwg = tb.ntiles * 8; S.G = c.G; S.c = c.bid;
        S.pitchA = 4096; S.pitchB = 4096; S.hA = 128 * 4096; S.hA2 = 0; S.hB2 = 0; S.A2 = S.A; S.B2 = S.B; S.expStrideB = 2048u * 2048u * 2u; S.tile0 = tb.tile0; S.cnt = tb.cnt; S.tileExp = tb.tileExp; S.rowl = rowl;
        S.rowl16 = WSP(u32x4, WS_ROWL16) + (size_t)LAYER * NE * CAP;
        EpiGU E{WSP(bf16, WS_HID), c.lds};
        if (CONV_IN_GEMM) {
            const int slot = (c.bid >> 3) % 4; S.i1 = slot + 1; pg::gemm_phase_w(c.lds, S, E, c.wave);
            conv_slice_moe(c, CVO_DN + LAYER * (CV_DN / 2), CV_DN / 2, S.nwg, 12);
            S.i0 = slot + 1; S.i1 = 1 << 20; pg::gemm_phase_w(c.lds, S, E, c.wave); }
        else pg::gemm_phase_w(c.lds, S, E, c.wave);
    }
}
template <int LAYER>
__device__ __forceinline__ void ph_moe_down(const Ctx& c) {
    const MoeTab tb = moe_tables(c, LAYER);
    const int* rowl = WSP(int, WS_ROWL) + (size_t)LAYER * NE * CAP; const float* tokg = WSP(float, WS_TOKG) + (size_t)LAYER * 2 * T_;
    bf16* Y = WSP(bf16, WS_KV);
    if (NAIVE_GEMM & 8) {
        const bf16* H = WSP(bf16, WS_HID);
        for (int rt = 0; rt < tb.ntiles; ++rt) {
            const int e = tb.tileExp[rt], lt = rt - tb.tile0[e], nv = tb.cnt[e] - lt * 256; const int M = nv < 256 ? nv : 256;
            const float* Wd = c.in[24] + ((size_t)LAYER * 32 + e) * 1024 * 2048;
            naive_gemm<false>(c, M, 2048, 1024, [=](int r) { return H + (size_t)(rt * 256 + r) * FF; }, Wd, nullptr, 2048,
                              [=](int r, int col, float a, float) { const int v = rowl[(size_t)e * CAP + lt * 256 + r]; Y[(size_t)v * D_ + col] = f2bf(tokg[v] * a); });
        }
    } else {
        pg::MoeSched<false> S; S.A = (const char*)WSP(bf16, WS_HID); S.B = (const char*)(WSP(bf16, WS_WD) + (size_t)LAYER * 32 * 2048 * 1024); S.nt1 = 16; S.nt2 = 0; S.i0 = 0; S.i1 = 1 << 20; S.nN = 8; S.nwg = tb.ntiles * 8; S.G = c.G; S.c = c.bid;
        S.pitchA = 128; S.pitchB = 2048; S.hA = 128 * 128; S.hA2 = 0; S.hB2 = 0; S.A2 = S.A; S.B2 = S.B; S.expStrideB = 2048u * 1024u * 2u; S.tile0 = tb.tile0; S.cnt = tb.cnt; S.tileExp = tb.tileExp; S.rowl = rowl;
        S.rowl16 = WSP(u32x4, WS_ROWL16) + (size_t)LAYER * NE * CAP;
        EpiDown E{Y, c.lds};
        if (CONV_IN_GEMM && LAYER == 0) {
            const int slot = (c.bid >> 3) % 4; S.i1 = slot + 1; pg::gemm_phase_w(c.lds, S, E, c.wave);
            conv_slice_moe(c, CVO_GU + CV_GU / 2, CV_GU1_SPLIT * 256, S.nwg, 7);
            S.i0 = slot + 1; S.i1 = 1 << 20; pg::gemm_phase_w(c.lds, S, E, c.wave); }
        else pg::gemm_phase_w(c.lds, S, E, c.wave);
    }
}

template <bool U2L>
__device__ __forceinline__ void ph_res_norm(const Ctx& c, const float* __restrict__ Xin, float* __restrict__ Xout, const float* __restrict__ g, bf16* __restrict__ U) {
    const bf16* Ys = WSP(bf16, WS_KV);
    const int gw = c.bid * NWAVE + c.wave, nw = c.G * NWAVE;
    for (int rb = gw; rb < T_ / 4; rb += nw) {
#pragma unroll 1
        for (int r4 = 0; r4 < 4; ++r4) {
            const int row = rb * 4 + r4;
            float v[32]; row_load32(Xin + (size_t)row * D_, c.lane, v);
            row_add_bf16(Ys + (size_t)(2 * row) * D_, c.lane, v); row_add_bf16(Ys + (size_t)(2 * row + 1) * D_, c.lane, v);
            if (Xout) {
#pragma unroll
            for (int cch = 0; cch < 4; ++cch) { *(f32x4*)(Xout + (size_t)row * D_ + cch * 512 + c.lane * 8) = (f32x4){v[cch * 8], v[cch * 8 + 1], v[cch * 8 + 2], v[cch * 8 + 3]};
                *(f32x4*)(Xout + (size_t)row * D_ + cch * 512 + c.lane * 8 + 4) = (f32x4){v[cch * 8 + 4], v[cch * 8 + 5], v[cch * 8 + 6], v[cch * 8 + 7]}; } }
            const float r = row_rstd(v);
            if (!U2L) row_store_norm_bf16(U + (size_t)row * D_, g, c.lane, v, r);
            else {
#pragma unroll
                for (int cch = 0; cch < 4; ++cch) { const f32x4 ga = *(const f32x4*)(g + cch * 512 + c.lane * 8), gb = *(const f32x4*)(g + cch * 512 + c.lane * 8 + 4); float f[8];
#pragma unroll
                    for (int j = 0; j < 4; ++j) { f[j] = v[cch * 8 + j] * r * ga[j]; f[4 + j] = v[cch * 8 + 4 + j] * r * gb[j]; }
                    *(LAS u32x4*)(c.lds + c.wave * 16640 + r4 * 4160 + cch * 1024 + c.lane * 16) = pack8(f); }
            }
        }
        if (U2L) {
#pragma unroll 4
            for (int it = 0; it < 16; ++it) { const int grp = it * 8 + (c.lane >> 3), r4 = (c.lane >> 1) & 3, hf = c.lane & 1;
                const u32x4 w = *(const LAS u32x4*)(c.lds + c.wave * 16640 + r4 * 4160 + grp * 32 + hf * 16);
                *(u32x4*)(U + ((size_t)grp * T_ + rb * 4 + r4) * 16 + hf * 8) = w; }
        }
    }
}

struct S5aSched {
    static constexpr bool GATHER = false, SEG2 = false, LIST = false, HALFN = true; static constexpr int KSA = 128;
    const char* A; const char* B; const char* A2; const char* B2; int zoff; int nt1, nt2, G, c; int hA, hA2, hB2;
    __device__ __forceinline__ unsigned voffA(int R, int C) const { return (unsigned)(R * 1024 + C * 2); }
    __device__ __forceinline__ unsigned voffB(int R, int C) const { return (unsigned)(R * 1024 + C * 2); }
    __device__ __forceinline__ unsigned voffA2(int, int) const { return 0u; }
    __device__ __forceinline__ unsigned voffB2(int, int) const { return 0u; }
    __device__ __forceinline__ bool next(int i, pg::Unit& u) const {
        const int L = i * G + c; if (L >= 256) return false;
        const int g = L >> 1, pm = L & 1; u.pm = pm; u.pn = 0; u.e = g; u.nvalid = 256;
        u.oA = (unsigned)g * 524288u + (unsigned)pm * 262144u; u.oB = (unsigned)g * 131072u; u.oA2 = 0u; u.oB2 = 0u; u.hB = zoff - (int)u.oB; return true;
    }
    __device__ __forceinline__ unsigned grow(const pg::Unit&, int) const { return 0u; }
    __device__ __forceinline__ void list_issue(const pg::Unit&, LAS unsigned char*, int, int, int) const {}
};
constexpr int LSW = 132;
struct EpiS5Loc {
    float* L; LAS float* LS; int to_lds;
    __device__ __forceinline__ void operator()(const f32x4 (&acc)[2][2][4][2], const pg::Unit& u, int wr, int wc, int fr, int fq) const {
        if (to_lds) {
            asm volatile("s_waitcnt vmcnt(0)" ::: "memory");
            __builtin_amdgcn_s_barrier();
#pragma unroll
            for (int ai = 0; ai < 2; ++ai)
#pragma unroll
                for (int m = 0; m < 4; ++m) { LAS float* rp = LS + (ai * 128 + wr * 64 + m * 16 + fr) * LSW + wc * 32 + 8 * fq;
                    *(LAS f32x4*)rp = acc[ai][0][m][0]; *(LAS f32x4*)(rp + 4) = acc[ai][0][m][1]; }
            return;
        }
#pragma unroll
        for (int ai = 0; ai < 2; ++ai)
#pragma unroll
            for (int m = 0; m < 4; ++m) { const int n = u.pm * 256 + ai * 128 + wr * 64 + m * 16 + fr; float* rp = L + ((size_t)u.e * 512 + n) * 128 + wc * 32 + 8 * fq;
                *(f32x4*)rp = acc[ai][0][m][0]; *(f32x4*)(rp + 4) = acc[ai][0][m][1]; }
    }
};
struct S5cSched {
    static constexpr bool GATHER = false, SEG2 = true, LIST = false, HALFN = false; static constexpr int KSA = 128;
    const char* A; const char* A2; const char* B; const char* B2; int nt1, nt2, G, c; int hA, hA2, hB2; int pnf;
    __device__ __forceinline__ unsigned voffA(int R_, int C) const { return (unsigned)(R_ * 1024 + C * 2); }
    __device__ __forceinline__ unsigned voffA2(int R_, int C) const { return (unsigned)(R_ * 256 + C * 2); }
    __device__ __forceinline__ unsigned voffB(int R_, int C) const { const int pj = perm32(R_ & 31), co = pj & 15, tl = 2 * (R_ >> 5) + (pj >> 4); return (unsigned)(co * 2048 + (31 - tl) * 32 + C * 2); }
    __device__ __forceinline__ unsigned voffB2(int R_, int C) const { return (unsigned)(R_ * 256 + C * 2); }
    __device__ __forceinline__ bool next(int i, pg::Unit& u) const {
        const int L = i * G + c; if (L >= 256) return false;
        const int wgid = (L & 7) * 32 + (L >> 3); const int g = wgid >> 1, pm = wgid & 1, pn = pnf;
        u.pm = pm; u.pn = pn; u.e = g; u.nvalid = 256;
        u.oA = (unsigned)g * 524288u + (unsigned)pm * 262144u; u.oA2 = (unsigned)g * 131072u + (unsigned)pm * 65536u;
        u.oB = (unsigned)(g * 32768 - pn * 512); u.hB = -256; u.oB2 = (unsigned)g * 131072u + (unsigned)pn * 65536u; return true;
    }
    __device__ __forceinline__ unsigned grow(const pg::Unit&, int) const { return 0u; }
    __device__ __forceinline__ void list_issue(const pg::Unit&, LAS unsigned char*, int, int, int) const {}
};
struct EpiS5Out {
    bf16* V; const bf16* U2; const float* dsk;
    __device__ __forceinline__ void operator()(const f32x4 (&acc)[2][2][4][2], const pg::Unit& u, int wr, int wc, int fr, int fq) const {
        const int g = u.e, ch0 = (fq & 1) * 8; float dv[8];
#pragma unroll
        for (int q = 0; q < 8; ++q) dv[q] = dsk[g * 16 + ch0 + q];
#pragma unroll
        for (int ai = 0; ai < 2; ++ai)
#pragma unroll
            for (int m = 0; m < 4; ++m) { const int n = u.pm * 256 + ai * 128 + wr * 64 + m * 16 + fr;
#pragma unroll
                for (int bj = 0; bj < 2; ++bj) { const int t = u.pn * 16 + 8 * bj + 2 * wc + (fq >> 1); const int token = n * 32 + t;
                    float uu[8], o[8]; unpack8(*(const u32x4*)(U2 + ((size_t)g * T_ + token) * 16 + ch0), uu);
#pragma unroll
                    for (int q = 0; q < 8; ++q) o[q] = gelu_tanh(acc[ai][bj][m][q >> 2][q & 3] + dv[q] * uu[q]);
                    *(u32x4*)(V + (((size_t)n * 128 + g) * 32 + t) * 16 + ch0) = pack8(o); } }
    }
};
__device__ __forceinline__ void ph_s5a(const Ctx& c) {
    S5aSched S; S.A = (const char*)WSP(bf16, WS_HB); S.B = (const char*)WSP(bf16, WS_S5WST); S.A2 = S.A; S.B2 = S.B; S.zoff = (int)(WS_S5ZERO - WS_S5WST); S.nt1 = 8; S.nt2 = 0; S.G = c.G; S.c = c.bid; S.hA = 128 * 1024; S.hA2 = 0; S.hB2 = 0;
    EpiS5Loc E{WSP(float, WS_S5LOC), (LAS float*)c.lds, (S5_MERGE && c.G == 256) ? 1 : 0};
    pg::gemm_phase_w(c.lds, S, E, c.wave);
}
__device__ __forceinline__ void ph_s5b(const Ctx& c, bool from_lds) {
    const float* L = WSP(float, WS_S5LOC); bf16* H = WSP(bf16, WS_S5HIN); const float* A32 = WSP(float, WS_S5A32);
    LAS float* LS = (LAS float*)c.lds;
    const int p = c.tid & 63, seg = c.tid >> 6;
    for (int item = c.bid; item < 256; item += c.G) {
        const int g = item >> 1, b = item & 1;
        const size_t base = ((size_t)g * 512 + b * 256) * 128;
        if (!from_lds) {
#pragma unroll
            for (int i = 0; i < 16; ++i) { const int e4 = (i * 512 + c.tid) * 4; const f32x4 v = *(const f32x4*)(L + base + e4); *(LAS f32x4*)(LS + (e4 >> 7) * LSW + (e4 & 127)) = v; }
        }
        const float er = A32[(size_t)(g * 64 + p) * 2], ei = A32[(size_t)(g * 64 + p) * 2 + 1];
        __syncthreads();
        float hr = 0.f, hi = 0.f;
        for (int i = 0; i < 32; ++i) { const int n = seg * 32 + i; const float lr = LS[n * LSW + p], li = LS[n * LSW + 64 + p];
            const float nr = er * hr - ei * hi + lr, ni = er * hi + ei * hr + li; hr = nr; hi = ni; LS[n * LSW + p] = hr; LS[n * LSW + 64 + p] = hi; }
        __syncthreads();
        float pr = er, pi = ei;
#pragma unroll
        for (int q = 0; q < 5; ++q) { const float nr = pr * pr - pi * pi, ni = 2.0f * pr * pi; pr = nr; pi = ni; }
        float cr = 0.f, ci = 0.f;
        for (int sp = 0; sp < seg; ++sp) { const float fr = LS[(sp * 32 + 31) * LSW + p], fi = LS[(sp * 32 + 31) * LSW + 64 + p];
            const float nr = pr * cr - pi * ci + fr, ni = pr * ci + pi * cr + fi; cr = nr; ci = ni; }
        __syncthreads();
        float wr = er, wi = ei;
        for (int i = 0; i < 32; ++i) { const int n = seg * 32 + i;
            const float vr = LS[n * LSW + p] + (wr * cr - wi * ci), vi = LS[n * LSW + 64 + p] + (wr * ci + wi * cr);
            LAS bf16* hb = (LAS bf16*)(LS + n * LSW); hb[p] = f2bf(vr); hb[64 + p] = f2bf(vi);
            const float nr = wr * er - wi * ei, ni = wr * ei + wi * er; wr = nr; wi = ni; }
        __syncthreads();
        bf16* hp = H + base;
#pragma unroll
        for (int ps = 0; ps < 8; ++ps) { const int row = ps * 32 + (c.tid >> 4), piece = c.tid & 15;
            if (row < 255) *(u32x4*)(hp + (size_t)(row + 1) * 128 + piece * 8) = *(const LAS u32x4*)((const LAS unsigned char*)(LS + row * LSW) + piece * 16); }
        if (c.tid < 16) *(u32x4*)(hp + c.tid * 8) = (u32x4){0u, 0u, 0u, 0u};
        __syncthreads();
    }
}
__device__ __forceinline__ void ph_s5c(const Ctx& c) {
    S5cSched S; S.A = (const char*)WSP(bf16, WS_HB); S.A2 = (const char*)WSP(bf16, WS_S5HIN); S.B = (const char*)WSP(bf16, WS_S5R); S.B2 = (const char*)WSP(bf16, WS_S5WC);
    S.nt1 = 8; S.nt2 = 2; S.G = c.G; S.c = c.bid; S.hA = 128 * 1024; S.hA2 = 128 * 256; S.hB2 = 128 * 256;
    EpiS5Out E{WSP(bf16, WS_YCAT), WSP(bf16, WS_HB), c.in[16]};
#pragma unroll 1
    for (int hp = 0; hp < 2; ++hp) { S.pnf = hp; S.nt1 = 4 + 4 * hp; pg::gemm_phase_w(c.lds, S, E, c.wave); }
}

__device__ __forceinline__ void s5_load_u(LAS float* ut, const bf16* __restrict__ U, int tbase, int g, int lane) {
    const bf16* p = U + (size_t)(tbase + lane) * D_ + g * 16; float f0[8], f1[8]; unpack8(*(const u32x4*)p, f0); unpack8(*(const u32x4*)(p + 8), f1);
    LAS float* q = ut + lane * 16;
#pragma unroll
    for (int j = 0; j < 8; ++j) { q[j] = f0[j]; q[8 + j] = f1[j]; }
}
template <int MODE>
__device__ __forceinline__ void ph_s5_chunks(const Ctx& c) {
    const bf16* U = WSP(bf16, WS_HB); bf16* V = WSP(bf16, WS_YCAT); float* LOC = WSP(float, WS_S5L);
    const float* A4 = WSP(float, WS_S5A); const float* BB = WSP(float, WS_S5B);
    LAS float* CR = (LAS float*)c.lds;
    LAS float* CI = CR + 16 * 65;
    LAS float* UT = CI + 16 * 65 + c.wave * 1024;
    LAS float* HR = (LAS float*)c.lds + 2 * 16 * 65 + 8 * 1024 + c.wave * (2 * 16 * 65);
    LAS float* HI = HR + 16 * 65;
    const int p = c.lane;
    for (int item = c.bid; item < 256; item += c.G) {
        const int g = item >> 1, b = item & 1;
        __syncthreads();
        if (MODE == 1) { for (int i = c.tid; i < 1024; i += 512) { const int co = i >> 6, pp = i & 63; CR[co * 65 + pp] = c.in[14][(size_t)g * 1024 + i]; CI[co * 65 + pp] = c.in[15][(size_t)g * 1024 + i]; } }
        __syncthreads();
        const float ar = A4[(size_t)(g * 64 + p) * 4], ai = A4[(size_t)(g * 64 + p) * 4 + 1];
        float br[16], bi[16];
#pragma unroll
        for (int j = 0; j < 16; ++j) { br[j] = BB[(size_t)(g * 64 + p) * 32 + j]; bi[j] = BB[(size_t)(g * 64 + p) * 32 + 16 + j]; }
        for (int chunk = c.wave; chunk < NCH; chunk += NWAVE) {
            const int tbase = b * SEQ + chunk * 64;
            s5_load_u(UT, U, tbase, g, c.lane);
            float hr = 0.f, hi = 0.f;
            const size_t li = ((size_t)((b * NCH + chunk) * 128 + g) * 64 + p) * 2;
            if (MODE == 1) { hr = LOC[li]; hi = LOC[li + 1]; }
            for (int sub = 0; sub < 4; ++sub) {
#pragma unroll 4
                for (int tt = 0; tt < 16; ++tt) {
                    const LAS float* up = UT + (sub * 16 + tt) * 16; float xr = 0.f, xi = 0.f;
#pragma unroll
                    for (int q4 = 0; q4 < 4; ++q4) { const f32x4 u4 = *(const LAS f32x4*)(up + q4 * 4);
#pragma unroll
                        for (int j = 0; j < 4; ++j) { xr += br[q4 * 4 + j] * u4[j]; xi += bi[q4 * 4 + j] * u4[j]; } }
                    const float nr = ar * hr - ai * hi + xr, ni = ar * hi + ai * hr + xi; hr = nr; hi = ni;
                    if (MODE == 1) { HR[tt * 65 + p] = hr; HI[tt * 65 + p] = hi; }
                }
                if (MODE == 1) {
                    const int tl = c.lane & 15, cq = c.lane >> 4; float y[4] = {0.f, 0.f, 0.f, 0.f};
                    for (int pp = 0; pp < 64; ++pp) { const float h_r = HR[tl * 65 + pp], h_i = HI[tl * 65 + pp];
#pragma unroll
                        for (int j = 0; j < 4; ++j) y[j] += CR[(cq * 4 + j) * 65 + pp] * h_r - CI[(cq * 4 + j) * 65 + pp] * h_i; }
                    const int t = tbase + sub * 16 + tl; const LAS float* up = UT + (sub * 16 + tl) * 16 + cq * 4;
                    float o[4];
#pragma unroll
                    for (int j = 0; j < 4; ++j) o[j] = gelu_tanh(y[j] + c.in[16][g * 16 + cq * 4 + j] * up[j]);
                    u32x2 w; w.x = pk2(o[0], o[1]); w.y = pk2(o[2], o[3]);
                    *(u32x2*)(V + (size_t)t * D_ + g * 16 + cq * 4) = w;
                }
            }
            if (MODE == 0) { LOC[li] = hr; LOC[li + 1] = hi; }
        }
    }
}
__device__ __forceinline__ void ph_s5_scan(const Ctx& c) {
    float* LOC = WSP(float, WS_S5L); const float* A4 = WSP(float, WS_S5A);
    const int gtid = c.bid * NTHR + c.tid, gn = c.G * NTHR;
    for (int i = gtid; i < 2 * 128 * 64; i += gn) {
        const int b = i >> 13, gp = i & 8191;
        const float er = A4[(size_t)gp * 4 + 2], ei = A4[(size_t)gp * 4 + 3];
        float hr = 0.f, hi = 0.f;
        for (int ch = 0; ch < NCH; ++ch) { const size_t li = ((size_t)(b * NCH + ch) * 8192 + gp) * 2; const float lr = LOC[li], lim = LOC[li + 1]; LOC[li] = hr; LOC[li + 1] = hi;
            const float nr = er * hr - ei * hi + lr, ni = er * hi + ei * hr + lim; hr = nr; hi = ni; }
    }
}

struct EpiGlu {
    const float* R; float* O; bf16* HBo; const float* g; const bf16* Ys;
    __device__ __forceinline__ void operator()(const f32x4 (&acc)[2][2][4][2], const pg::Unit& u, int wr, int wc, int fr, int fq) const {
        const int colb = u.pn * 128 + wc * 32 + 8 * fq;
        const f32x4 g0 = *(const f32x4*)(g + colb), g1 = *(const f32x4*)(g + colb + 4);
#pragma unroll
        for (int ai = 0; ai < 2; ++ai) {
            f32x4 rv[4][2]; u32x4 ya[4], yb[4];
#pragma unroll
            for (int m = 0; m < 4; ++m) { const size_t row = (size_t)(u.pm * 256 + ai * 128 + wr * 64 + m * 16 + fr);
#pragma unroll
                for (int n = 0; n < 2; ++n) rv[m][n] = *(const f32x4*)(R + row * D_ + colb + n * 4);
                if (Ys) { ya[m] = *(const u32x4*)(Ys + (2 * row) * D_ + colb); yb[m] = *(const u32x4*)(Ys + (2 * row + 1) * D_ + colb); } }
            asm volatile("" ::: "memory");
#pragma unroll
            for (int m = 0; m < 4; ++m) { const size_t off = (size_t)(u.pm * 256 + ai * 128 + wr * 64 + m * 16 + fr) * D_ + colb; f32x4 o[2];
                if (Ys) { float fa[8], fb[8]; unpack8(ya[m], fa); unpack8(yb[m], fb);
#pragma unroll
                    for (int j = 0; j < 4; ++j) { rv[m][0][j] += fa[j] + fb[j]; rv[m][1][j] += fa[4 + j] + fb[4 + j]; } }
#pragma unroll
                for (int n = 0; n < 2; ++n) {
#pragma unroll
                    for (int j = 0; j < 4; ++j) o[n][j] = rv[m][n][j] + acc[ai][0][m][n][j] * sigmoidf_(acc[ai][1][m][n][j]);
                    *(f32x4*)(O + off + n * 4) = o[n]; }
                u32x4 w; w.x = pk2(o[0][0] * g0[0], o[0][1] * g0[1]); w.y = pk2(o[0][2] * g0[2], o[0][3] * g0[3]); w.z = pk2(o[1][0] * g1[0], o[1][1] * g1[1]); w.w = pk2(o[1][2] * g1[2], o[1][3] * g1[3]);
                *(u32x4*)(HBo + off) = w; }
            asm volatile("" ::: "memory");
        }
    }
};
struct GluSched : pg::DenseSched {
    static constexpr int KSA = 4096;
    __device__ __forceinline__ unsigned voffA(int R, int C) const { return (unsigned)((R >> 5) * 131072 + (C >> 4) * 1024 + (R & 31) * 32 + (C & 15) * 2); }
};
__device__ __forceinline__ void ph_glu(const Ctx& c) {
    if (NAIVE_GEMM & 16) {
        const bf16* A = WSP(bf16, WS_YCAT); const float* X = WSP(float, WS_XB); float* O = WSP(float, WS_XA); bf16* HBn = WSP(bf16, WS_HB); const float* gn = c.in[2] + 2048;
        naive_gemm<true>(c, T_, 2048, 2048, [=](int r) { return A + (size_t)r * 2048; }, c.in[17], c.in[17] + 2048, 4096, [=](int r, int col, float a, float b) { const float o = X[(size_t)r * 2048 + col] + a * sigmoidf_(b); O[(size_t)r * 2048 + col] = o; HBn[(size_t)r * 2048 + col] = f2bf(o * gn[col]); });
    } else {
        GluSched S; S.init(WSP(bf16, WS_YCAT), WSP(bf16, WS_WGLU), T_, 4096, 2048, c.G, c.bid);
        EpiGlu E{SKIP_X2 ? WSP(float, WS_XA) : WSP(float, WS_XB), WSP(float, WS_XA), WSP(bf16, WS_HB), c.in[2] + 2048, SKIP_X2 ? WSP(bf16, WS_KV) : (const bf16*)nullptr};
        if (CONV_IN_GEMM) {
            const int slot = (c.bid >> 3) % 4; S.i1 = slot + 1; pg::gemm_phase_w(c.lds, S, E, c.wave);
            conv_slice(c, CVO_GU + CV_GU / 2 + CV_GU1_SPLIT * 256, CV_GU / 2 - CV_GU1_SPLIT * 256, 0, 0, 0, 0);
            S.i0 = slot + 1; S.i1 = 1 << 20; pg::gemm_phase_w(c.lds, S, E, c.wave); }
        else pg::gemm_phase_w(c.lds, S, E, c.wave);
    }
}

__device__ __forceinline__ void ph_final(const Ctx& c) {
    const bf16* Ys = WSP(bf16, WS_KV); const float* X = WSP(float, WS_XA); const float* g = c.in[3];
    const int gw = c.bid * NWAVE + c.wave, nw = c.G * NWAVE;
    for (int row = gw; row < T_; row += nw) {
        float v[32]; row_load32(X + (size_t)row * D_, c.lane, v);
        row_add_bf16(Ys + (size_t)(2 * row) * D_, c.lane, v); row_add_bf16(Ys + (size_t)(2 * row + 1) * D_, c.lane, v);
        const float r = row_rstd(v);
#pragma unroll
        for (int cch = 0; cch < 4; ++cch) { const f32x4 ga = *(const f32x4*)(g + cch * 512 + c.lane * 8), gb = *(const f32x4*)(g + cch * 512 + c.lane * 8 + 4);
            *(f32x4*)(c.out + (size_t)row * D_ + cch * 512 + c.lane * 8) = (f32x4){v[cch * 8] * r * ga[0], v[cch * 8 + 1] * r * ga[1], v[cch * 8 + 2] * r * ga[2], v[cch * 8 + 3] * r * ga[3]};
            *(f32x4*)(c.out + (size_t)row * D_ + cch * 512 + c.lane * 8 + 4) = (f32x4){v[cch * 8 + 4] * r * gb[0], v[cch * 8 + 5] * r * gb[1], v[cch * 8 + 6] * r * gb[2], v[cch * 8 + 7] * r * gb[3]}; }
    }
}

constexpr int NPHASE = 18;
__global__ void __launch_bounds__(NTHR, 2) mk_fwd(Args args) {
    extern __shared__ __attribute__((aligned(16))) unsigned char lds_raw[];
    Ctx c;
#pragma unroll
    for (int i = 0; i < 25; ++i) c.in[i] = args.in[i];
    c.out = args.out; c.ws = args.ws; c.lds = (LAS unsigned char*)lds_raw;
    c.wave = __builtin_amdgcn_readfirstlane((int)threadIdx.x >> 6); c.lane = lane_id(); c.tid = c.wave * 64 + c.lane;     c.G = gridDim.x; c.bid = blockIdx.x;
    const int lo = args.ph_lo, hi = args.ph_hi;
    volatile LAS unsigned* st = (volatile LAS unsigned*)(c.lds + MISC_OFF);
    if (c.tid < 4) st[c.tid] = 0u;
    __syncthreads();
    XcdBarrier bar; bar.bar = WSP(unsigned, WS_CTL) + CW_BAR; bar.x = 0; bar.st = st;
    if (hi - lo > 1) bar = xcd_barrier_post(WSP(unsigned, WS_CTL) + CW_BAR, st, c.tid == 0);
#define IN(k) (lo <= (k) && (k) < hi)
#define SEAM(k) do { c.lane = lane_id(); c.tid = c.wave * 64 + c.lane; if (IN(k) && IN((k) + 1)) { xcd_barrier(bar, c.tid == 0); if (PROBE_DUP & (1 << 30)) xcd_barrier(bar, c.tid == 0); } } while (0)
    if (IN(0)) { ph_prologue(c); if (PROBE_DUP & (1 << 0)) { __syncthreads(); ph_prologue(c); } }
    SEAM(0);
    if (IN(1)) { ph_inproj(c); if (PROBE_DUP & (1 << 1)) { __syncthreads(); ph_inproj(c); } }
    SEAM(1);
    if (IN(2)) { ph_conv_hglocal(c); if (HG_MFMA) ph_hgL(c); if (PROBE_DUP & (1 << 2)) { __syncthreads(); ph_conv_hglocal(c); if (HG_MFMA) ph_hgL(c); } }
    SEAM(2);
    if (IN(3)) { if (HG_MFMA) ph_hgS(c); else ph_hgscan(c); if (PROBE_DUP & (1 << 3)) { __syncthreads(); if (HG_MFMA) ph_hgS(c); else ph_hgscan(c); } }
    SEAM(3);
    if (IN(4)) { if (HG_MFMA) ph_hgO(c); else ph_hgout(c); if (PROBE_DUP & (1 << 4)) { __syncthreads(); if (HG_MFMA) ph_hgO(c); else ph_hgout(c); } }
    SEAM(4);
    if (IN(5)) { ph_outproj(c); if (PROBE_DUP & (1 << 5)) { __syncthreads(); ph_outproj(c); } }
    SEAM(5);
    if (IN(6)) { ph_router<0>(c, WSP(float, WS_XA)); if (PROBE_DUP & (1 << 6)) { __syncthreads(); ph_router<0, true>(c, WSP(float, WS_XA)); } }
    SEAM(6);
    if (IN(7)) { ph_moe_gu<0>(c); if (PROBE_DUP & (1 << 7)) { __syncthreads(); ph_moe_gu<0>(c); } }
    SEAM(7);
    if (IN(8)) { ph_moe_down<0>(c); if (PROBE_DUP & (1 << 8)) { __syncthreads(); ph_moe_down<0>(c); } }
    SEAM(8);
    if (IN(9)) { ph_res_norm<S5_MFMA != 0>(c, WSP(float, WS_XA), (SKIP_X2 && !(NAIVE_GEMM & 16)) ? (float*)nullptr : WSP(float, WS_XB), c.in[1] + 2048, WSP(bf16, WS_HB)); if (PROBE_DUP & (1 << 9)) { __syncthreads(); ph_res_norm<S5_MFMA != 0>(c, WSP(float, WS_XA), (SKIP_X2 && !(NAIVE_GEMM & 16)) ? (float*)nullptr : WSP(float, WS_XB), c.in[1] + 2048, WSP(bf16, WS_HB)); } }
    SEAM(9);
    if (IN(10)) { if (S5_MFMA) { ph_s5a(c); if (S5_MERGE && c.G == 256) { asm volatile("s_waitcnt vmcnt(0)" ::: "memory"); __syncthreads(); ph_s5b(c, true); } } else ph_s5_chunks<0>(c); if (PROBE_DUP & (1 << 10)) { __syncthreads(); if (S5_MFMA) ph_s5a(c); else ph_s5_chunks<0>(c); } }
    if (!(S5_MFMA && S5_MERGE && c.G == 256)) SEAM(10);
    if (IN(11)) { if (S5_MFMA) { if (!(S5_MERGE && c.G == 256)) ph_s5b(c, false); } else ph_s5_scan(c); if (PROBE_DUP & (1 << 11)) { __syncthreads(); if (S5_MFMA) ph_s5b(c, false); else ph_s5_scan(c); } }
    SEAM(11);
    if (IN(12)) { if (S5_MFMA) ph_s5c(c); else ph_s5_chunks<1>(c); if (PROBE_DUP & (1 << 12)) { __syncthreads(); if (S5_MFMA) ph_s5c(c); else ph_s5_chunks<1>(c); } }
    SEAM(12);
    if (IN(13)) { ph_glu(c); if (PROBE_DUP & (1 << 13)) { __syncthreads(); ph_glu(c); } }
    SEAM(13);
    if (IN(14)) { ph_router<1>(c, WSP(float, WS_XA)); if (PROBE_DUP & (1 << 14)) { __syncthreads(); ph_router<1, true>(c, WSP(float, WS_XA)); } }
    SEAM(14);
    if (IN(15)) { ph_moe_gu<1>(c); if (PROBE_DUP & (1 << 15)) { __syncthreads(); ph_moe_gu<1>(c); } }
    SEAM(15);
    if (IN(16)) { ph_moe_down<1>(c); if (PROBE_DUP & (1 << 16)) { __syncthreads(); ph_moe_down<1>(c); } }
    SEAM(16);
    if (IN(17)) { ph_final(c); if (PROBE_DUP & (1 << 17)) { __syncthreads(); ph_final(c); } }
#undef IN
#undef SEAM
}

extern "C" void kernel_launch(void* const* d_in, const int* in_sizes, int n_in, void* d_out, int out_size, void* d_ws, size_t ws_size, hipStream_t stream) {
    static int grid = 0;
    if (grid == 0) {
        if (n_in != 25 || out_size != T_ * D_ || ws_size < WS_END) { fprintf(stderr, "kernel_launch: unexpected shapes (n_in %d out %d ws %zu)\n", n_in, out_size, ws_size); grid = -1; return; }
        int dev = 0, cus = 0, per_cu = 0;
        if (hipGetDevice(&dev) != hipSuccess || hipDeviceGetAttribute(&cus, hipDeviceAttributeMultiprocessorCount, dev) != hipSuccess) { grid = -1; return; }
        if (hipFuncSetAttribute((const void*)mk_fwd, hipFuncAttributeMaxDynamicSharedMemorySize, LDS_BYTES) != hipSuccess) { fprintf(stderr, "kernel_launch: hipFuncSetAttribute failed\n"); grid = -1; return; }
        if (hipOccupancyMaxActiveBlocksPerMultiprocessor(&per_cu, (const void*)mk_fwd, NTHR, LDS_BYTES) != hipSuccess || per_cu < 1) fprintf(stderr, "kernel_launch: occupancy query says %d\n", per_cu);
        (void)hipGetLastError();
        grid = cus;
    }
    if (grid < 0) return;
    (void)hipMemsetAsync((char*)d_ws + WS_CTL, 0, CTL_BYTES, stream);
    Args a{};
    for (int i = 0; i < 25; ++i) a.in[i] = (const float*)d_in[i];
    a.out = (float*)d_out; a.ws = (unsigned char*)d_ws;
#if N_LAUNCH_MODE == 1
    a.ph_lo = 0; a.ph_hi = NPHASE;
    hipLaunchKernelGGL(mk_fwd, dim3(grid), dim3(NTHR), LDS_BYTES, stream, a);
#else
    for (int p = 0; p < NPHASE; ++p) { a.ph_lo = p; a.ph_hi = p + 1; hipLaunchKernelGGL(mk_fwd, dim3(grid), dim3(NTHR), LDS_BYTES, stream, a); }
#endif
}
```

```cpp
#include <hip/hip_runtime.h>
#include <cstdio>
#include <cstdint>

#ifndef N_LAUNCH_MODE
#define N_LAUNCH_MODE 1
#endif
#ifndef NAIVE_GEMM
#define NAIVE_GEMM 0
#endif

#ifndef S5_MFMA
#define S5_MFMA 1
#endif
#ifndef HG_MFMA
#define HG_MFMA 1
#endif
#ifndef S5_MERGE
#define S5_MERGE 1
#endif
#ifndef SKIP_X2
#define SKIP_X2 1
#endif
#ifndef PROBE_DUP
#define PROBE_DUP 0
#endif
#define LAS __attribute__((address_space(3)))
typedef unsigned short bf16;
typedef short bf16x8 __attribute__((ext_vector_type(8)));
typedef float f32x4 __attribute__((ext_vector_type(4)));
typedef float f32x2 __attribute__((ext_vector_type(2)));
typedef float f32x16 __attribute__((ext_vector_type(16)));
typedef unsigned u32x4 __attribute__((ext_vector_type(4)));
typedef unsigned u32x2 __attribute__((ext_vector_type(2)));

constexpr int T_ = 16384, SEQ = 8192, D_ = 2048, NIN = 7168, FF = 1024, NE = 32, CAP = 16384, HSLOT = 40960;
constexpr int NCH = 128;
constexpr float EPS = 1e-6f;
constexpr int NTHR = 512, NWAVE = 8;

constexpr size_t MiB = 1u << 20;
constexpr size_t WS_CTL = 0, CTL_BYTES = 1 * MiB;
constexpr size_t WS_WIN = 1 * MiB;
constexpr size_t WS_WOUT = 29 * MiB;
constexpr size_t WS_WGLU = 37 * MiB;
constexpr size_t WS_WGU = 53 * MiB;
constexpr size_t WS_WD = 565 * MiB;
constexpr size_t WS_HB = 821 * MiB;
constexpr size_t WS_YCAT = 885 * MiB;
constexpr size_t WS_XA = 949 * MiB;
constexpr size_t WS_XB = 1077 * MiB;
constexpr size_t WS_Z = 1205 * MiB;
constexpr size_t WS_KV = 1429 * MiB;
constexpr size_t WS_HID = 1557 * MiB;
constexpr size_t WS_ROWL = 1637 * MiB;
constexpr size_t WS_TOKG = 1641 * MiB;
constexpr size_t WS_TOKR = 1641 * MiB + 262144;
constexpr size_t WS_HGDEC = 1642 * MiB;
constexpr size_t WS_LB = 1643 * MiB;
constexpr size_t WS_S5A = 1643 * MiB + 65536;
constexpr size_t WS_S5B = 1644 * MiB;
constexpr size_t WS_S5L = 1645 * MiB;
constexpr size_t WS_WR = 1661 * MiB;
constexpr size_t WS_S5R = 1662 * MiB;
constexpr size_t WS_S5WST = 1666 * MiB;
constexpr size_t WS_S5WC = 1682 * MiB;
constexpr size_t WS_S5ZERO = 1698 * MiB;
constexpr size_t WS_S5A32 = 1698 * MiB + 524288;
constexpr size_t WS_S5LOC = 1699 * MiB;
constexpr size_t WS_S5HIN = 1731 * MiB;
constexpr size_t WS_SIN = 1747 * MiB;
constexpr size_t WS_ROWL16 = 1811 * MiB;
constexpr size_t WS_END = 1827 * MiB;

constexpr int CW_BAR = 4096;
constexpr int CW_CNT = 8192;

constexpr int LDS_BYTES = 163840;
constexpr int CONV_OFF = 131072;
constexpr int LIST_OFF = 131072;
constexpr int MISC_OFF = 155648;

__device__ __forceinline__ float bf2f(bf16 b) { return __uint_as_float(((unsigned)b) << 16); }
typedef __bf16 bf16x2_t __attribute__((ext_vector_type(2)));
__device__ __forceinline__ unsigned pk2(float lo, float hi) { const f32x2 v = {lo, hi}; return __builtin_bit_cast(unsigned, __builtin_convertvector(v, bf16x2_t)); }
__device__ __forceinline__ bf16 f2bf(float f) { return __builtin_bit_cast(bf16, (__bf16)f); }
__device__ __forceinline__ float sigmoidf_(float x) { return __builtin_amdgcn_rcpf(1.0f + __builtin_amdgcn_exp2f(-1.4426950408889634f * x)); }
__device__ __forceinline__ float siluf_(float x) { return x * __builtin_amdgcn_rcpf(1.0f + __builtin_amdgcn_exp2f(-1.4426950408889634f * x)); }
__device__ __forceinline__ float gelu_tanh(float x) { const float t = x * x; const float p = __builtin_fmaf(t, -0.10294324f, -2.3022082f); return x * __builtin_amdgcn_rcpf(1.0f + __builtin_amdgcn_exp2f(x * p)); }
__device__ __forceinline__ void unpack8(const u32x4 w, float (&o)[8]) {
    o[0] = __uint_as_float(w.x << 16); o[1] = __uint_as_float(w.x & 0xffff0000u); o[2] = __uint_as_float(w.y << 16); o[3] = __uint_as_float(w.y & 0xffff0000u);
    o[4] = __uint_as_float(w.z << 16); o[5] = __uint_as_float(w.z & 0xffff0000u); o[6] = __uint_as_float(w.w << 16); o[7] = __uint_as_float(w.w & 0xffff0000u);
}
__device__ __forceinline__ u32x4 pack8(const float (&v)[8]) { u32x4 w; w.x = pk2(v[0], v[1]); w.y = pk2(v[2], v[3]); w.z = pk2(v[4], v[5]); w.w = pk2(v[6], v[7]); return w; }
__host__ __device__ __forceinline__ int perm32(int rho) { const int n = rho >> 4, i = rho & 15; return 8 * (i >> 2) + 4 * n + (i & 3); }
__device__ __forceinline__ int lane_id() { unsigned z = 0u; asm volatile("" : "+v"(z)); return (int)__builtin_amdgcn_mbcnt_hi(~0u, __builtin_amdgcn_mbcnt_lo(~0u, z)); }
__device__ __forceinline__ float wave_sum(float v) {
#pragma unroll
    for (int o = 32; o >= 1; o >>= 1) v += __shfl_xor(v, o);
    return v;
}

#define XB_TMO      128
#define XB_XCNT(j)  (256  + 64 * (j))
#define XB_XSUB(j)  (1280 + 64 * (j))
#define XB_XGEN(j)  (2304 + 64 * (j))
#define XB_TOP      3328
#define XB_TOPGEN   3392
#define XCD_BAR_WORDS 3456
#define XB_SPIN_CAP (1u << 24)
__device__ __forceinline__ unsigned xb_ld(unsigned* p)              { return __hip_atomic_load(p, __ATOMIC_RELAXED, __HIP_MEMORY_SCOPE_AGENT); }
__device__ __forceinline__ unsigned xb_add(unsigned* p, unsigned v) { return __hip_atomic_fetch_add(p, v, __ATOMIC_RELAXED, __HIP_MEMORY_SCOPE_AGENT); }
__device__ __forceinline__ unsigned xb_xcc_id() { return (unsigned)__builtin_amdgcn_s_getreg((3 << 11) | 20) & 0xFu; }
#define XB_SPIN(cond, bar) do { unsigned _sp = 0; while (cond) { __builtin_amdgcn_s_sleep(1); \
    if ((++_sp & 255u) == 0u) { if (xb_ld(&(bar)[XB_TMO])) break; if (_sp > XB_SPIN_CAP) { atomicAdd(&(bar)[XB_TMO], 1u); break; } } } } while (0)
struct XcdBarrier { unsigned* bar; unsigned x; volatile LAS unsigned* st; };
__device__ __forceinline__ XcdBarrier xcd_barrier_post(unsigned* bar, volatile LAS unsigned* st, bool t0) {
    XcdBarrier b; b.bar = bar; b.x = xb_xcc_id(); b.st = st;
    if (t0) (void)xb_add(&bar[XB_XCNT(b.x)], 1u);
    return b;
}
__device__ __forceinline__ void xcd_barrier_complete(unsigned* bar, unsigned x, unsigned& nloc, unsigned& nx) {
    const unsigned G = gridDim.x * gridDim.y * gridDim.z;
    unsigned sum, cnt, mine, sp = 0u;
    for (;;) {
        sum = 0u; cnt = 0u; mine = 0u;
#pragma unroll
        for (unsigned j = 0; j < 16; ++j) { const unsigned c = xb_ld(&bar[XB_XCNT(j)]); sum += c; cnt += (c > 0u) ? 1u : 0u; mine = (j == x) ? c : mine; }
        if (sum == G) break;
        __builtin_amdgcn_s_sleep(1);
        if ((++sp & 255u) == 0u) { if (xb_ld(&bar[XB_TMO])) break; if (sp > XB_SPIN_CAP) { atomicAdd(&bar[XB_TMO], 1u); break; } }
    }
    nloc = mine > 0u ? mine : 1u; nx = cnt > 0u ? cnt : 1u;
}
__device__ __forceinline__ void xcd_barrier(const XcdBarrier& b, bool t0) {
    asm volatile("s_waitcnt vmcnt(0)" ::: "memory");
    __syncthreads();
    if (t0) {
        unsigned* bar = b.bar;
        __builtin_amdgcn_s_waitcnt(0);
        unsigned nloc = b.st[0], nx = b.st[1];
        if (nloc == 0u) { xcd_barrier_complete(bar, b.x, nloc, nx); b.st[0] = nloc; b.st[1] = nx; }
        const unsigned old = xb_add(&bar[XB_XSUB(b.x)], 1u);
        const unsigned gen = old / nloc;
        if (old + 1u == (gen + 1u) * nloc) {
            __builtin_amdgcn_fence(__ATOMIC_RELEASE, "agent");
            asm volatile("s_waitcnt vmcnt(0)" ::: "memory");
            const unsigned og = xb_add(&bar[XB_TOP], 1u);
            const unsigned tg = og / nx;
            if (og + 1u == (tg + 1u) * nx) xb_add(&bar[XB_TOPGEN], 1u);
            else XB_SPIN(xb_ld(&bar[XB_TOPGEN]) == tg, bar);
            __builtin_amdgcn_fence(__ATOMIC_ACQUIRE, "agent");
            xb_add(&bar[XB_XGEN(b.x)], 1u);
            asm volatile("s_waitcnt vmcnt(0)" ::: "memory");
        } else {
            XB_SPIN(xb_ld(&bar[XB_XGEN(b.x)]) == gen, bar);
            __builtin_amdgcn_fence(__ATOMIC_ACQUIRE, "agent");
            asm volatile("s_waitcnt vmcnt(0)" ::: "memory");
        }
    }
    __syncthreads();
}

namespace pg {
constexpr int BM = 256, BK = 64, HALF = 128, HTB = HALF * BK * 2, STAGE_BYTES = 8 * HTB, NXCD = 8, WGM = 8;
__host__ __device__ __forceinline__ int lds_byte(int r, int c) { const int st = (r >> 4) * 2 + (c >> 5), rr = r & 15, cc = c & 31, ob = rr * 64 + cc * 2; return st * 1024 + (ob ^ (((ob >> 9) & 1) << 5)); }
__host__ __device__ __forceinline__ void stage_rc(int b, int& R, int& C) { const int st = b / 1024, sb = b % 1024, swz = sb ^ (((sb >> 9) & 1) << 5); R = (st >> 1) * 16 + swz / 64; C = (st & 1) * 32 + (swz % 64) / 2; }

struct Unit { unsigned oA, oB, oA2, oB2; int hB, pm, pn, e, nvalid, lbuf; };

struct DenseSched {
    static constexpr bool GATHER = false, SEG2 = false, LIST = false, HALFN = false; static constexpr int KSA = 128;
    const char* A; const char* B; const char* A2; const char* B2; int nt1, nt2, nM, nN, nwg, G, c, i0, i1;
    int pitchA, pitchB, hA, hA2, hB2;
    __device__ __forceinline__ void init(const bf16* A_, const bf16* B_, int M, int N, int K_, int G_, int c_) { A = (const char*)A_; B = (const char*)B_; A2 = A; B2 = B; nt1 = K_ / BK; nt2 = 0; nM = M / BM; nN = N / BM; nwg = nM * nN; G = G_; c = c_; pitchA = K_ * 2; pitchB = K_ * 2; hA = 128 * pitchA; hA2 = 0; hB2 = 0; i0 = 0; i1 = 1 << 20; }
    __device__ __forceinline__ unsigned voffA(int R, int C) const { return (unsigned)(R * pitchA + C * 2); }
    __device__ __forceinline__ unsigned voffB(int R, int C) const { return (unsigned)(R * pitchB + C * 2); }
    __device__ __forceinline__ unsigned voffA2(int, int) const { return 0u; }
    __device__ __forceinline__ unsigned voffB2(int, int) const { return 0u; }
    __device__ __forceinline__ bool next(int i, Unit& u) const {
        if (i0 + i >= i1) return false;
        const long L = (long)(i0 + i) * G + c; if (L >= nwg) return false;
        int wgid = (int)L; { const int q = nwg / NXCD, r = nwg % NXCD, xcd = wgid % NXCD, off = wgid / NXCD; wgid = (xcd < r ? xcd * (q + 1) : r * (q + 1) + (xcd - r) * q) + off; }
        const int nig = WGM * nN, gid = wgid / nig, fm = gid * WGM, gsz = (nM - fm) < WGM ? (nM - fm) : WGM;
        u.pm = fm + ((wgid % nig) % gsz); u.pn = (wgid % nig) / gsz; u.e = 0; u.nvalid = 256;
        u.oA = (unsigned)u.pm * 256u * (unsigned)pitchA; u.oB = (unsigned)u.pn * 256u * (unsigned)pitchB; u.oA2 = 0u; u.oB2 = 0u; u.hB = 128 * pitchB; return true;
    }
    __device__ __forceinline__ unsigned grow(const Unit&, int) const { return 0u; }
    __device__ __forceinline__ void list_issue(const Unit&, LAS unsigned char*, int, int, int) const {}
};

template <bool GATHER_> struct MoeSched {
    static constexpr bool GATHER = GATHER_, SEG2 = false, LIST = true, HALFN = false; static constexpr int KSA = 128;
    const u32x4* rowl16;
    const char* A; const char* B; const char* A2; const char* B2; int nt1, nt2, nN, nwg, G, c, i0, i1; int pitchA, pitchB, hA, hA2, hB2; unsigned expStrideB;
    const LAS int* tile0; const LAS int* cnt; const LAS unsigned char* tileExp; const int* rowl;
    __device__ __forceinline__ unsigned voffA(int R, int C) const { return (unsigned)(R * pitchA + C * 2); }
    __device__ __forceinline__ unsigned voffB(int R, int C) const { return (unsigned)(R * pitchB + C * 2); }
    __device__ __forceinline__ unsigned voffA2(int, int) const { return 0u; }
    __device__ __forceinline__ unsigned voffB2(int, int) const { return 0u; }
    __device__ __forceinline__ bool next(int i, Unit& u) const {
        if (i0 + i >= i1) return false;
        const long L = (long)(i0 + i) * G + c; if (L >= nwg) return false;
        int wgid = (int)L; { const int q = nwg / NXCD, xcd = wgid % NXCD, off = wgid / NXCD; wgid = xcd * q + off; }
        const int rt = wgid / nN, nt = wgid % nN;
        const int e = __builtin_amdgcn_readfirstlane((int)tileExp[rt]);
        const int lt = rt - __builtin_amdgcn_readfirstlane(tile0[e]);
        const int ce = __builtin_amdgcn_readfirstlane(cnt[e]);
        u.pm = rt; u.pn = nt; u.e = e; u.nvalid = ce - lt * 256;
        u.oA = GATHER ? 0u : (unsigned)rt * 256u * (unsigned)pitchA;
        u.oB = (unsigned)e * expStrideB + (unsigned)nt * 256u * (unsigned)pitchB; u.oA2 = 0u; u.oB2 = 0u; u.hB = 128 * pitchB; return true;
    }
    __device__ __forceinline__ void list_issue(const Unit& u, LAS unsigned char* lds, int buf, int wid, int lane) const {
        if (wid < 4) { const u32x4* src = rowl16 + (size_t)u.e * CAP + (size_t)(u.pm - tile0[u.e]) * 256 + wid * 64 + lane;
            __builtin_amdgcn_global_load_lds((const unsigned*)src, (LAS unsigned*)(lds + LIST_OFF + buf * 4096 + wid * 1024), 16, 0, 0); }
    }
    __device__ __forceinline__ unsigned grow_l(const Unit& u, const LAS unsigned char* lds, int buf, int r) const {
        const int v = *(const LAS int*)(lds + LIST_OFF + buf * 4096 + r * 16);
        const int tok = r < u.nvalid ? (v >> 1) : 0;
        return (unsigned)tok * (unsigned)pitchA;
    }
};

struct NoHook { __device__ __forceinline__ void operator()(int) const {} };
template <class Epi, class Sched, class Hook = NoHook>
__device__ __forceinline__ void gemm_phase_w(LAS unsigned char* lds, const Sched& S, const Epi& E, int wave_id, const Hook& HK = Hook()) {
    constexpr bool GATHER = Sched::GATHER, SEG2 = Sched::SEG2, LIST = Sched::LIST, HALFN = Sched::HALFN;
    const int lane = lane_id(), wid = wave_id, tid = wid * 64 + lane, wr = wid >> 2, wc = wid & 3, fr = lane & 15, fq = lane >> 4;
    const int nt1 = S.nt1, nt = S.nt1 + S.nt2;
    int R0, C0, R1, C1; stage_rc(tid * 16, R0, C0); stage_rc(tid * 16 + 8192, R1, C1);
    const unsigned voffA_0 = S.voffA(R0, C0), voffA_1 = S.voffA(R1, C1), voffB_0 = S.voffB(R0, C0), voffB_1 = S.voffB(R1, C1);
    const unsigned voffA2_0 = SEG2 ? S.voffA2(R0, C0) : 0u, voffA2_1 = SEG2 ? S.voffA2(R1, C1) : 0u, voffB2_0 = SEG2 ? S.voffB2(R0, C0) : 0u, voffB2_1 = SEG2 ? S.voffB2(R1, C1) : 0u;
    const int hA = S.hA, hA2 = S.hA2, hB2 = S.hB2;
    const unsigned ldsw = (unsigned)wid * 1024u;
    const int aoff = lds_byte(wr * 64 + fr, fq * 8), boff = lds_byte(wc * 32 + fr, fq * 8);
    unsigned gcur_00 = 0u, gcur_01 = 0u, gcur_10 = 0u, gcur_11 = 0u, gnxt_00 = 0u, gnxt_01 = 0u, gnxt_10 = 0u, gnxt_11 = 0u;
#define PG_SA(b, h) (((b) * 2 + (h)) * HTB)
#define PG_SB(b, h) ((4 + (b) * 2 + (h)) * HTB)
#define PG_GLDS(gp, bufoff, _i) __builtin_amdgcn_global_load_lds((const unsigned*)(gp), (LAS unsigned*)(lds + (bufoff) + ldsw + (_i) * 8192), 16, 0, 0)
#define PG_STAGE_B(bufoff, oB_, oB2_, hB_, kt, h, S2) do { \
        const char* _b = (S2) ? S.B2 + (long)(int)((oB2_) + (unsigned)(((kt) - nt1) * 128 + (h) * hB2)) : S.B + (long)(int)((oB_) + (unsigned)((kt) * 128 + (h) * (hB_))); \
        PG_GLDS(_b + ((S2) ? voffB2_0 : voffB_0), bufoff, 0); PG_GLDS(_b + ((S2) ? voffB2_1 : voffB_1), bufoff, 1); } while (0)
#define PG_STAGE_A(bufoff, oA_, oA2_, kt, h, GV, S2) do { \
        const char* _b = (S2) ? S.A2 + (size_t)((oA2_) + (unsigned)(((kt) - nt1) * 128 + (h) * hA2)) : S.A + (size_t)((oA_) + (unsigned)((kt) * S.KSA + (GATHER ? 0 : (h) * hA))); \
        if constexpr (GATHER) { PG_GLDS(_b + (GV##_##h##0), bufoff, 0); PG_GLDS(_b + (GV##_##h##1), bufoff, 1); } \
        else { PG_GLDS(_b + ((S2) ? voffA2_0 : voffA_0), bufoff, 0); PG_GLDS(_b + ((S2) ? voffA2_1 : voffA_1), bufoff, 1); } } while (0)
#define PG_SB_CUR(bufoff, kt, h, S2) PG_STAGE_B(bufoff, cur.oB, cur.oB2, cur.hB, kt, h, S2)
#define PG_SA_CUR(bufoff, kt, h, S2) PG_STAGE_A(bufoff, cur.oA, cur.oA2, kt, h, gcur, S2)
#define PG_SB_SEL(bufoff, kt, h, S2) PG_STAGE_B(bufoff, s_oB, s_oB2, s_hB, kt, h, S2)
#define PG_SA_SEL(bufoff, kt, h, S2) PG_STAGE_A(bufoff, s_oA, s_oA2, kt, h, gsel, S2)
#define PG_LDA(dst, b, h) do { _Pragma("unroll") for (int m = 0; m < 4; ++m) _Pragma("unroll") for (int k = 0; k < 2; ++k) dst[m][k] = *(const LAS bf16x8*)(lds + PG_SA(b, h) + aoff + m * 2048 + k * 1024); } while (0)
#define PG_LDB(dst, b, h) do { _Pragma("unroll") for (int n = 0; n < 2; ++n) _Pragma("unroll") for (int k = 0; k < 2; ++k) dst[n][k] = *(const LAS bf16x8*)(lds + PG_SB(b, h) + boff + n * 2048 + k * 1024); } while (0)
#define PG_MMA(ai, bj, At, Bt) do { __builtin_amdgcn_s_setprio(1); _Pragma("unroll") for (int m = 0; m < 4; ++m) _Pragma("unroll") for (int n = 0; n < 2; ++n) _Pragma("unroll") for (int k = 0; k < 2; ++k) \
        acc[ai][bj][m][n] = __builtin_amdgcn_mfma_f32_16x16x32_bf16(Bt[n][k], At[m][k], acc[ai][bj][m][n], 0, 0, 0); __builtin_amdgcn_s_setprio(0); } while (0)
#define PG_WAIT_V(n) asm volatile("s_waitcnt vmcnt(" #n ")" ::: "memory")
#define PG_WAIT_L(n) asm volatile("s_waitcnt lgkmcnt(" #n ")" ::: "memory")
#define PG_BAR __builtin_amdgcn_s_barrier()
#define PG_SCHED __builtin_amdgcn_sched_barrier(0)
    Unit cur, nxt; int ui = 0;
    if (!S.next(0, cur)) return;
    f32x4 acc[2][2][4][2];
#pragma unroll
    for (int a = 0; a < 2; ++a)
#pragma unroll
        for (int b = 0; b < 2; ++b)
#pragma unroll
            for (int m = 0; m < 4; ++m)
#pragma unroll
                for (int n = 0; n < 2; ++n) acc[a][b][m][n] = (f32x4){0.f, 0.f, 0.f, 0.f};
    bf16x8 At[4][2], B0[2][2], B1[2][2];
    cur.lbuf = 0;
    if constexpr (LIST) {
        S.list_issue(cur, lds, 0, wid, lane);
        asm volatile("s_waitcnt vmcnt(0)" ::: "memory"); __builtin_amdgcn_s_barrier(); asm volatile("" ::: "memory");
    }
    if constexpr (GATHER) {
        gcur_00 = S.grow_l(cur, lds, 0, R0) + (unsigned)(C0 * 2); gcur_01 = S.grow_l(cur, lds, 0, R1) + (unsigned)(C1 * 2); gcur_10 = S.grow_l(cur, lds, 0, 128 + R0) + (unsigned)(C0 * 2); gcur_11 = S.grow_l(cur, lds, 0, 128 + R1) + (unsigned)(C1 * 2);
    }
    PG_SB_CUR(PG_SB(0, 0), 0, 0, false); PG_SB_CUR(PG_SB(0, 1), 0, 1, false); PG_SA_CUR(PG_SA(0, 0), 0, 0, false); PG_SA_CUR(PG_SA(0, 1), 0, 1, false);
    if (wr == 1) PG_BAR;
    PG_WAIT_V(2); PG_BAR;
    PG_SB_CUR(PG_SB(1, 0), 1, 0, false); PG_SA_CUR(PG_SA(1, 0), 1, 0, false); PG_SB_CUR(PG_SB(1, 1), 1, 1, false);
    PG_WAIT_V(6); PG_BAR;
    for (;;) {
        const bool has_next = S.next(ui + 1, nxt);
        if (!has_next) nxt = cur;
        const int nbuf = (ui + 1) % 3; nxt.lbuf = has_next ? nbuf : cur.lbuf;
        if constexpr (LIST) { if (has_next) S.list_issue(nxt, lds, nbuf, wid, lane); }
#define PG_TRIP(T, A1S2, K23S2, LAST) do { const int t = (T); const bool last = (t == nt - 2); (void)(LAST); \
            const unsigned s_oA = last ? nxt.oA : cur.oA, s_oB = last ? nxt.oB : cur.oB, s_oA2 = last ? nxt.oA2 : cur.oA2, s_oB2 = last ? nxt.oB2 : cur.oB2; const int s_hB = last ? nxt.hB : cur.hB; \
            const int k2 = last ? 0 : t + 2, k3 = k2 + 1; \
            const unsigned gsel_00 = last ? gnxt_00 : gcur_00, gsel_01 = last ? gnxt_01 : gcur_01, gsel_10 = last ? gnxt_10 : gcur_10, gsel_11 = last ? gnxt_11 : gcur_11; \
            (void)s_oA2; (void)s_oB2; (void)gsel_00; (void)gsel_01; (void)gsel_10; (void)gsel_11; \
              \
            PG_LDB(B0, 0, 0); if constexpr (!HALFN) PG_LDB(B1, 0, 1); PG_SCHED; PG_LDA(At, 0, 0); PG_SA_CUR(PG_SA(1, 1), t + 1, 1, A1S2); \
            PG_WAIT_V(8); PG_WAIT_L(0); PG_BAR; PG_MMA(0, 0, At, B0); if constexpr (!HALFN) PG_MMA(0, 1, At, B1); PG_BAR; PG_SCHED; \
              \
            PG_LDA(At, 0, 1); PG_SB_SEL(PG_SB(0, 0), k2, 0, K23S2); PG_SB_SEL(PG_SB(0, 1), k2, 1, K23S2); PG_SA_SEL(PG_SA(0, 0), k2, 0, K23S2); \
            PG_WAIT_V(8); PG_WAIT_L(0); PG_BAR; PG_MMA(1, 0, At, B0); if constexpr (!HALFN) PG_MMA(1, 1, At, B1); PG_BAR; PG_SCHED; \
              \
            PG_LDB(B0, 1, 0); if constexpr (!HALFN) PG_LDB(B1, 1, 1); PG_SCHED; PG_LDA(At, 1, 0); PG_SA_SEL(PG_SA(0, 1), k2, 1, K23S2); \
            PG_WAIT_V(8); PG_WAIT_L(0); PG_BAR; PG_MMA(0, 0, At, B0); if constexpr (!HALFN) PG_MMA(0, 1, At, B1); PG_BAR; PG_SCHED; \
              \
            PG_LDA(At, 1, 1); PG_SB_SEL(PG_SB(1, 0), k3, 0, K23S2); PG_SB_SEL(PG_SB(1, 1), k3, 1, K23S2); PG_SA_SEL(PG_SA(1, 0), k3, 0, K23S2); \
            PG_WAIT_V(8); PG_WAIT_L(0); PG_BAR; PG_MMA(1, 0, At, B0); if constexpr (!HALFN) PG_MMA(1, 1, At, B1); PG_BAR; PG_SCHED; } while (0)
        if constexpr (!SEG2) {
            for (int tt = 0; tt < nt; tt += 2) {
                if constexpr (GATHER) { if (tt == nt - 2) {
                    if (has_next) { gnxt_00 = S.grow_l(nxt, lds, nbuf, R0) + (unsigned)(C0 * 2); gnxt_01 = S.grow_l(nxt, lds, nbuf, R1) + (unsigned)(C1 * 2); gnxt_10 = S.grow_l(nxt, lds, nbuf, 128 + R0) + (unsigned)(C0 * 2); gnxt_11 = S.grow_l(nxt, lds, nbuf, 128 + R1) + (unsigned)(C1 * 2); }
                    else { gnxt_00 = gcur_00; gnxt_01 = gcur_01; gnxt_10 = gcur_10; gnxt_11 = gcur_11; } } }
                PG_TRIP(tt, false, false, false);
            }
        } else {
            for (int tt = 0; tt < nt - 4; tt += 2) PG_TRIP(tt, false, false, false);
            PG_TRIP(nt - 4, false, true, false);
            PG_TRIP(nt - 2, true, false, true);
        }
#undef PG_TRIP
        if (wr == 0) PG_BAR;
        E(acc, cur, wr, wc, fr, fq);
        HK(ui);
        if (!has_next) break;
#pragma unroll
        for (int a = 0; a < 2; ++a)
#pragma unroll
            for (int b = 0; b < 2; ++b)
#pragma unroll
                for (int m = 0; m < 4; ++m)
#pragma unroll
                    for (int n = 0; n < 2; ++n) acc[a][b][m][n] = (f32x4){0.f, 0.f, 0.f, 0.f};
        cur = nxt; ++ui;
        if constexpr (GATHER) { gcur_00 = gnxt_00; gcur_01 = gnxt_01; gcur_10 = gnxt_10; gcur_11 = gnxt_11; }
        if (wr == 1) PG_BAR;
    }
    PG_WAIT_V(0);
    PG_BAR;
#undef PG_SA
#undef PG_SB
#undef PG_GLDS
#undef PG_STAGE_A
#undef PG_STAGE_B
#undef PG_SB_CUR
#undef PG_SA_CUR
#undef PG_SB_SEL
#undef PG_SA_SEL
#undef PG_LDA
#undef PG_LDB
#undef PG_MMA
#undef PG_WAIT_V
#undef PG_WAIT_L
#undef PG_BAR
#undef PG_SCHED
}
}


struct Args { const float* in[25]; float* out; unsigned char* ws; int ph_lo, ph_hi; };

struct Ctx {
    const float* in[25]; float* out; unsigned char* ws; LAS unsigned char* lds;
    int tid, lane, wave, G, bid;
};
#define WSP(T, off) ((T*)(c.ws + (off)))

struct ConvJob { const float* src; bf16* dst; int ld, k0, col0, dK, drow0; };
__device__ __forceinline__ ConvJob conv_job(const Ctx& c, int t);
__device__ __forceinline__ void conv_load(const ConvJob& j, f32x4 (&v)[8]) {
    const int tid = threadIdx.x;
#pragma unroll
    for (int it = 0; it < 8; ++it) { const int kk = it * 16 + (tid >> 5), c4 = tid & 31; v[it] = __builtin_nontemporal_load((const f32x4*)(j.src + (size_t)(j.k0 + kk) * j.ld + j.col0 + c4 * 4)); }
}
__device__ __forceinline__ void conv_to_lds(LAS float* L, const f32x4 (&v)[8]) {
    const int tid = threadIdx.x;
#pragma unroll
    for (int it = 0; it < 8; ++it) { const int kk = it * 16 + (tid >> 5), c4 = tid & 31; LAS float* p = L + kk * 129 + c4 * 4; p[0] = v[it][0]; p[1] = v[it][1]; p[2] = v[it][2]; p[3] = v[it][3]; }
}
__device__ __forceinline__ void conv_store(const LAS float* L, const ConvJob& j) {
    const int tid = threadIdx.x;
    const int rr = tid >> 2, kq = tid & 3; const int sc = (rr & ~31) + perm32(rr & 31);
#pragma unroll
    for (int j8 = 0; j8 < 4; ++j8) {
        float f[8];
#pragma unroll
        for (int q = 0; q < 8; ++q) f[q] = L[(kq * 32 + j8 * 8 + q) * 129 + sc];
        *(u32x4*)(j.dst + (size_t)(j.drow0 + rr) * j.dK + j.k0 + kq * 32 + j8 * 8) = pack8(f);
    }
}

__device__ __forceinline__ void row_load32(const float* __restrict__ p, int lane, float (&v)[32]) {
#pragma unroll
    for (int cch = 0; cch < 4; ++cch) { const f32x4 a = *(const f32x4*)(p + cch * 512 + lane * 8), b = *(const f32x4*)(p + cch * 512 + lane * 8 + 4);
        v[cch * 8 + 0] = a[0]; v[cch * 8 + 1] = a[1]; v[cch * 8 + 2] = a[2]; v[cch * 8 + 3] = a[3]; v[cch * 8 + 4] = b[0]; v[cch * 8 + 5] = b[1]; v[cch * 8 + 6] = b[2]; v[cch * 8 + 7] = b[3]; }
}
__device__ __forceinline__ void row_add_bf16(const bf16* __restrict__ p, int lane, float (&v)[32]) {
#pragma unroll
    for (int cch = 0; cch < 4; ++cch) { const u32x4 w = *(const u32x4*)(p + cch * 512 + lane * 8); float f[8]; unpack8(w, f);
#pragma unroll
        for (int j = 0; j < 8; ++j) v[cch * 8 + j] += f[j]; }
}
__device__ __forceinline__ float row_rstd(const float (&v)[32]) {
    float ss = 0.f;
#pragma unroll
    for (int j = 0; j < 32; ++j) ss += v[j] * v[j];
    ss = wave_sum(ss);
    return rsqrtf(ss * (1.0f / 2048.0f) + EPS);
}
__device__ __forceinline__ void row_store_norm_bf16(bf16* __restrict__ o, const float* __restrict__ g, int lane, const float (&v)[32], float r) {
#pragma unroll
    for (int cch = 0; cch < 4; ++cch) { const f32x4 ga = *(const f32x4*)(g + cch * 512 + lane * 8), gb = *(const f32x4*)(g + cch * 512 + lane * 8 + 4); float f[8];
#pragma unroll
        for (int j = 0; j < 4; ++j) { f[j] = v[cch * 8 + j] * r * ga[j]; f[4 + j] = v[cch * 8 + 4 + j] * r * gb[j]; }
        *(u32x4*)(o + cch * 512 + lane * 8) = pack8(f); }
}

constexpr int CV_IN = 16 * 56, CV_OUT = 16 * 16, CV_GLU = 16 * 32, CV_GU = 2 * 32 * 2 * 128, CV_DN = 2 * 32 * 128;
constexpr int CONV_TOT = CV_IN + CV_OUT + CV_GLU + CV_GU + CV_DN;
#ifndef CONV_IN_GEMM
#define CONV_IN_GEMM 1
#endif
constexpr int CONV_PRO = CONV_IN_GEMM ? CV_IN + CV_OUT : CONV_TOT;
constexpr int CVO_GLU = CV_IN + CV_OUT, CVO_GU = CVO_GLU + CV_GLU, CVO_DN = CVO_GU + CV_GU;
constexpr int CV_GU1_SPLIT = 13;
__device__ __forceinline__ ConvJob conv_job(const Ctx& c, int t) {
    ConvJob j; int i = t;
    if (i < CV_IN) { const int kb = i % 16, cb = i / 16; j.src = c.in[4]; j.ld = NIN; j.k0 = kb * 128; j.col0 = cb * 128; j.dst = WSP(bf16, WS_WIN); j.dK = 2048; j.drow0 = cb * 128; return j; }
    i -= CV_IN;
    if (i < CV_OUT) { const int kb = i % 16, cb = i / 16; j.src = c.in[8]; j.ld = 2048; j.k0 = kb * 128; j.col0 = cb * 128; j.dst = WSP(bf16, WS_WOUT); j.dK = 2048; j.drow0 = cb * 128; return j; }
    i -= CV_OUT;
    if (i < CV_GLU) { const int kb = i % 16, cb = i / 16; j.src = c.in[17]; j.ld = 4096; j.k0 = kb * 128; j.col0 = cb * 128; j.dst = WSP(bf16, WS_WGLU); j.dK = 2048; j.drow0 = cb < 16 ? cb * 256 : (cb - 16) * 256 + 128; return j; }
    i -= CV_GLU;
    if (i < CV_GU) { const int kb = i % 16, cb = (i / 16) % 8, gu = (i / 128) % 2, le = i / 256;
        j.src = (gu ? c.in[23] : c.in[22]) + (size_t)le * 2048 * 1024; j.ld = 1024; j.k0 = kb * 128; j.col0 = cb * 128; j.dst = WSP(bf16, WS_WGU) + (size_t)le * 2048 * 2048; j.dK = 2048; j.drow0 = cb * 256 + gu * 128; return j; }
    i -= CV_GU;
    { const int kb = i % 8, cb = (i / 8) % 16, le = i / 128;
        j.src = c.in[24] + (size_t)le * 1024 * 2048; j.ld = 2048; j.k0 = kb * 128; j.col0 = cb * 128; j.dst = WSP(bf16, WS_WD) + (size_t)le * 2048 * 1024; j.dK = 1024; j.drow0 = cb * 128; return j; }
}

__device__ __forceinline__ int cv_fz(int k) { return (k >> 3) & 7; }
__device__ __forceinline__ void conv_slice(const Ctx& c, int lo0, int n0, int lo1, int n1, int lo2, int n2) {
    const int tot = n0 + n1 + n2, G = c.G;
    const int mine = (tot - c.bid + G - 1) / G;
    if (mine <= 0) return;
    const int tid = c.tid, w = c.wave, lrow = c.lane >> 5, gp = c.lane & 31;
    const int rr0 = tid >> 3, kq = tid & 7;
#define CV_JOB(i) conv_job(c, [&](int ii) { const int v = c.bid + (ii < mine ? ii : mine - 1) * G; return v < n0 ? lo0 + v : (v < n0 + n1 ? lo1 + (v - n0) : lo2 + (v - n0 - n1)); }(i))
#define CV_ISSUE(i, buf) do { const ConvJob _j = CV_JOB(i); _Pragma("unroll") for (int _q = 0; _q < 8; ++_q) { const int _row = 2 * (_q * 8 + w) + lrow; const int _g = gp ^ cv_fz(_row); \
        __builtin_amdgcn_global_load_lds((const unsigned*)(_j.src + (size_t)(_j.k0 + _row) * _j.ld + _j.col0 + _g * 4), (LAS unsigned*)(c.lds + (buf) * 65536 + (_q * 8 + w) * 1024), 16, 0, 2); } } while (0)
    CV_ISSUE(0, 0); CV_ISSUE(1, 1);
    for (int i = 0; i < mine; ++i) {
        if (i == 0) asm volatile("s_waitcnt vmcnt(8)" ::: "memory"); else if (i == 1) asm volatile("s_waitcnt vmcnt(12)" ::: "memory"); else asm volatile("s_waitcnt vmcnt(16)" ::: "memory");
        __builtin_amdgcn_s_barrier();
        asm volatile("" ::: "memory");
        const LAS float* B = (const LAS float*)(c.lds + (i & 1) * 65536);
        u32x4 o[4];
#pragma unroll
        for (int p = 0; p < 2; ++p) { const int rr = rr0 + 64 * p, sc = (rr & ~31) + perm32(rr & 31), scg = sc >> 2, scl = sc & 3;
#pragma unroll
            for (int h = 0; h < 2; ++h) { float f[8];
#pragma unroll
                for (int q = 0; q < 8; ++q) { const int k = 64 * h + kq * 8 + q; f[q] = B[k * 128 + ((scg ^ kq) << 2) + scl]; }
                o[p * 2 + h] = pack8(f); } }
        asm volatile("s_waitcnt lgkmcnt(0)" ::: "memory");
        __builtin_amdgcn_s_barrier();
        asm volatile("" ::: "memory");
        if ((i & 1) == 0) CV_ISSUE(i + 2, 0); else CV_ISSUE(i + 2, 1);
        asm volatile("" ::: "memory");
        { const ConvJob j = CV_JOB(i);
#pragma unroll
          for (int p = 0; p < 2; ++p) { bf16* d = j.dst + (size_t)(j.drow0 + rr0 + 64 * p) * j.dK + j.k0 + kq * 8;
#pragma unroll
              for (int h = 0; h < 2; ++h) *(u32x4*)(d + 64 * h) = o[p * 2 + h]; } }
        asm volatile("" ::: "memory");
    }
    asm volatile("s_waitcnt vmcnt(0)" ::: "memory");
    __builtin_amdgcn_s_barrier();
#undef CV_ISSUE
#undef CV_JOB
}

__device__ __forceinline__ void conv_slice_moe(const Ctx& c, int lo, int n, int nwg, int per_light) {
    const int extra = nwg % c.G, n_light = extra ? c.G - extra : 0;
    int nb = n_light * per_light; if (nb > n) nb = n;
    if (n_light > 0 && c.bid >= extra && nb > 0) { Ctx c2 = c; c2.bid = c.bid - extra; c2.G = n_light; conv_slice(c2, lo, nb, 0, 0, 0, 0); }
    conv_slice(c, lo + nb, n - nb, 0, 0, 0, 0);
}

__device__ __forceinline__ void s5_precompute_group(const Ctx& c, int g) {
    LAS float* AR = (LAS float*)c.lds; LAS float* AI = AR + 64; LAS float* BBR = AI + 64; LAS float* BBI = BBR + 1024;
    LAS float* PR = BBI + 1024; LAS float* PI = PR + 33 * 64; LAS float* CRE = PI + 33 * 64; LAS float* CIM = CRE + 1024;
    const int tid = c.tid;
    if (tid < 64) {
        const int p = tid, i = g * 64 + p;
        const float dt = expf(c.in[11][g]), lr = c.in[9][i], li = c.in[10][i];
        const float mag = expf(lr * dt), ar = mag * cosf(li * dt), ai = mag * sinf(li * dt);
        const float den = lr * lr + li * li;
        const float cr = ((ar - 1.0f) * lr + ai * li) / den, ci = (ai * lr - (ar - 1.0f) * li) / den;
        AR[p] = ar; AI[p] = ai;
        for (int ch = 0; ch < 16; ++ch) { const float br = c.in[12][(size_t)i * 16 + ch], bi = c.in[13][(size_t)i * 16 + ch]; BBR[p * 16 + ch] = cr * br - ci * bi; BBI[p * 16 + ch] = cr * bi + ci * br; }
        float pr = 1.0f, pi = 0.0f; PR[p] = pr; PI[p] = pi;
        for (int tau = 1; tau <= 32; ++tau) { const float nr = pr * ar - pi * ai, ni = pr * ai + pi * ar; pr = nr; pi = ni; PR[tau * 64 + p] = pr; PI[tau * 64 + p] = pi; }
        float* A32 = WSP(float, WS_S5A32) + (size_t)i * 2; A32[0] = pr; A32[1] = pi;
        *(u32x4*)(WSP(bf16, WS_S5ZERO) + (size_t)g * 512 + p * 8) = (u32x4){0u, 0u, 0u, 0u};
    }
    for (int i = tid; i < 1024; i += NTHR) { CRE[i] = c.in[14][(size_t)g * 1024 + i]; CIM[i] = c.in[15][(size_t)g * 1024 + i]; }
    __syncthreads();
    bf16* Rg = WSP(bf16, WS_S5R) + (size_t)g * 16 * 1024;
    for (int idx = tid; idx < 16 * 32 * 16; idx += NTHR) {
        const int co = idx >> 9, tau = (idx >> 4) & 31, ci = idx & 15; float acc = 0.f;
        for (int p = 0; p < 64; ++p) { const float pr = PR[tau * 64 + p], pi = PI[tau * 64 + p], br = BBR[p * 16 + ci], bi = BBI[p * 16 + ci];
            const float wr = pr * br - pi * bi, wi = pr * bi + pi * br; acc += CRE[co * 64 + p] * wr - CIM[co * 64 + p] * wi; }
        Rg[co * 1024 + (31 - tau) * 16 + ci] = f2bf(acc);
    }
    for (int idx = tid; idx < 16 * 64; idx += NTHR) { const int co = idx >> 6, q = idx & 63; *(u32x4*)(Rg + co * 1024 + 512 + q * 8) = (u32x4){0u, 0u, 0u, 0u}; }
    bf16* Wst = WSP(bf16, WS_S5WST) + (size_t)g * 128 * 512;
    for (int idx = tid; idx < 128 * 64; idx += NTHR) {
        const int r = idx >> 6, k8 = idx & 63, sI = k8 >> 1, ci0 = (k8 & 1) * 8; const int j = (r & ~31) + perm32(r & 31), ri = j >> 6, p = j & 63, tau = 31 - sI;
        const float pr = PR[tau * 64 + p], pi = PI[tau * 64 + p]; float f[8];
#pragma unroll
        for (int q = 0; q < 8; ++q) { const float br = BBR[p * 16 + ci0 + q], bi = BBI[p * 16 + ci0 + q]; f[q] = ri ? (pr * bi + pi * br) : (pr * br - pi * bi); }
        *(u32x4*)(Wst + (size_t)r * 512 + k8 * 8) = pack8(f);
    }
    bf16* Wc = WSP(bf16, WS_S5WC) + (size_t)g * 512 * 128;
    for (int idx = tid; idx < 512 * 16; idx += NTHR) {
        const int r = idx >> 4, k8 = idx & 15, ri = k8 >> 3, p0 = (k8 & 7) * 8; const int j = (r & ~31) + perm32(r & 31), t = j >> 4, co = j & 15, n = t + 1; float f[8];
#pragma unroll
        for (int q = 0; q < 8; ++q) { const int p = p0 + q; const float pr = PR[n * 64 + p], pi = PI[n * 64 + p], cr = CRE[co * 64 + p], ci = CIM[co * 64 + p]; f[q] = ri ? (-cr * pi - ci * pr) : (cr * pr - ci * pi); }
        *(u32x4*)(Wc + (size_t)r * 128 + k8 * 8) = pack8(f);
    }
    __syncthreads();
}
__device__ __forceinline__ void ph_prologue(const Ctx& c) {
    LAS float* L = (LAS float*)c.lds;
    if (S5_MFMA) { for (int g = c.bid; g < 128; g += c.G) s5_precompute_group(c, g); }
    conv_slice(c, 0, CONV_PRO, 0, 0, 0, 0);
    __syncthreads();
    {
        const bool bal = S5_MFMA && c.G == 256; const int heavy = c.bid < 128;
        const int nrow = bal ? (heavy ? 6 : 10) : (T_ + c.G * NWAVE - 1) / (c.G * NWAVE);
        const int row0 = bal ? (heavy ? (c.bid * NWAVE + c.wave) * 6 : 128 * NWAVE * 6 + ((c.bid - 128) * NWAVE + c.wave) * 10) : (c.bid * NWAVE + c.wave) * nrow;
        for (int i = 0; i < nrow; ++i) { const int row = row0 + i; if (row >= T_) break;
            float v[32]; row_load32(c.in[0] + (size_t)row * D_, c.lane, v);
            const float r = row_rstd(v);
            row_store_norm_bf16(WSP(bf16, WS_HB) + (size_t)row * D_, c.in[1], c.lane, v, r);
        }
    }
    const int gtid = c.bid * NTHR + c.tid, gn = c.G * NTHR;
    for (int i = gtid; i < 1024; i += gn) { const float a = c.in[6][i], b = c.in[6][1024 + i], m = fmaxf(a, b); const float ea = expf(a - m), eb = expf(b - m); WSP(float, WS_LB)[i] = ea / (ea + eb); }
    for (int i = gtid; i < 128 * 64; i += gn) {
        const int g = i >> 6;
        const float dt = expf(c.in[11][g]), lr = c.in[9][i], li = c.in[10][i];
        const float mag = expf(lr * dt), ar = mag * cosf(li * dt), ai = mag * sinf(li * dt);
        const float den = lr * lr + li * li;
        const float cr = ((ar - 1.0f) * lr + ai * li) / den, ci = (ai * lr - (ar - 1.0f) * li) / den;
        float pr = ar, pi = ai;
#pragma unroll
        for (int s = 0; s < 6; ++s) { const float nr = pr * pr - pi * pi, ni = 2.0f * pr * pi; pr = nr; pi = ni; }
        float* A4 = WSP(float, WS_S5A) + (size_t)i * 4; A4[0] = ar; A4[1] = ai; A4[2] = pr; A4[3] = pi;
        float* Bo = WSP(float, WS_S5B) + (size_t)i * 32;
        for (int ch = 0; ch < 16; ++ch) { const float br = c.in[12][(size_t)i * 16 + ch], bi = c.in[13][(size_t)i * 16 + ch]; Bo[ch] = cr * br - ci * bi; Bo[16 + ch] = cr * bi + ci * br; }
    }
    for (int i = gtid; i < 2 * 48 * 2048; i += gn) {
        const int k = i % 2048, n = (i / 2048) % 48, l = i / (48 * 2048);
        float w = 0.f;
        if (n < 4) w = c.in[18][((size_t)l * 2048 + k) * 4 + n]; else if (n < 36) w = c.in[20][((size_t)l * 2048 + k) * 32 + (n - 4)];
        w *= c.in[2][l * 2048 + k];
        const bf16 hi = f2bf(w), lo = f2bf(w - bf2f(hi));
        bf16* d = WSP(bf16, WS_WR) + ((size_t)(l * 48 + n) * 2) * 2048 + k; d[0] = hi; d[2048] = lo;
    }
}

template <bool PAIRED, class ARow, class Epi>
__device__ __forceinline__ void naive_gemm(const Ctx& c, int M, int N, int K, const ARow& arow, const float* __restrict__ W, const float* __restrict__ W2, int ldw, const Epi& epi) {
    LAS float* As = (LAS float*)c.lds;
    LAS float* Ws = As + 16 * 68;
    LAS float* Ws2 = Ws + 16 * 132;
    const int tid = c.tid, ty = tid >> 5, tx = tid & 31;
    const int ntm = (M + 63) / 64, ntn = N / 128;
    for (int tile = c.bid; tile < ntm * ntn; tile += c.G) {
        const int tm = tile / ntn, tn = tile % ntn, r0 = tm * 64, c0 = tn * 128;
        float a1[4][4], a2[4][4];
#pragma unroll
        for (int i = 0; i < 4; ++i)
#pragma unroll
            for (int j = 0; j < 4; ++j) { a1[i][j] = 0.f; a2[i][j] = 0.f; }
        const int lr = tid >> 3, lk = (tid & 7) * 2;
        const bf16* ap = (r0 + lr < M) ? arow(r0 + lr) : nullptr;
        for (int k0 = 0; k0 < K; k0 += 16) {
            { float x0 = 0.f, x1 = 0.f; if (ap) { const unsigned w = *(const unsigned*)(ap + k0 + lk); x0 = __uint_as_float(w << 16); x1 = __uint_as_float(w & 0xffff0000u); }
              As[lk * 68 + lr] = x0; As[(lk + 1) * 68 + lr] = x1; }
            { const int wk = tid >> 5, w4 = tid & 31; const f32x4 wv = *(const f32x4*)(W + (size_t)(k0 + wk) * ldw + c0 + w4 * 4);
              LAS float* p = Ws + wk * 132 + w4 * 4; p[0] = bf2f(f2bf(wv[0])); p[1] = bf2f(f2bf(wv[1])); p[2] = bf2f(f2bf(wv[2])); p[3] = bf2f(f2bf(wv[3]));
              if (PAIRED) { const f32x4 wv2 = *(const f32x4*)(W2 + (size_t)(k0 + wk) * ldw + c0 + w4 * 4); LAS float* p2 = Ws2 + wk * 132 + w4 * 4;
                  p2[0] = bf2f(f2bf(wv2[0])); p2[1] = bf2f(f2bf(wv2[1])); p2[2] = bf2f(f2bf(wv2[2])); p2[3] = bf2f(f2bf(wv2[3])); } }
            __syncthreads();
#pragma unroll
            for (int kk = 0; kk < 16; ++kk) {
                float av[4], wv[4], wv2[4];
#pragma unroll
                for (int i = 0; i < 4; ++i) av[i] = As[kk * 68 + ty * 4 + i];
#pragma unroll
                for (int j = 0; j < 4; ++j) { wv[j] = Ws[kk * 132 + tx * 4 + j]; if (PAIRED) wv2[j] = Ws2[kk * 132 + tx * 4 + j]; }
#pragma unroll
                for (int i = 0; i < 4; ++i)
#pragma unroll
                    for (int j = 0; j < 4; ++j) { a1[i][j] += av[i] * wv[j]; if (PAIRED) a2[i][j] += av[i] * wv2[j]; }
            }
            __syncthreads();
        }
#pragma unroll
        for (int i = 0; i < 4; ++i) { const int r = r0 + ty * 4 + i; if (r < M)
#pragma unroll
            for (int j = 0; j < 4; ++j) epi(r, c0 + tx * 4 + j, a1[i][j], a2[i][j]); }
    }
}

constexpr size_t ZH_AS = (size_t)2 * 8 * SEQ * 128;
struct EpiZ {
    bf16* Z; bf16* ZH;
    __device__ __forceinline__ void operator()(const f32x4 (&acc)[2][2][4][2], const pg::Unit& u, int wr, int wc, int fr, int fq) const {
        if (u.pn >= 12) {
            const int pp = u.pn - 12, arr = pp >> 2, h0 = (pp & 3) * 2;
#pragma unroll
            for (int ai = 0; ai < 2; ++ai)
#pragma unroll
                for (int m = 0; m < 4; ++m) { const int row = u.pm * 256 + ai * 128 + wr * 64 + m * 16 + fr; const int b = row >> 13, t = row & (SEQ - 1);
#pragma unroll
                    for (int bj = 0; bj < 2; ++bj) { const f32x4 v0 = acc[ai][bj][m][0], v1 = acc[ai][bj][m][1]; u32x4 w; w.x = pk2(v0[0], v0[1]); w.y = pk2(v0[2], v0[3]); w.z = pk2(v1[0], v1[1]); w.w = pk2(v1[2], v1[3]);
                        *(u32x4*)(ZH + (size_t)arr * ZH_AS + ((size_t)((b * 8 + h0 + bj) * SEQ + t)) * 128 + wc * 32 + 8 * fq) = w; } }
            return;
        }
#pragma unroll
        for (int ai = 0; ai < 2; ++ai)
#pragma unroll
            for (int m = 0; m < 4; ++m) { const int row = u.pm * 256 + ai * 128 + wr * 64 + m * 16 + fr; bf16* rp = Z + (size_t)row * NIN + u.pn * 256 + wc * 32 + 8 * fq;
#pragma unroll
                for (int bj = 0; bj < 2; ++bj) { const f32x4 v0 = acc[ai][bj][m][0], v1 = acc[ai][bj][m][1]; u32x4 w; w.x = pk2(v0[0], v0[1]); w.y = pk2(v0[2], v0[3]); w.z = pk2(v1[0], v1[1]); w.w = pk2(v1[2], v1[3]);
                    *(u32x4*)(rp + bj * 128) = w; } }
    }
};
__device__ __forceinline__ void ph_inproj(const Ctx& c) {
    if (NAIVE_GEMM & 1) {
        const bf16* hb = WSP(bf16, WS_HB); bf16* Z = WSP(bf16, WS_Z);
        naive_gemm<false>(c, T_, NIN, 2048, [=](int r) { return hb + (size_t)r * 2048; }, c.in[4], nullptr, NIN, [=](int r, int col, float a, float) { Z[(size_t)r * NIN + col] = f2bf(a); });
    } else {
        pg::DenseSched S; S.init(WSP(bf16, WS_HB), WSP(bf16, WS_WIN), T_, NIN, 2048, c.G, c.bid);
        EpiZ E{WSP(bf16, WS_Z), WSP(bf16, WS_XB)};
        if (CONV_IN_GEMM) {
            const int slot = (c.bid >> 3) % 7; S.i1 = slot + 1; pg::gemm_phase_w(c.lds, S, E, c.wave);
            conv_slice(c, CVO_GLU, CV_GLU + CV_GU / 2, 0, 0, 0, 0);
            S.i0 = slot + 1; S.i1 = 1 << 20; pg::gemm_phase_w(c.lds, S, E, c.wave); }
        else pg::gemm_phase_w(c.lds, S, E, c.wave);
    }
}

constexpr int HS = 132;
__device__ __forceinline__ void hg_load_tile(const Ctx& c, LAS float* dst, const bf16* __restrict__ src  ) {
#pragma unroll
    for (int i = 0; i < 2; ++i) { const int vid = c.tid + i * 512, t = vid >> 4, d8 = vid & 15; const u32x4 w = *(const u32x4*)(src + (size_t)t * NIN + d8 * 8); float f[8]; unpack8(w, f);
        LAS float* p = dst + t * HS + d8 * 8;
#pragma unroll
        for (int j = 0; j < 8; ++j) p[j] = f[j]; }
}
__device__ __forceinline__ void ph_conv_hglocal(const Ctx& c) {
    const bf16* Z = WSP(bf16, WS_Z); bf16* Y = WSP(bf16, WS_YCAT);
    {
        const float* cw = c.in[5];
        const int gtid = c.bid * NTHR + c.tid, gn = c.G * NTHR;
        for (int it = gtid; it < (T_ / 8) * 128; it += gn) {
            const int c8 = it & 127, tb = it >> 7, t0 = tb * 8, ch = c8 * 8;
            float w0[8], w1[8], w2[8];
#pragma unroll
            for (int j = 0; j < 8; ++j) { w0[j] = cw[ch + j]; w1[j] = cw[1024 + ch + j]; w2[j] = cw[2048 + ch + j]; }
            float um2[8], um1[8];
#pragma unroll
            for (int j = 0; j < 8; ++j) { um2[j] = 0.f; um1[j] = 0.f; }
            if ((t0 & (SEQ - 1)) != 0) {
                float a[8], b[8];
                unpack8(*(const u32x4*)(Z + (size_t)(t0 - 2) * NIN + 1024 + ch), a); unpack8(*(const u32x4*)(Z + (size_t)(t0 - 2) * NIN + 2048 + ch), b);
#pragma unroll
                for (int j = 0; j < 8; ++j) um2[j] = a[j] * b[j];
                unpack8(*(const u32x4*)(Z + (size_t)(t0 - 1) * NIN + 1024 + ch), a); unpack8(*(const u32x4*)(Z + (size_t)(t0 - 1) * NIN + 2048 + ch), b);
#pragma unroll
                for (int j = 0; j < 8; ++j) um1[j] = a[j] * b[j];
            }
#pragma unroll
            for (int tt = 0; tt < 8; ++tt) {
                const size_t ro = (size_t)(t0 + tt) * NIN; float ab[8], ac[8], ah[8], o[8];
                unpack8(*(const u32x4*)(Z + ro + ch), ab); unpack8(*(const u32x4*)(Z + ro + 1024 + ch), ac); unpack8(*(const u32x4*)(Z + ro + 2048 + ch), ah);
#pragma unroll
                for (int j = 0; j < 8; ++j) { const float u0 = ac[j] * ah[j]; o[j] = ab[j] * (w0[j] * um2[j] + w1[j] * um1[j] + w2[j] * u0); um2[j] = um1[j]; um1[j] = u0; }
                *(u32x4*)(Y + (size_t)(t0 + tt) * D_ + ch) = pack8(o);
            }
        }
    }
    if (!HG_MFMA) {
        LAS float* B0 = (LAS float*)c.lds; LAS float* B1 = B0 + 64 * HS; LAS float* B2 = B1 + 64 * HS;
        const float* lb = WSP(float, WS_LB); float* KV = WSP(float, WS_KV); float* DEC = WSP(float, WS_HGDEC);
        for (int u = c.bid; u < 2048; u += c.G) {
            const int chunk = u & 127, bh = u >> 7, h = bh & 7, b = bh >> 3; const int t0 = b * SEQ + chunk * 64;
            hg_load_tile(c, B0, Z + (size_t)t0 * NIN + 4096 + h * 128);
            hg_load_tile(c, B2, Z + (size_t)t0 * NIN + 5120 + h * 128);
            __syncthreads();
            for (int i = c.tid; i < 64 * 128; i += 512) { const int t = i >> 7, d = i & 127; const float l = lb[h * 128 + d]; const float f = l + (1.0f - l) * sigmoidf_(B0[t * HS + d]); B0[t * HS + d] = logf(f); B1[t * HS + d] = 1.0f - f; }
            __syncthreads();
            if (c.tid < 128) { float run = 0.f; for (int t = 0; t < 64; ++t) { run += B0[t * HS + c.tid]; B0[t * HS + c.tid] = run; } }
            __syncthreads();
            for (int i = c.tid; i < 64 * 128; i += 512) { const int t = i >> 7, d = i & 127; B1[t * HS + d] *= expf(B0[63 * HS + d] - B0[t * HS + d]); }
            __syncthreads();
            const int kd0 = (c.tid >> 4) * 4, vd0 = (c.tid & 15) * 8;
            float acc[4][8];
#pragma unroll
            for (int i = 0; i < 4; ++i)
#pragma unroll
                for (int j = 0; j < 8; ++j) acc[i][j] = 0.f;
            for (int t = 0; t < 64; ++t) {
                const f32x4 kv = *(const LAS f32x4*)(B1 + t * HS + kd0), va = *(const LAS f32x4*)(B2 + t * HS + vd0), vb = *(const LAS f32x4*)(B2 + t * HS + vd0 + 4);
#pragma unroll
                for (int i = 0; i < 4; ++i) {
#pragma unroll
                    for (int j = 0; j < 4; ++j) { acc[i][j] += kv[i] * va[j]; acc[i][4 + j] += kv[i] * vb[j]; } }
            }
            float* kvp = KV + (size_t)u * 16384;
#pragma unroll
            for (int i = 0; i < 4; ++i) { *(f32x4*)(kvp + (kd0 + i) * 128 + vd0) = (f32x4){acc[i][0], acc[i][1], acc[i][2], acc[i][3]}; *(f32x4*)(kvp + (kd0 + i) * 128 + vd0 + 4) = (f32x4){acc[i][4], acc[i][5], acc[i][6], acc[i][7]}; }
            if (c.tid < 128) DEC[(size_t)u * 128 + c.tid] = expf(B0[63 * HS + c.tid]);
            __syncthreads();
        }
    }
}

__device__ __forceinline__ void ph_hgscan(const Ctx& c) {
    float* KV = WSP(float, WS_KV); const float* DEC = WSP(float, WS_HGDEC);
    const int gtid = c.bid * NTHR + c.tid, gn = c.G * NTHR;
    for (int i = gtid; i < 16 * 16384; i += gn) {
        const int bh = i >> 14, el = i & 16383, kd = el >> 7;
        float s = 0.f;
        for (int c0 = 0; c0 < 128; c0 += 8) {
            float tmp[8], dc[8];
#pragma unroll
            for (int j = 0; j < 8; ++j) { tmp[j] = KV[(size_t)(bh * 128 + c0 + j) * 16384 + el]; dc[j] = DEC[(size_t)(bh * 128 + c0 + j) * 128 + kd]; }
#pragma unroll
            for (int j = 0; j < 8; ++j) { KV[(size_t)(bh * 128 + c0 + j) * 16384 + el] = s; s = dc[j] * s + tmp[j]; }
        }
    }
}

__device__ __forceinline__ void ph_hgout(const Ctx& c) {
    const bf16* Z = WSP(bf16, WS_Z); bf16* Y = WSP(bf16, WS_YCAT);
    LAS float* B0 = (LAS float*)c.lds; LAS float* B1 = B0 + 64 * HS; LAS float* B2 = B1 + 64 * HS; LAS float* B3 = B2 + 64 * HS;
    const float* lb = WSP(float, WS_LB); const float* KV = WSP(float, WS_KV); const float* ng = c.in[7];
    for (int u = c.bid; u < 2048; u += c.G) {
        const int chunk = u & 127, bh = u >> 7, h = bh & 7, b = bh >> 3; const int t0 = b * SEQ + chunk * 64;
        hg_load_tile(c, B0, Z + (size_t)t0 * NIN + 4096 + h * 128);
        hg_load_tile(c, B1, Z + (size_t)t0 * NIN + 3072 + h * 128);
        hg_load_tile(c, B2, Z + (size_t)t0 * NIN + 5120 + h * 128);
        __syncthreads();
        for (int i = c.tid; i < 64 * 128; i += 512) { const int t = i >> 7, d = i & 127; const float l = lb[h * 128 + d]; const float f = l + (1.0f - l) * sigmoidf_(B0[t * HS + d]); B0[t * HS + d] = logf(f); B3[t * HS + d] = 1.0f - f; }
        __syncthreads();
        if (c.tid < 128) { float run = 0.f; for (int t = 0; t < 64; ++t) { run += B0[t * HS + c.tid]; B0[t * HS + c.tid] = run; } }
        __syncthreads();
        const int dd = c.tid & 127; const float ref = B0[31 * HS + dd];
        __syncthreads();
        for (int i = c.tid; i < 64 * 128; i += 512) { const int t = i >> 7; const float bb = B0[t * HS + dd], q = B1[t * HS + dd];
            B1[t * HS + dd] = q * expf(bb); B0[t * HS + dd] = q * expf(bb - ref); B3[t * HS + dd] *= expf(ref - bb); }
        __syncthreads();
        const int tg = c.tid >> 4, vg = c.tid & 15, ta = tg * 2, vd0 = vg * 8;
        float o[2][8];
#pragma unroll
        for (int i = 0; i < 2; ++i)
#pragma unroll
            for (int j = 0; j < 8; ++j) o[i][j] = 0.f;
        {
            const float* sp = KV + (size_t)u * 16384 + vd0;
            for (int kd = 0; kd < 128; kd += 4) {
                const f32x4 qa = *(const LAS f32x4*)(B1 + ta * HS + kd), qb = *(const LAS f32x4*)(B1 + (ta + 1) * HS + kd);
#pragma unroll
                for (int k2 = 0; k2 < 4; ++k2) { const f32x4 s0 = *(const f32x4*)(sp + (size_t)(kd + k2) * 128), s1 = *(const f32x4*)(sp + (size_t)(kd + k2) * 128 + 4);
#pragma unroll
                    for (int j = 0; j < 4; ++j) { o[0][j] += qa[k2] * s0[j]; o[0][4 + j] += qa[k2] * s1[j]; o[1][j] += qb[k2] * s0[j]; o[1][4 + j] += qb[k2] * s1[j]; } }
            }
        }
        __syncthreads();
        {
            const int t = c.tid >> 3, s0 = (c.tid & 7) * 8; float sc[8];
#pragma unroll
            for (int j = 0; j < 8; ++j) sc[j] = 0.f;
            for (int kd = 0; kd < 128; kd += 4) { const f32x4 q = *(const LAS f32x4*)(B0 + t * HS + kd);
#pragma unroll
                for (int j = 0; j < 8; ++j) { const f32x4 k = *(const LAS f32x4*)(B3 + (s0 + j) * HS + kd); sc[j] += q[0] * k[0] + q[1] * k[1] + q[2] * k[2] + q[3] * k[3]; } }
#pragma unroll
            for (int j = 0; j < 8; ++j) B1[t * 68 + s0 + j] = (s0 + j <= t) ? sc[j] : 0.f;
        }
        __syncthreads();
        for (int s = 0; s <= ta + 1; ++s) {
            const float p0 = B1[ta * 68 + s], p1 = B1[(ta + 1) * 68 + s];
            const f32x4 va = *(const LAS f32x4*)(B2 + s * HS + vd0), vb = *(const LAS f32x4*)(B2 + s * HS + vd0 + 4);
#pragma unroll
            for (int j = 0; j < 4; ++j) { o[0][j] += p0 * va[j]; o[0][4 + j] += p0 * vb[j]; o[1][j] += p1 * va[j]; o[1][4 + j] += p1 * vb[j]; }
        }
#pragma unroll
        for (int i = 0; i < 2; ++i) {
            float ss = 0.f;
#pragma unroll
            for (int j = 0; j < 8; ++j) ss += o[i][j] * o[i][j];
            ss += __shfl_xor(ss, 1); ss += __shfl_xor(ss, 2); ss += __shfl_xor(ss, 4); ss += __shfl_xor(ss, 8);
            const float r = rsqrtf(ss * (1.0f / 128.0f) + EPS);
            float g[8], res[8]; unpack8(*(const u32x4*)(Z + (size_t)(t0 + ta + i) * NIN + 6144 + h * 128 + vd0), g);
#pragma unroll
            for (int j = 0; j < 8; ++j) res[j] = o[i][j] * r * ng[vd0 + j] * siluf_(g[j]);
            *(u32x4*)(Y + (size_t)(t0 + ta + i) * D_ + 1024 + h * 128 + vd0) = pack8(res);
        }
        __syncthreads();
    }
}

__device__ __forceinline__ void hg_col16(const bf16* __restrict__ p, unsigned short (&o)[16]) {
#pragma unroll
    for (int i = 0; i < 16; ++i) o[i] = p[(size_t)i * NIN];
}
__device__ __forceinline__ u32x4 pk8us(unsigned short a0, unsigned short a1, unsigned short a2, unsigned short a3, unsigned short a4, unsigned short a5, unsigned short a6, unsigned short a7) {
    u32x4 w; w.x = (unsigned)a0 | ((unsigned)a1 << 16); w.y = (unsigned)a2 | ((unsigned)a3 << 16); w.z = (unsigned)a4 | ((unsigned)a5 << 16); w.w = (unsigned)a6 | ((unsigned)a7 << 16); return w;
}
__device__ __forceinline__ void ph_hgL(const Ctx& c) {
    const bf16* ZH = WSP(bf16, WS_XB); const float* lb = WSP(float, WS_LB); float* KV = WSP(float, WS_KV); float* DEC = WSP(float, WS_HGDEC);
    LAS bf16* VT = (LAS bf16*)c.lds; LAS bf16* KT = VT + 128 * 72; LAS float* SS = (LAS float*)(KT + 128 * 72); LAS bf16* ST = (LAS bf16*)(c.lds + 65536);
    const int d = c.tid & 127, seg = c.tid >> 7, r = c.lane & 31, hh = c.lane >> 5, w = c.wave;
    unsigned short fl[16], vv[16];
    LAS unsigned char* ZW = c.lds + 107520 + w * 4096;
    const int zr = c.lane >> 3, zp = c.lane & 7;
#define HGL_DMA(U) do { const int _c = (U) & 127, _bh = (U) >> 7; const bf16* _z = ZH + ((size_t)_bh * SEQ + _c * 64 + 16 * seg + zr) * 128 + 64 * (w & 1) + zp * 8; \
        _Pragma("unroll") for (int _a = 0; _a < 2; ++_a) _Pragma("unroll") for (int _hr = 0; _hr < 2; ++_hr) \
            __builtin_amdgcn_global_load_lds((const unsigned*)(_z + (size_t)(_a ? 2 : 1) * ZH_AS + (8 * _hr) * 128), (LAS unsigned*)(ZW + _a * 2048 + _hr * 1024), 16, 0, 0); } while (0)
#define HGL_COLS() do { asm volatile("s_waitcnt vmcnt(0)" ::: "memory"); _Pragma("unroll") for (int i = 0; i < 16; ++i) { fl[i] = *(const LAS unsigned short*)(ZW + i * 128 + c.lane * 2); vv[i] = *(const LAS unsigned short*)(ZW + 2048 + i * 128 + c.lane * 2); } \
        asm volatile("s_waitcnt lgkmcnt(0)" ::: "memory"); } while (0)
    if (c.bid < 2048) { HGL_DMA(c.bid); HGL_COLS(); }
    for (int u = c.bid; u < 2048; u += c.G) {
        const int bh = u >> 7, h = bh & 7;
        if (u + c.G < 2048) HGL_DMA(u + c.G);
        const float lbv = lb[h * 128 + d];
        float cs[16], kk[16]; float run = 0.f;
#pragma unroll
        for (int i = 0; i < 16; ++i) { const float f = lbv + (1.0f - lbv) * sigmoidf_(bf2f(fl[i])); kk[i] = 1.0f - f; run += __builtin_amdgcn_logf(f); cs[i] = run; }
        SS[seg * 128 + d] = run;
        __syncthreads();
        const float s0 = SS[d], s1 = SS[128 + d], s2 = SS[256 + d], s3 = SS[384 + d];
        const float prefix = (seg > 0 ? s0 : 0.f) + (seg > 1 ? s1 : 0.f) + (seg > 2 ? s2 : 0.f), total = (s0 + s1) + (s2 + s3);
        float kd[16];
#pragma unroll
        for (int i = 0; i < 16; ++i) kd[i] = kk[i] * __builtin_amdgcn_exp2f(total - prefix - cs[i]);
        { float f0[8], f1[8];
#pragma unroll
          for (int i = 0; i < 8; ++i) { f0[i] = kd[i]; f1[i] = kd[8 + i]; }
          *(LAS u32x4*)(KT + d * 72 + 16 * seg) = pack8(f0); *(LAS u32x4*)(KT + d * 72 + 16 * seg + 8) = pack8(f1);
          *(LAS u32x4*)(VT + d * 72 + 16 * seg) = pk8us(vv[0], vv[1], vv[2], vv[3], vv[4], vv[5], vv[6], vv[7]);
          *(LAS u32x4*)(VT + d * 72 + 16 * seg + 8) = pk8us(vv[8], vv[9], vv[10], vv[11], vv[12], vv[13], vv[14], vv[15]); }
        if (seg == 0) DEC[(size_t)u * 128 + d] = __builtin_amdgcn_exp2f(total);
        __syncthreads();
        const int vdt = w >> 1, kdt0 = (w & 1) * 2;
        f32x16 acc0, acc1;
#pragma unroll
        for (int i = 0; i < 16; ++i) { acc0[i] = 0.f; acc1[i] = 0.f; }
#pragma unroll
        for (int ks = 0; ks < 4; ++ks) {
            const bf16x8 a = *(const LAS bf16x8*)(VT + (32 * vdt + r) * 72 + 16 * ks + 8 * hh);
            const bf16x8 b0 = *(const LAS bf16x8*)(KT + (32 * kdt0 + r) * 72 + 16 * ks + 8 * hh), b1 = *(const LAS bf16x8*)(KT + (32 * (kdt0 + 1) + r) * 72 + 16 * ks + 8 * hh);
            acc0 = __builtin_amdgcn_mfma_f32_32x32x16_bf16(a, b0, acc0, 0, 0, 0); acc1 = __builtin_amdgcn_mfma_f32_32x32x16_bf16(a, b1, acc1, 0, 0, 0);
        }
        bf16* kvp = (bf16*)KV + (size_t)u * 16384;
#pragma unroll
        for (int i = 0; i < 16; ++i) { const int vd = 32 * vdt + (i & 3) + 8 * (i >> 2) + 4 * hh; ST[vd * 136 + 32 * kdt0 + r] = f2bf(acc0[i]); ST[vd * 136 + 32 * (kdt0 + 1) + r] = f2bf(acc1[i]); }
        __syncthreads();
        if (u + c.G < 2048) HGL_COLS();
#pragma unroll
        for (int p = 0; p < 4; ++p) { const int vd = p * 32 + (c.tid >> 4), k0 = (c.tid & 15) * 8;
            *(u32x4*)(kvp + vd * 128 + k0) = *(const LAS u32x4*)(ST + vd * 136 + k0); }
    }
}
#undef HGL_DMA
#undef HGL_COLS
__device__ __forceinline__ void ph_hgS(const Ctx& c) {
    const float* KV = WSP(float, WS_KV); const float* DEC = WSP(float, WS_HGDEC); bf16* SIN = WSP(bf16, WS_SIN);
    const int gtid = c.bid * NTHR + c.tid, gn = c.G * NTHR;
    for (int i = gtid; i < 16 * 8192; i += gn) {
        const int bh = i >> 13, e2 = i & 8191, vd = e2 >> 6, kd = (e2 & 63) * 2;
        float sa = 0.f, sb = 0.f;
        for (int c0 = 0; c0 < 128; c0 += 16) {
            f32x2 kv[16], dc[16];
#pragma unroll
            for (int j = 0; j < 16; ++j) { const unsigned wv = *(const unsigned*)((const bf16*)KV + (size_t)(bh * 128 + c0 + j) * 16384 + vd * 128 + kd); kv[j][0] = __uint_as_float(wv << 16); kv[j][1] = __uint_as_float(wv & 0xffff0000u);
                dc[j] = *(const f32x2*)(DEC + (size_t)(bh * 128 + c0 + j) * 128 + kd); }
#pragma unroll
            for (int j = 0; j < 16; ++j) { *(unsigned*)(SIN + (size_t)(bh * 128 + c0 + j) * 16384 + vd * 128 + kd) = pk2(sa, sb); sa = dc[j][0] * sa + kv[j][0]; sb = dc[j][1] * sb + kv[j][1]; }
        }
    }
}
__device__ __forceinline__ void ph_hgO(const Ctx& c) {
    const bf16* ZH = WSP(bf16, WS_XB); bf16* Y = WSP(bf16, WS_YCAT); const float* lb = WSP(float, WS_LB); const bf16* SIN = WSP(bf16, WS_SIN); const float* ng = c.in[7];
    LAS bf16* QB = (LAS bf16*)c.lds; LAS bf16* QS = QB + 64 * 136; LAS bf16* KS = QS + 64 * 136; LAS bf16* VT = KS + 64 * 136;
    LAS float* SS = (LAS float*)(c.lds + MISC_OFF + 1024); LAS float* RS = SS + 512; LAS float* OT = (LAS float*)(VT + 128 * 72);
    const int d = c.tid & 127, seg = c.tid >> 7, r = c.lane & 31, hh = c.lane >> 5, w = c.wave, vdt = w & 3, tt = w >> 2;
    bf16x8 sfr[8]; unsigned short fl[16], qq[16], vv[16]; u32x4 gn0, gn1;
    const int ot = c.tid >> 3, ovd0 = (c.tid & 7) * 8;
    LAS unsigned char* ZW = c.lds + 104448 + w * 6144;
    const int zr = c.lane >> 3, zp = c.lane & 7;
#define HGO_DMA(U) do { const int _c = (U) & 127, _bh = (U) >> 7; const bf16* _z = ZH + ((size_t)_bh * SEQ + _c * 64 + 16 * seg + zr) * 128 + 64 * (w & 1) + zp * 8; \
        _Pragma("unroll") for (int _a = 0; _a < 3; ++_a) _Pragma("unroll") for (int _hr = 0; _hr < 2; ++_hr) \
            __builtin_amdgcn_global_load_lds((const unsigned*)(_z + (size_t)(_a == 0 ? 1 : _a == 1 ? 0 : 2) * ZH_AS + (8 * _hr) * 128), (LAS unsigned*)(ZW + _a * 2048 + _hr * 1024), 16, 0, 0); } while (0)
#define HGO_LOAD_G(U) do { const int _c = (U) & 127, _bh = (U) >> 7; \
        const bf16* _gp = ZH + 3 * ZH_AS + ((size_t)_bh * SEQ + _c * 64 + ot) * 128 + ovd0; gn0 = *(const u32x4*)_gp; gn1 = *(const u32x4*)(_gp + 64); } while (0)
#define HGO_COLS(NW) do { asm volatile("s_waitcnt vmcnt(" #NW ")" ::: "memory"); _Pragma("unroll") for (int i = 0; i < 16; ++i) { fl[i] = *(const LAS unsigned short*)(ZW + i * 128 + c.lane * 2); \
        qq[i] = *(const LAS unsigned short*)(ZW + 2048 + i * 128 + c.lane * 2); vv[i] = *(const LAS unsigned short*)(ZW + 4096 + i * 128 + c.lane * 2); } asm volatile("s_waitcnt lgkmcnt(0)" ::: "memory"); } while (0)
#define HGO_LOAD_S(U) do { const bf16* _sp = SIN + (size_t)(U) * 16384 + (32 * vdt + r) * 128 + 8 * hh; _Pragma("unroll") for (int k8 = 0; k8 < 8; ++k8) sfr[k8] = *(const bf16x8*)(_sp + 16 * k8); } while (0)
    if (c.bid < 2048) { HGO_DMA(c.bid); HGO_LOAD_G(c.bid); HGO_LOAD_S(c.bid); HGO_COLS(0); }
    for (int u = c.bid; u < 2048; u += c.G) {
        const int chunk = u & 127, bh = u >> 7, h = bh & 7, b = bh >> 3; const int t0 = b * SEQ + chunk * 64;
        const u32x4 gc0 = gn0, gc1 = gn1;
        if (u + c.G < 2048) { HGO_DMA(u + c.G); HGO_LOAD_G(u + c.G); }
        const float lbv = lb[h * 128 + d];
        float cs[16], kk[16]; float run = 0.f;
#pragma unroll
        for (int i = 0; i < 16; ++i) { const float f = lbv + (1.0f - lbv) * sigmoidf_(bf2f(fl[i])); kk[i] = 1.0f - f; run += __builtin_amdgcn_logf(f); cs[i] = run; }
        SS[seg * 128 + d] = run;
        __syncthreads();
        { const float s0 = SS[d], s1 = SS[128 + d], s2 = SS[256 + d];
          const float prefix = (seg > 0 ? s0 : 0.f) + (seg > 1 ? s1 : 0.f) + (seg > 2 ? s2 : 0.f), ref = s0 + s1;
#pragma unroll
          for (int i = 0; i < 16; ++i) { const float bb = prefix + cs[i], q = bf2f(qq[i]); const int t = 16 * seg + i;
              QB[t * 136 + d] = f2bf(q * __builtin_amdgcn_exp2f(bb)); QS[t * 136 + d] = f2bf(q * __builtin_amdgcn_exp2f(bb - ref)); KS[t * 136 + d] = f2bf(kk[i] * __builtin_amdgcn_exp2f(ref - bb)); }
          *(LAS u32x4*)(VT + d * 72 + 16 * seg) = pk8us(vv[0], vv[1], vv[2], vv[3], vv[8], vv[9], vv[10], vv[11]);
          *(LAS u32x4*)(VT + d * 72 + 16 * seg + 8) = pk8us(vv[4], vv[5], vv[6], vv[7], vv[12], vv[13], vv[14], vv[15]); }
        __syncthreads();
        f32x16 acc;
#pragma unroll
        for (int i = 0; i < 16; ++i) acc[i] = 0.f;
#pragma unroll
        for (int k8 = 0; k8 < 8; ++k8) { const bf16x8 bq = *(const LAS bf16x8*)(QB + (32 * tt + r) * 136 + 16 * k8 + 8 * hh); acc = __builtin_amdgcn_mfma_f32_32x32x16_bf16(sfr[k8], bq, acc, 0, 0, 0); }
        if (u + c.G < 2048) HGO_LOAD_S(u + c.G);
        for (int st = 0; st <= tt; ++st) {
            f32x16 x;
#pragma unroll
            for (int i = 0; i < 16; ++i) x[i] = 0.f;
#pragma unroll
            for (int k8 = 0; k8 < 8; ++k8) { const bf16x8 ak = *(const LAS bf16x8*)(KS + (32 * st + r) * 136 + 16 * k8 + 8 * hh), bq = *(const LAS bf16x8*)(QS + (32 * tt + r) * 136 + 16 * k8 + 8 * hh);
                x = __builtin_amdgcn_mfma_f32_32x32x16_bf16(ak, bq, x, 0, 0, 0); }
            if (st == tt) {
#pragma unroll
                for (int i = 0; i < 16; ++i) { const int row = (i & 3) + 8 * (i >> 2) + 4 * hh; if (row > r) x[i] = 0.f; }
            }
#pragma unroll
            for (int sp = 0; sp < 2; ++sp) {
                u32x4 pw; pw.x = pk2(x[8 * sp], x[8 * sp + 1]); pw.y = pk2(x[8 * sp + 2], x[8 * sp + 3]); pw.z = pk2(x[8 * sp + 4], x[8 * sp + 5]); pw.w = pk2(x[8 * sp + 6], x[8 * sp + 7]);
                const bf16x8 pf = __builtin_bit_cast(bf16x8, pw);
                const bf16x8 av = *(const LAS bf16x8*)(VT + (32 * vdt + r) * 72 + 32 * st + 16 * sp + 8 * hh);
                acc = __builtin_amdgcn_mfma_f32_32x32x16_bf16(av, pf, acc, 0, 0, 0);
            }
        }
        { float ss = 0.f;
#pragma unroll
          for (int i = 0; i < 16; ++i) ss += acc[i] * acc[i];
          ss += __shfl_xor(ss, 32);
          if (hh == 0) RS[(tt * 4 + vdt) * 32 + r] = ss;
#pragma unroll
          for (int i4 = 0; i4 < 4; ++i4) *(LAS f32x4*)(OT + (32 * tt + r) * 132 + 32 * vdt + 8 * i4 + 4 * hh) = (f32x4){acc[4 * i4], acc[4 * i4 + 1], acc[4 * i4 + 2], acc[4 * i4 + 3]}; }
        __syncthreads();
        if (u + c.G < 2048) HGO_COLS(8);
        { const int t = ot, vd0 = ovd0;
          const float ssum = (RS[((t >> 5) * 4 + 0) * 32 + (t & 31)] + RS[((t >> 5) * 4 + 1) * 32 + (t & 31)]) + (RS[((t >> 5) * 4 + 2) * 32 + (t & 31)] + RS[((t >> 5) * 4 + 3) * 32 + (t & 31)]);
          const float rr = rsqrtf(ssum * (1.0f / 128.0f) + EPS);
#pragma unroll
          for (int hf = 0; hf < 2; ++hf) { float g[8], o[8]; unpack8(hf ? gc1 : gc0, g);
              const f32x4 oa = *(const LAS f32x4*)(OT + t * 132 + vd0 + 64 * hf), ob = *(const LAS f32x4*)(OT + t * 132 + vd0 + 64 * hf + 4);
#pragma unroll
              for (int j = 0; j < 4; ++j) { o[j] = oa[j] * rr * ng[vd0 + 64 * hf + j] * siluf_(g[j]); o[4 + j] = ob[j] * rr * ng[vd0 + 64 * hf + 4 + j] * siluf_(g[4 + j]); }
              *(u32x4*)(Y + (size_t)(t0 + t) * D_ + 1024 + h * 128 + vd0 + 64 * hf) = pack8(o); } }
    }
}

#undef HGO_DMA
#undef HGO_LOAD_G
#undef HGO_COLS
#undef HGO_LOAD_S
struct EpiRes {
    const float* R; float* O; bf16* HBo; const float* g;
    __device__ __forceinline__ void operator()(const f32x4 (&acc)[2][2][4][2], const pg::Unit& u, int wr, int wc, int fr, int fq) const {
        const int colb = u.pn * 256 + wc * 32 + 8 * fq;
        f32x4 gv[2][2];
#pragma unroll
        for (int bj = 0; bj < 2; ++bj)
#pragma unroll
            for (int n = 0; n < 2; ++n) gv[bj][n] = *(const f32x4*)(g + colb + bj * 128 + n * 4);
#pragma unroll
        for (int ai = 0; ai < 2; ++ai)
#pragma unroll
            for (int m = 0; m < 4; ++m) { const int row = u.pm * 256 + ai * 128 + wr * 64 + m * 16 + fr; const size_t off = (size_t)row * D_ + colb;
#pragma unroll
                for (int bj = 0; bj < 2; ++bj) { f32x4 o[2];
#pragma unroll
                    for (int n = 0; n < 2; ++n) { const f32x4 r = *(const f32x4*)(R + off + bj * 128 + n * 4); o[n] = r + acc[ai][bj][m][n]; *(f32x4*)(O + off + bj * 128 + n * 4) = o[n]; }
                    u32x4 w; w.x = pk2(o[0][0] * gv[bj][0][0], o[0][1] * gv[bj][0][1]); w.y = pk2(o[0][2] * gv[bj][0][2], o[0][3] * gv[bj][0][3]);
                    w.z = pk2(o[1][0] * gv[bj][1][0], o[1][1] * gv[bj][1][1]); w.w = pk2(o[1][2] * gv[bj][1][2], o[1][3] * gv[bj][1][3]);
                    *(u32x4*)(HBo + off + bj * 128) = w; } }
    }
};
__device__ __forceinline__ void ph_outproj(const Ctx& c) {
    if (NAIVE_GEMM & 2) {
        const bf16* A = WSP(bf16, WS_YCAT); const float* X = c.in[0]; float* O = WSP(float, WS_XA); bf16* HBn = WSP(bf16, WS_HB); const float* gn = c.in[2];
        naive_gemm<false>(c, T_, 2048, 2048, [=](int r) { return A + (size_t)r * 2048; }, c.in[8], nullptr, 2048, [=](int r, int col, float a, float) { const float o = X[(size_t)r * 2048 + col] + a; O[(size_t)r * 2048 + col] = o; HBn[(size_t)r * 2048 + col] = f2bf(o * gn[col]); });
    } else {
        pg::DenseSched S; S.init(WSP(bf16, WS_YCAT), WSP(bf16, WS_WOUT), T_, 2048, 2048, c.G, c.bid);
        EpiRes E{c.in[0], WSP(float, WS_XA), WSP(bf16, WS_HB), c.in[2]};
        pg::gemm_phase_w(c.lds, S, E, c.wave);
    }
}

template <int LAYER, bool DRY = false>
__device__ __forceinline__ void ph_router(const Ctx& c, const float* __restrict__ X) {
    constexpr int WST = 264, WBUF = 2 * 48 * WST;
    LAS bf16* WL = (LAS bf16*)c.lds;
    LAS float* P = (LAS float*)c.lds;
    LAS float* SSQ = P + 8 * 16 * 48;
    LAS float* LG = SSQ + 128;
    LAS float* RS = LG + 64 * 48;
    LAS int* DE = (LAS int*)(RS + 64); LAS int* DV = DE + 128; LAS int* LC = DV + 128; LAS int* LB = LC + 32; LAS float* DG = (LAS float*)(LB + 32);
    const bf16* WRS = WSP(bf16, WS_WR) + (size_t)LAYER * 48 * 2 * 2048;
    const float* bc = c.in[19] + LAYER * 4; const float* bfi = c.in[21] + LAYER * 32;
    int* rowl = WSP(int, WS_ROWL) + (size_t)LAYER * NE * CAP; float* tokg = WSP(float, WS_TOKG) + (size_t)LAYER * 2 * T_; float* tokr = WSP(float, WS_TOKR) + (size_t)LAYER * T_; u32x4* rowl16 = WSP(u32x4, WS_ROWL16) + (size_t)LAYER * NE * CAP;
    unsigned* cnt = WSP(unsigned, WS_CTL) + CW_CNT + LAYER * 32;
    const int tok = c.lane & 15, kq = c.lane >> 4, w = c.wave, tg = w & 3, kh = w >> 2;
#define RT_WSRC(idx, cc) (WRS + ((size_t)((((idx) % 1536) >> 5) * 2 + ((((idx) % 1536) & 31) >> 4)) * 2048) + 1024 * ((idx) / 1536) + 128 * (cc) + 8 * ((idx) & 15))
#define RT_WDST(idx, buf) (WL + (buf) * WBUF + (((idx) / 1536) * 48 + (((idx) % 1536) >> 5)) * WST + ((((idx) % 1536) & 31) >> 4) * 128 + 8 * ((idx) & 15))
    for (int pass = c.bid; pass < T_ / 64; pass += c.G) {
        const int t0 = pass * 64;
        const float* xr = X + (size_t)(t0 + 16 * tg + tok) * D_ + 1024 * kh + 8 * kq;
        u32x4 wst[6];
#pragma unroll
        for (int i = 0; i < 6; ++i) wst[i] = *(const u32x4*)RT_WSRC(c.tid + i * 512, 0);
#pragma unroll
        for (int i = 0; i < 6; ++i) *(LAS u32x4*)RT_WDST(c.tid + i * 512, 0) = wst[i];
        f32x4 xq[3][8];
#define RT_XLOAD(dst, ch) do { _Pragma("unroll") for (int i = 0; i < 4; ++i) { dst[2 * i] = *(const f32x4*)(xr + 128 * (ch) + 32 * i); dst[2 * i + 1] = *(const f32x4*)(xr + 128 * (ch) + 32 * i + 4); } } while (0)
        RT_XLOAD(xq[0], 0); RT_XLOAD(xq[1], 1);
        __syncthreads();
        f32x4 acc[3]; acc[0] = acc[1] = acc[2] = (f32x4){0.f, 0.f, 0.f, 0.f};
        float ss = 0.f;
#pragma unroll
        for (int cc = 0; cc < 8; ++cc) {
            if (cc < 7) {
#pragma unroll
                for (int i = 0; i < 6; ++i) wst[i] = *(const u32x4*)RT_WSRC(c.tid + i * 512, cc + 1);
            }
            if (cc < 6) RT_XLOAD(xq[(cc + 2) % 3], cc + 2);
            const f32x4 (&xc)[8] = xq[cc % 3];
            const LAS bf16* wb = WL + (cc & 1) * WBUF + (kh * 48 + tok) * WST + 8 * kq;
#pragma unroll
            for (int i = 0; i < 4; ++i) {
                const f32x4 xa = xc[2 * i], xb = xc[2 * i + 1];
                u32x4 hw; hw.x = pk2(xa[0], xa[1]); hw.y = pk2(xa[2], xa[3]); hw.z = pk2(xb[0], xb[1]); hw.w = pk2(xb[2], xb[3]);
                u32x4 lw;
                lw.x = pk2(xa[0] - __uint_as_float(hw.x << 16), xa[1] - __uint_as_float(hw.x & 0xffff0000u)); lw.y = pk2(xa[2] - __uint_as_float(hw.y << 16), xa[3] - __uint_as_float(hw.y & 0xffff0000u));
                lw.z = pk2(xb[0] - __uint_as_float(hw.z << 16), xb[1] - __uint_as_float(hw.z & 0xffff0000u)); lw.w = pk2(xb[2] - __uint_as_float(hw.w << 16), xb[3] - __uint_as_float(hw.w & 0xffff0000u));
                const bf16x8 ahi = __builtin_bit_cast(bf16x8, hw), alo = __builtin_bit_cast(bf16x8, lw);
#pragma unroll
                for (int j = 0; j < 4; ++j) ss += xa[j] * xa[j] + xb[j] * xb[j];
#pragma unroll
                for (int nt = 0; nt < 3; ++nt) {
                    const bf16x8 bhi = *(const LAS bf16x8*)(wb + nt * 16 * WST + 32 * i), blo = *(const LAS bf16x8*)(wb + nt * 16 * WST + 128 + 32 * i);
                    acc[nt] = __builtin_amdgcn_mfma_f32_16x16x32_bf16(ahi, bhi, acc[nt], 0, 0, 0);
                    acc[nt] = __builtin_amdgcn_mfma_f32_16x16x32_bf16(ahi, blo, acc[nt], 0, 0, 0);
                    acc[nt] = __builtin_amdgcn_mfma_f32_16x16x32_bf16(alo, bhi, acc[nt], 0, 0, 0);
                }
            }
            if (cc < 7) {
#pragma unroll
                for (int i = 0; i < 6; ++i) *(LAS u32x4*)RT_WDST(c.tid + i * 512, (cc + 1) & 1) = wst[i];
            }
            asm volatile("s_waitcnt lgkmcnt(0)" ::: "memory"); __builtin_amdgcn_s_barrier(); asm volatile("" ::: "memory");
        }
#undef RT_XLOAD
        ss += __shfl_xor(ss, 16); ss += __shfl_xor(ss, 32);
#pragma unroll
        for (int nt = 0; nt < 3; ++nt)
#pragma unroll
            for (int r = 0; r < 4; ++r) P[(w * 16 + 4 * kq + r) * 48 + 16 * nt + tok] = acc[nt][r];
        if (kq == 0) SSQ[w * 16 + tok] = ss;
        __syncthreads();
        for (int i = c.tid; i < 64 * 48; i += 512) { const int tk = i / 48, n = i % 48, g4 = tk >> 4, tl = tk & 15; LG[i] = P[(g4 * 16 + tl) * 48 + n] + P[((g4 + 4) * 16 + tl) * 48 + n]; }
        if (c.tid < 64) { const int g4 = c.tid >> 4, tl = c.tid & 15; RS[c.tid] = rsqrtf((SSQ[g4 * 16 + tl] + SSQ[(g4 + 4) * 16 + tl]) * (1.0f / 2048.0f) + EPS); }
        __syncthreads();
        if (c.tid < 64) {
            const int t = t0 + c.tid; const float rr = RS[c.tid];
            float lc[4]; int grp = 0; float mx = -3.0e38f;
#pragma unroll
            for (int i = 0; i < 4; ++i) { lc[i] = rr * LG[c.tid * 48 + i] + bc[i]; if (lc[i] > mx) { mx = lc[i]; grp = i; } }
            float den = 0.f;
#pragma unroll
            for (int i = 0; i < 4; ++i) den += expf(lc[i] - mx);
            const float ptop = 1.0f / den;
            float fv[8]; int i0 = 0; float v0 = -3.0e38f;
#pragma unroll
            for (int i = 0; i < 8; ++i) { fv[i] = rr * LG[c.tid * 48 + 4 + grp * 8 + i] + bfi[grp * 8 + i]; if (fv[i] > v0) { v0 = fv[i]; i0 = i; } }
            int i1 = 0; float v1 = -3.0e38f;
#pragma unroll
            for (int i = 0; i < 8; ++i) if (i != i0 && fv[i] > v1) { v1 = fv[i]; i1 = i; }
            const float e1 = expf(v1 - v0); const float w0 = 1.0f / (1.0f + e1), w1 = e1 / (1.0f + e1);
            DE[2 * c.tid] = grp * 8 + i0; DV[2 * c.tid] = 2 * t; DE[2 * c.tid + 1] = grp * 8 + i1; DV[2 * c.tid + 1] = 2 * t + 1;
            DG[2 * c.tid] = ptop * w0; DG[2 * c.tid + 1] = ptop * w1;
            if (!DRY) { tokg[2 * t] = ptop * w0; tokg[2 * t + 1] = ptop * w1; tokr[t] = rr; }
        }
        if (c.tid < 32) LC[c.tid] = 0;
        __syncthreads();
        int rank0 = 0;
        if (c.tid < 128) rank0 = __hip_atomic_fetch_add(&LC[DE[c.tid]], 1, __ATOMIC_RELAXED, __HIP_MEMORY_SCOPE_WORKGROUP);
        __syncthreads();
        if (!DRY && c.tid < 32) { const int n = LC[c.tid]; LB[c.tid] = n ? (int)atomicAdd(&cnt[c.tid], (unsigned)n) : 0; }
        __syncthreads();
        if (!DRY && c.tid < 128) { const int e = DE[c.tid]; const size_t pos = (size_t)e * CAP + LB[e] + rank0; rowl[pos] = DV[c.tid];
            rowl16[pos] = (u32x4){(unsigned)DV[c.tid], __float_as_uint(DG[c.tid]), __float_as_uint(RS[c.tid >> 1]), 0u}; }
        __syncthreads();
    }
}

#undef RT_WSRC
#undef RT_WDST
struct MoeTab { const LAS int* tile0; const LAS int* cnt; const LAS unsigned char* tileExp; int ntiles; };
__device__ __forceinline__ MoeTab moe_tables(const Ctx& c, int layer) {
    LAS int* tile0 = (LAS int*)(c.lds + MISC_OFF + 64); LAS int* cn = (LAS int*)(c.lds + MISC_OFF + 256); LAS unsigned char* te = (LAS unsigned char*)(c.lds + MISC_OFF + 512);
    const unsigned* cnt = WSP(unsigned, WS_CTL) + CW_CNT + layer * 32;
    __syncthreads();
    if (c.tid < 64) {
        const int e = c.tid & 31; const int ce = (int)__hip_atomic_load(cnt + e, __ATOMIC_RELAXED, __HIP_MEMORY_SCOPE_AGENT); const int nt = (ce + 255) >> 8;
        int incl = nt;
#pragma unroll
        for (int o = 1; o < 32; o <<= 1) { const int v = __shfl_up(incl, o, 32); if (e >= o) incl += v; }
        if (c.tid < 32) { const int start = incl - nt; cn[e] = ce; tile0[e] = start; for (int j = 0; j < nt; ++j) te[start + j] = (unsigned char)e; if (e == 31) tile0[NE] = incl; }
    }
    __syncthreads();
    MoeTab t; t.tile0 = tile0; t.cnt = cn; t.tileExp = te; t.ntiles = tile0[NE]; return t;
}
struct EpiGU {
    bf16* H; const LAS unsigned char* lds;
    __device__ __forceinline__ void operator()(const f32x4 (&acc)[2][2][4][2], const pg::Unit& u, int wr, int wc, int fr, int fq) const {
        const LAS u32x4* lst = (const LAS u32x4*)(lds + LIST_OFF + u.lbuf * 4096);
#pragma unroll
        for (int ai = 0; ai < 2; ++ai)
#pragma unroll
            for (int m = 0; m < 4; ++m) { const int r = ai * 128 + wr * 64 + m * 16 + fr; const int slot = u.pm * 256 + r;
                const float rs = r < u.nvalid ? *(const LAS float*)((const LAS unsigned char*)lst + r * 16 + 8) : 0.f;
                u32x4 w = (u32x4){0u, 0u, 0u, 0u};
                if (r < u.nvalid) { float f[8];
#pragma unroll
                    for (int n = 0; n < 2; ++n)
#pragma unroll
                        for (int j = 0; j < 4; ++j) { const float a = rs * acc[ai][0][m][n][j]; f[n * 4 + j] = a * (rs * acc[ai][1][m][n][j]) * __builtin_amdgcn_rcpf(1.0f + __builtin_amdgcn_exp2f(-1.4426950408889634f * a)); }
                    w = pack8(f); }
                *(u32x4*)(H + (size_t)slot * FF + u.pn * 128 + wc * 32 + 8 * fq) = w; }
    }
};
struct EpiDown {
    bf16* Y; const LAS unsigned char* lds;
    __device__ __forceinline__ void operator()(const f32x4 (&acc)[2][2][4][2], const pg::Unit& u, int wr, int wc, int fr, int fq) const {
        const LAS u32x4* lst = (const LAS u32x4*)(lds + LIST_OFF + u.lbuf * 4096);
#pragma unroll
        for (int ai = 0; ai < 2; ++ai)
#pragma unroll
            for (int m = 0; m < 4; ++m) { const int r = ai * 128 + wr * 64 + m * 16 + fr;
                if (r < u.nvalid) { const u32x2 en = *(const LAS u32x2*)((const LAS unsigned char*)lst + r * 16); const int v = (int)en.x; const float g = __uint_as_float(en.y); bf16* rp = Y + (size_t)v * D_ + u.pn * 256 + wc * 32 + 8 * fq;
#pragma unroll
                    for (int bj = 0; bj < 2; ++bj) { float f[8];
#pragma unroll
                        for (int n = 0; n < 2; ++n)
#pragma unroll
                            for (int j = 0; j < 4; ++j) f[n * 4 + j] = g * acc[ai][bj][m][n][j];
                        *(u32x4*)(rp + bj * 128) = pack8(f); } } }
    }
};
template <int LAYER>
__device__ __forceinline__ void ph_moe_gu(const Ctx& c) {
    const MoeTab tb = moe_tables(c, LAYER);
    const int* rowl = WSP(int, WS_ROWL) + (size_t)LAYER * NE * CAP;
    if (NAIVE_GEMM & 4) {
        const bf16* hb = WSP(bf16, WS_HB); bf16* H = WSP(bf16, WS_HID); const float* tokr = WSP(float, WS_TOKR) + (size_t)LAYER * T_;
        for (int rt = 0; rt < tb.ntiles; ++rt) {
            const int e = tb.tileExp[rt], lt = rt - tb.tile0[e], nv = tb.cnt[e] - lt * 256; const int M = nv < 256 ? nv : 256;
            const float* Wg = c.in[22] + ((size_t)LAYER * 32 + e) * 2048 * 1024; const float* Wu = c.in[23] + ((size_t)LAYER * 32 + e) * 2048 * 1024;
            naive_gemm<true>(c, M, 1024, 2048, [=](int r) { return hb + (size_t)(rowl[(size_t)e * CAP + lt * 256 + r] >> 1) * 2048; }, Wg, Wu, 1024,
                             [=](int r, int col, float a, float b) { const float rs = tokr[rowl[(size_t)e * CAP + lt * 256 + r] >> 1]; H[(size_t)(rt * 256 + r) * FF + col] = f2bf(siluf_(rs * a) * (rs * b)); });
        }
    } else {
        pg::MoeSched<true> S; S.A = (const char*)WSP(bf16, WS_HB); S.B = (const char*)(WSP(bf16, WS_WGU) + (size_t)LAYER * 32 * 2048 * 2048); S.nt1 = 32; S.nt2 = 0; S.i0 = 0; S.i1 = 1 << 20; S.nN = 8; S.nwg = tb.ntiles * 8; S.G = c.G; S.c = c.bid;
        S.pitchA = 4096; S.pitchB = 4096; S.hA = 128 * 4096; S.hA2 = 0; S.hB2 = 0; S.A2 = S.A; S.B2 = S.B; S.expStrideB = 2048u * 2048u * 2u; S.tile0 = tb.tile0; S.cnt = tb.cnt; S.tileExp = tb.tileExp; S.rowl = rowl;
        S.rowl16 = WSP(u32x4, WS_ROWL16) + (size_t)LAYER * NE * CAP;
        EpiGU E{WSP(bf16, WS_HID), c.lds};
        if (CONV_IN_GEMM) {
            const int slot = (c.bid >> 3) % 4; S.i1 = slot + 1; pg::gemm_phase_w(c.lds, S, E, c.wave);
            conv_slice_moe(c, CVO_DN + LAYER * (CV_DN / 2), CV_DN / 2, S.nwg, 12);
            S.i0 = slot + 1; S.i1 = 1 << 20; pg::gemm_phase_w(c.lds, S, E, c.wave); }
        else pg::gemm_phase_w(c.lds, S, E, c.wave);
    }
}
template <int LAYER>
__device__ __forceinline__ void ph_moe_down(const Ctx& c) {
    const MoeTab tb = moe_tables(c, LAYER);
    const int* rowl = WSP(int, WS_ROWL) + (size_t)LAYER * NE * CAP; const float* tokg = WSP(float, WS_TOKG) + (size_t)LAYER * 2 * T_;
    bf16* Y = WSP(bf16, WS_KV);
    if (NAIVE_GEMM & 8) {
        const bf16* H = WSP(bf16, WS_HID);
        for (int rt = 0; rt < tb.ntiles; ++rt) {
            const int e = tb.tileExp[rt], lt = rt - tb.tile0[e], nv = tb.cnt[e] - lt * 256; const int M = nv < 256 ? nv : 256;
            const float* Wd = c.in[24] + ((size_t)LAYER * 32 + e) * 1024 * 2048;
            naive_gemm<false>(c, M, 2048, 1024, [=](int r) { return H + (size_t)(rt * 256 + r) * FF; }, Wd, nullptr, 2048,
                              [=](int r, int col, float a, float) { const int v = rowl[(size_t)e * CAP + lt * 256 + r]; Y[(size_t)v * D_ + col] = f2bf(tokg[v] * a); });
        }
    } else {
        pg::MoeSched<false> S; S.A = (const char*)WSP(bf16, WS_HID); S.B = (const char*)(WSP(bf16, WS_WD) + (size_t)LAYER * 32 * 2048 * 1024); S.nt1 = 16; S.nt2 = 0; S.i0 = 0; S.i1 = 1 << 20; S.nN = 8; S.nwg = tb.ntiles * 8; S.G = c.G; S.c = c.bid;
        S.pitchA = 2048; S.pitchB = 2048; S.hA = 128 * 2048; S.hA2 = 0; S.hB2 = 0; S.A2 = S.A; S.B2 = S.B; S.expStrideB = 2048u * 1024u * 2u; S.tile0 = tb.tile0; S.cnt = tb.cnt; S.tileExp = tb.tileExp; S.rowl = rowl;
        S.rowl16 = WSP(u32x4, WS_ROWL16) + (size_t)LAYER * NE * CAP;
        EpiDown E{Y, c.lds};
        if (CONV_IN_GEMM && LAYER == 0) {
            const int slot = (c.bid >> 3) % 4; S.i1 = slot + 1; pg::gemm_phase_w(c.lds, S, E, c.wave);
            conv_slice_moe(c, CVO_GU + CV_GU / 2, CV_GU1_SPLIT * 256, S.nwg, 7);
            S.i0 = slot + 1; S.i1 = 1 << 20; pg::gemm_phase_w(c.lds, S, E, c.wave); }
        else pg::gemm_phase_w(c.lds, S, E, c.wave);
    }
}

template <bool U2L>
__device__ __forceinline__ void ph_res_norm(const Ctx& c, const float* __restrict__ Xin, float* __restrict__ Xout, const float* __restrict__ g, bf16* __restrict__ U) {
    const bf16* Ys = WSP(bf16, WS_KV);
    const int gw = c.bid * NWAVE + c.wave, nw = c.G * NWAVE;
    for (int rb = gw; rb < T_ / 4; rb += nw) {
#pragma unroll 1
        for (int r4 = 0; r4 < 4; ++r4) {
            const int row = rb * 4 + r4;
            float v[32]; row_load32(Xin + (size_t)row * D_, c.lane, v);
            row_add_bf16(Ys + (size_t)(2 * row) * D_, c.lane, v); row_add_bf16(Ys + (size_t)(2 * row + 1) * D_, c.lane, v);
            if (Xout) {
#pragma unroll
            for (int cch = 0; cch < 4; ++cch) { *(f32x4*)(Xout + (size_t)row * D_ + cch * 512 + c.lane * 8) = (f32x4){v[cch * 8], v[cch * 8 + 1], v[cch * 8 + 2], v[cch * 8 + 3]};
                *(f32x4*)(Xout + (size_t)row * D_ + cch * 512 + c.lane * 8 + 4) = (f32x4){v[cch * 8 + 4], v[cch * 8 + 5], v[cch * 8 + 6], v[cch * 8 + 7]}; } }
            const float r = row_rstd(v);
            if (!U2L) row_store_norm_bf16(U + (size_t)row * D_, g, c.lane, v, r);
            else {
#pragma unroll
                for (int cch = 0; cch < 4; ++cch) { const f32x4 ga = *(const f32x4*)(g + cch * 512 + c.lane * 8), gb = *(const f32x4*)(g + cch * 512 + c.lane * 8 + 4); float f[8];
#pragma unroll
                    for (int j = 0; j < 4; ++j) { f[j] = v[cch * 8 + j] * r * ga[j]; f[4 + j] = v[cch * 8 + 4 + j] * r * gb[j]; }
                    *(LAS u32x4*)(c.lds + c.wave * 16640 + r4 * 4160 + cch * 1024 + c.lane * 16) = pack8(f); }
            }
        }
        if (U2L) {
#pragma unroll 4
            for (int it = 0; it < 16; ++it) { const int grp = it * 8 + (c.lane >> 3), r4 = (c.lane >> 1) & 3, hf = c.lane & 1;
                const u32x4 w = *(const LAS u32x4*)(c.lds + c.wave * 16640 + r4 * 4160 + grp * 32 + hf * 16);
                *(u32x4*)(U + ((size_t)grp * T_ + rb * 4 + r4) * 16 + hf * 8) = w; }
        }
    }
}

struct S5aSched {
    static constexpr bool GATHER = false, SEG2 = false, LIST = false, HALFN = true; static constexpr int KSA = 128;
    const char* A; const char* B; const char* A2; const char* B2; int zoff; int nt1, nt2, G, c; int hA, hA2, hB2;
    __device__ __forceinline__ unsigned voffA(int R, int C) const { return (unsigned)(R * 1024 + C * 2); }
    __device__ __forceinline__ unsigned voffB(int R, int C) const { return (unsigned)(R * 1024 + C * 2); }
    __device__ __forceinline__ unsigned voffA2(int, int) const { return 0u; }
    __device__ __forceinline__ unsigned voffB2(int, int) const { return 0u; }
    __device__ __forceinline__ bool next(int i, pg::Unit& u) const {
        const int L = i * G + c; if (L >= 256) return false;
        const int g = L >> 1, pm = L & 1; u.pm = pm; u.pn = 0; u.e = g; u.nvalid = 256;
        u.oA = (unsigned)g * 524288u + (unsigned)pm * 262144u; u.oB = (unsigned)g * 131072u; u.oA2 = 0u; u.oB2 = 0u; u.hB = zoff - (int)u.oB; return true;
    }
    __device__ __forceinline__ unsigned grow(const pg::Unit&, int) const { return 0u; }
    __device__ __forceinline__ void list_issue(const pg::Unit&, LAS unsigned char*, int, int, int) const {}
};
constexpr int LSW = 132;
struct EpiS5Loc {
    float* L; LAS float* LS; int to_lds;
    __device__ __forceinline__ void operator()(const f32x4 (&acc)[2][2][4][2], const pg::Unit& u, int wr, int wc, int fr, int fq) const {
        if (to_lds) {
            asm volatile("s_waitcnt vmcnt(0)" ::: "memory");
            __builtin_amdgcn_s_barrier();
#pragma unroll
            for (int ai = 0; ai < 2; ++ai)
#pragma unroll
                for (int m = 0; m < 4; ++m) { LAS float* rp = LS + (ai * 128 + wr * 64 + m * 16 + fr) * LSW + wc * 32 + 8 * fq;
                    *(LAS f32x4*)rp = acc[ai][0][m][0]; *(LAS f32x4*)(rp + 4) = acc[ai][0][m][1]; }
            return;
        }
#pragma unroll
        for (int ai = 0; ai < 2; ++ai)
#pragma unroll
            for (int m = 0; m < 4; ++m) { const int n = u.pm * 256 + ai * 128 + wr * 64 + m * 16 + fr; float* rp = L + ((size_t)u.e * 512 + n) * 128 + wc * 32 + 8 * fq;
                *(f32x4*)rp = acc[ai][0][m][0]; *(f32x4*)(rp + 4) = acc[ai][0][m][1]; }
    }
};
struct S5cSched {
    static constexpr bool GATHER = false, SEG2 = true, LIST = false, HALFN = false; static constexpr int KSA = 128;
    const char* A; const char* A2; const char* B; const char* B2; int nt1, nt2, G, c; int hA, hA2, hB2; int pnf;
    __device__ __forceinline__ unsigned voffA(int R_, int C) const { return (unsigned)(R_ * 1024 + C * 2); }
    __device__ __forceinline__ unsigned voffA2(int R_, int C) const { return (unsigned)(R_ * 256 + C * 2); }
    __device__ __forceinline__ unsigned voffB(int R_, int C) const { const int pj = perm32(R_ & 31), co = pj & 15, tl = 2 * (R_ >> 5) + (pj >> 4); return (unsigned)(co * 2048 + (31 - tl) * 32 + C * 2); }
    __device__ __forceinline__ unsigned voffB2(int R_, int C) const { return (unsigned)(R_ * 256 + C * 2); }
    __device__ __forceinline__ bool next(int i, pg::Unit& u) const {
        const int L = i * G + c; if (L >= 256) return false;
        const int wgid = (L & 7) * 32 + (L >> 3); const int g = wgid >> 1, pm = wgid & 1, pn = pnf;
        u.pm = pm; u.pn = pn; u.e = g; u.nvalid = 256;
        u.oA = (unsigned)g * 524288u + (unsigned)pm * 262144u; u.oA2 = (unsigned)g * 131072u + (unsigned)pm * 65536u;
        u.oB = (unsigned)(g * 32768 - pn * 512); u.hB = -256; u.oB2 = (unsigned)g * 131072u + (unsigned)pn * 65536u; return true;
    }
    __device__ __forceinline__ unsigned grow(const pg::Unit&, int) const { return 0u; }
    __device__ __forceinline__ void list_issue(const pg::Unit&, LAS unsigned char*, int, int, int) const {}
};
struct EpiS5Out {
    bf16* V; const bf16* U2; const float* dsk;
    __device__ __forceinline__ void operator()(const f32x4 (&acc)[2][2][4][2], const pg::Unit& u, int wr, int wc, int fr, int fq) const {
        const int g = u.e, ch0 = (fq & 1) * 8; float dv[8];
#pragma unroll
        for (int q = 0; q < 8; ++q) dv[q] = dsk[g * 16 + ch0 + q];
#pragma unroll
        for (int ai = 0; ai < 2; ++ai)
#pragma unroll
            for (int m = 0; m < 4; ++m) { const int n = u.pm * 256 + ai * 128 + wr * 64 + m * 16 + fr;
#pragma unroll
                for (int bj = 0; bj < 2; ++bj) { const int t = u.pn * 16 + 8 * bj + 2 * wc + (fq >> 1); const int token = n * 32 + t;
                    float uu[8], o[8]; unpack8(*(const u32x4*)(U2 + ((size_t)g * T_ + token) * 16 + ch0), uu);
#pragma unroll
                    for (int q = 0; q < 8; ++q) o[q] = gelu_tanh(acc[ai][bj][m][q >> 2][q & 3] + dv[q] * uu[q]);
                    *(u32x4*)(V + (((size_t)n * 128 + g) * 32 + t) * 16 + ch0) = pack8(o); } }
    }
};
__device__ __forceinline__ void ph_s5a(const Ctx& c) {
    S5aSched S; S.A = (const char*)WSP(bf16, WS_HB); S.B = (const char*)WSP(bf16, WS_S5WST); S.A2 = S.A; S.B2 = S.B; S.zoff = (int)(WS_S5ZERO - WS_S5WST); S.nt1 = 8; S.nt2 = 0; S.G = c.G; S.c = c.bid; S.hA = 128 * 1024; S.hA2 = 0; S.hB2 = 0;
    EpiS5Loc E{WSP(float, WS_S5LOC), (LAS float*)c.lds, (S5_MERGE && c.G == 256) ? 1 : 0};
    pg::gemm_phase_w(c.lds, S, E, c.wave);
}
__device__ __forceinline__ void ph_s5b(const Ctx& c, bool from_lds) {
    const float* L = WSP(float, WS_S5LOC); bf16* H = WSP(bf16, WS_S5HIN); const float* A32 = WSP(float, WS_S5A32);
    LAS float* LS = (LAS float*)c.lds;
    const int p = c.tid & 63, seg = c.tid >> 6;
    for (int item = c.bid; item < 256; item += c.G) {
        const int g = item >> 1, b = item & 1;
        const size_t base = ((size_t)g * 512 + b * 256) * 128;
        if (!from_lds) {
#pragma unroll
            for (int i = 0; i < 16; ++i) { const int e4 = (i * 512 + c.tid) * 4; const f32x4 v = *(const f32x4*)(L + base + e4); *(LAS f32x4*)(LS + (e4 >> 7) * LSW + (e4 & 127)) = v; }
        }
        const float er = A32[(size_t)(g * 64 + p) * 2], ei = A32[(size_t)(g * 64 + p) * 2 + 1];
        __syncthreads();
        float hr = 0.f, hi = 0.f;
        for (int i = 0; i < 32; ++i) { const int n = seg * 32 + i; const float lr = LS[n * LSW + p], li = LS[n * LSW + 64 + p];
            const float nr = er * hr - ei * hi + lr, ni = er * hi + ei * hr + li; hr = nr; hi = ni; LS[n * LSW + p] = hr; LS[n * LSW + 64 + p] = hi; }
        __syncthreads();
        float pr = er, pi = ei;
#pragma unroll
        for (int q = 0; q < 5; ++q) { const float nr = pr * pr - pi * pi, ni = 2.0f * pr * pi; pr = nr; pi = ni; }
        float cr = 0.f, ci = 0.f;
        for (int sp = 0; sp < seg; ++sp) { const float fr = LS[(sp * 32 + 31) * LSW + p], fi = LS[(sp * 32 + 31) * LSW + 64 + p];
            const float nr = pr * cr - pi * ci + fr, ni = pr * ci + pi * cr + fi; cr = nr; ci = ni; }
        __syncthreads();
        float wr = er, wi = ei;
        for (int i = 0; i < 32; ++i) { const int n = seg * 32 + i;
            const float vr = LS[n * LSW + p] + (wr * cr - wi * ci), vi = LS[n * LSW + 64 + p] + (wr * ci + wi * cr);
            LAS bf16* hb = (LAS bf16*)(LS + n * LSW); hb[p] = f2bf(vr); hb[64 + p] = f2bf(vi);
            const float nr = wr * er - wi * ei, ni = wr * ei + wi * er; wr = nr; wi = ni; }
        __syncthreads();
        bf16* hp = H + base;
#pragma unroll
        for (int ps = 0; ps < 8; ++ps) { const int row = ps * 32 + (c.tid >> 4), piece = c.tid & 15;
            if (row < 255) *(u32x4*)(hp + (size_t)(row + 1) * 128 + piece * 8) = *(const LAS u32x4*)((const LAS unsigned char*)(LS + row * LSW) + piece * 16); }
        if (c.tid < 16) *(u32x4*)(hp + c.tid * 8) = (u32x4){0u, 0u, 0u, 0u};
        __syncthreads();
    }
}
__device__ __forceinline__ void ph_s5c(const Ctx& c) {
    S5cSched S; S.A = (const char*)WSP(bf16, WS_HB); S.A2 = (const char*)WSP(bf16, WS_S5HIN); S.B = (const char*)WSP(bf16, WS_S5R); S.B2 = (const char*)WSP(bf16, WS_S5WC);
    S.nt1 = 8; S.nt2 = 2; S.G = c.G; S.c = c.bid; S.hA = 128 * 1024; S.hA2 = 128 * 256; S.hB2 = 128 * 256;
    EpiS5Out E{WSP(bf16, WS_YCAT), WSP(bf16, WS_HB), c.in[16]};
#pragma unroll 1
    for (int hp = 0; hp < 2; ++hp) { S.pnf = hp; S.nt1 = 4 + 4 * hp; pg::gemm_phase_w(c.lds, S, E, c.wave); }
}

__device__ __forceinline__ void s5_load_u(LAS float* ut, const bf16* __restrict__ U, int tbase, int g, int lane) {
    const bf16* p = U + (size_t)(tbase + lane) * D_ + g * 16; float f0[8], f1[8]; unpack8(*(const u32x4*)p, f0); unpack8(*(const u32x4*)(p + 8), f1);
    LAS float* q = ut + lane * 16;
#pragma unroll
    for (int j = 0; j < 8; ++j) { q[j] = f0[j]; q[8 + j] = f1[j]; }
}
template <int MODE>
__device__ __forceinline__ void ph_s5_chunks(const Ctx& c) {
    const bf16* U = WSP(bf16, WS_HB); bf16* V = WSP(bf16, WS_YCAT); float* LOC = WSP(float, WS_S5L);
    const float* A4 = WSP(float, WS_S5A); const float* BB = WSP(float, WS_S5B);
    LAS float* CR = (LAS float*)c.lds;
    LAS float* CI = CR + 16 * 65;
    LAS float* UT = CI + 16 * 65 + c.wave * 1024;
    LAS float* HR = (LAS float*)c.lds + 2 * 16 * 65 + 8 * 1024 + c.wave * (2 * 16 * 65);
    LAS float* HI = HR + 16 * 65;
    const int p = c.lane;
    for (int item = c.bid; item < 256; item += c.G) {
        const int g = item >> 1, b = item & 1;
        __syncthreads();
        if (MODE == 1) { for (int i = c.tid; i < 1024; i += 512) { const int co = i >> 6, pp = i & 63; CR[co * 65 + pp] = c.in[14][(size_t)g * 1024 + i]; CI[co * 65 + pp] = c.in[15][(size_t)g * 1024 + i]; } }
        __syncthreads();
        const float ar = A4[(size_t)(g * 64 + p) * 4], ai = A4[(size_t)(g * 64 + p) * 4 + 1];
        float br[16], bi[16];
#pragma unroll
        for (int j = 0; j < 16; ++j) { br[j] = BB[(size_t)(g * 64 + p) * 32 + j]; bi[j] = BB[(size_t)(g * 64 + p) * 32 + 16 + j]; }
        for (int chunk = c.wave; chunk < NCH; chunk += NWAVE) {
            const int tbase = b * SEQ + chunk * 64;
            s5_load_u(UT, U, tbase, g, c.lane);
            float hr = 0.f, hi = 0.f;
            const size_t li = ((size_t)((b * NCH + chunk) * 128 + g) * 64 + p) * 2;
            if (MODE == 1) { hr = LOC[li]; hi = LOC[li + 1]; }
            for (int sub = 0; sub < 4; ++sub) {
#pragma unroll 4
                for (int tt = 0; tt < 16; ++tt) {
                    const LAS float* up = UT + (sub * 16 + tt) * 16; float xr = 0.f, xi = 0.f;
#pragma unroll
                    for (int q4 = 0; q4 < 4; ++q4) { const f32x4 u4 = *(const LAS f32x4*)(up + q4 * 4);
#pragma unroll
                        for (int j = 0; j < 4; ++j) { xr += br[q4 * 4 + j] * u4[j]; xi += bi[q4 * 4 + j] * u4[j]; } }
                    const float nr = ar * hr - ai * hi + xr, ni = ar * hi + ai * hr + xi; hr = nr; hi = ni;
                    if (MODE == 1) { HR[tt * 65 + p] = hr; HI[tt * 65 + p] = hi; }
                }
                if (MODE == 1) {
                    const int tl = c.lane & 15, cq = c.lane >> 4; float y[4] = {0.f, 0.f, 0.f, 0.f};
                    for (int pp = 0; pp < 64; ++pp) { const float h_r = HR[tl * 65 + pp], h_i = HI[tl * 65 + pp];
#pragma unroll
                        for (int j = 0; j < 4; ++j) y[j] += CR[(cq * 4 + j) * 65 + pp] * h_r - CI[(cq * 4 + j) * 65 + pp] * h_i; }
                    const int t = tbase + sub * 16 + tl; const LAS float* up = UT + (sub * 16 + tl) * 16 + cq * 4;
                    float o[4];
#pragma unroll
                    for (int j = 0; j < 4; ++j) o[j] = gelu_tanh(y[j] + c.in[16][g * 16 + cq * 4 + j] * up[j]);
                    u32x2 w; w.x = pk2(o[0], o[1]); w.y = pk2(o[2], o[3]);
                    *(u32x2*)(V + (size_t)t * D_ + g * 16 + cq * 4) = w;
                }
            }
            if (MODE == 0) { LOC[li] = hr; LOC[li + 1] = hi; }
        }
    }
}
__device__ __forceinline__ void ph_s5_scan(const Ctx& c) {
    float* LOC = WSP(float, WS_S5L); const float* A4 = WSP(float, WS_S5A);
    const int gtid = c.bid * NTHR + c.tid, gn = c.G * NTHR;
    for (int i = gtid; i < 2 * 128 * 64; i += gn) {
        const int b = i >> 13, gp = i & 8191;
        const float er = A4[(size_t)gp * 4 + 2], ei = A4[(size_t)gp * 4 + 3];
        float hr = 0.f, hi = 0.f;
        for (int ch = 0; ch < NCH; ++ch) { const size_t li = ((size_t)(b * NCH + ch) * 8192 + gp) * 2; const float lr = LOC[li], lim = LOC[li + 1]; LOC[li] = hr; LOC[li + 1] = hi;
            const float nr = er * hr - ei * hi + lr, ni = er * hi + ei * hr + lim; hr = nr; hi = ni; }
    }
}

struct EpiGlu {
    const float* R; float* O; bf16* HBo; const float* g; const bf16* Ys;
    __device__ __forceinline__ void operator()(const f32x4 (&acc)[2][2][4][2], const pg::Unit& u, int wr, int wc, int fr, int fq) const {
        const int colb = u.pn * 128 + wc * 32 + 8 * fq;
        const f32x4 g0 = *(const f32x4*)(g + colb), g1 = *(const f32x4*)(g + colb + 4);
#pragma unroll
        for (int ai = 0; ai < 2; ++ai) {
            f32x4 rv[4][2]; u32x4 ya[4], yb[4];
#pragma unroll
            for (int m = 0; m < 4; ++m) { const size_t row = (size_t)(u.pm * 256 + ai * 128 + wr * 64 + m * 16 + fr);
#pragma unroll
                for (int n = 0; n < 2; ++n) rv[m][n] = *(const f32x4*)(R + row * D_ + colb + n * 4);
                if (Ys) { ya[m] = *(const u32x4*)(Ys + (2 * row) * D_ + colb); yb[m] = *(const u32x4*)(Ys + (2 * row + 1) * D_ + colb); } }
            asm volatile("" ::: "memory");
#pragma unroll
            for (int m = 0; m < 4; ++m) { const size_t off = (size_t)(u.pm * 256 + ai * 128 + wr * 64 + m * 16 + fr) * D_ + colb; f32x4 o[2];
                if (Ys) { float fa[8], fb[8]; unpack8(ya[m], fa); unpack8(yb[m], fb);
#pragma unroll
                    for (int j = 0; j < 4; ++j) { rv[m][0][j] += fa[j] + fb[j]; rv[m][1][j] += fa[4 + j] + fb[4 + j]; } }
#pragma unroll
                for (int n = 0; n < 2; ++n) {
#pragma unroll
                    for (int j = 0; j < 4; ++j) o[n][j] = rv[m][n][j] + acc[ai][0][m][n][j] * sigmoidf_(acc[ai][1][m][n][j]);
                    *(f32x4*)(O + off + n * 4) = o[n]; }
                u32x4 w; w.x = pk2(o[0][0] * g0[0], o[0][1] * g0[1]); w.y = pk2(o[0][2] * g0[2], o[0][3] * g0[3]); w.z = pk2(o[1][0] * g1[0], o[1][1] * g1[1]); w.w = pk2(o[1][2] * g1[2], o[1][3] * g1[3]);
                *(u32x4*)(HBo + off) = w; }
            asm volatile("" ::: "memory");
        }
    }
};
struct GluSched : pg::DenseSched {
    static constexpr int KSA = 4096;
    __device__ __forceinline__ unsigned voffA(int R, int C) const { return (unsigned)((R >> 5) * 131072 + (C >> 4) * 1024 + (R & 31) * 32 + (C & 15) * 2); }
};
__device__ __forceinline__ void ph_glu(const Ctx& c) {
    if (NAIVE_GEMM & 16) {
        const bf16* A = WSP(bf16, WS_YCAT); const float* X = WSP(float, WS_XB); float* O = WSP(float, WS_XA); bf16* HBn = WSP(bf16, WS_HB); const float* gn = c.in[2] + 2048;
        naive_gemm<true>(c, T_, 2048, 2048, [=](int r) { return A + (size_t)r * 2048; }, c.in[17], c.in[17] + 2048, 4096, [=](int r, int col, float a, float b) { const float o = X[(size_t)r * 2048 + col] + a * sigmoidf_(b); O[(size_t)r * 2048 + col] = o; HBn[(size_t)r * 2048 + col] = f2bf(o * gn[col]); });
    } else {
        GluSched S; S.init(WSP(bf16, WS_YCAT), WSP(bf16, WS_WGLU), T_, 4096, 2048, c.G, c.bid);
        EpiGlu E{SKIP_X2 ? WSP(float, WS_XA) : WSP(float, WS_XB), WSP(float, WS_XA), WSP(bf16, WS_HB), c.in[2] + 2048, SKIP_X2 ? WSP(bf16, WS_KV) : (const bf16*)nullptr};
        if (CONV_IN_GEMM) {
            const int slot = (c.bid >> 3) % 4; S.i1 = slot + 1; pg::gemm_phase_w(c.lds, S, E, c.wave);
            conv_slice(c, CVO_GU + CV_GU / 2 + CV_GU1_SPLIT * 256, CV_GU / 2 - CV_GU1_SPLIT * 256, 0, 0, 0, 0);
            S.i0 = slot + 1; S.i1 = 1 << 20; pg::gemm_phase_w(c.lds, S, E, c.wave); }
        else pg::gemm_phase_w(c.lds, S, E, c.wave);
    }
}

__device__ __forceinline__ void ph_final(const Ctx& c) {
    const bf16* Ys = WSP(bf16, WS_KV); const float* X = WSP(float, WS_XA); const float* g = c.in[3];
    const int gw = c.bid * NWAVE + c.wave, nw = c.G * NWAVE;
    for (int row = gw; row < T_; row += nw) {
        float v[32]; row_load32(X + (size_t)row * D_, c.lane, v);
        row_add_bf16(Ys + (size_t)(2 * row) * D_, c.lane, v); row_add_bf16(Ys + (size_t)(2 * row + 1) * D_, c.lane, v);
        const float r = row_rstd(v);
#pragma unroll
        for (int cch = 0; cch < 4; ++cch) { const f32x4 ga = *(const f32x4*)(g + cch * 512 + c.lane * 8), gb = *(const f32x4*)(g + cch * 512 + c.lane * 8 + 4);
            *(f32x4*)(c.out + (size_t)row * D_ + cch * 512 + c.lane * 8) = (f32x4){v[cch * 8] * r * ga[0], v[cch * 8 + 1] * r * ga[1], v[cch * 8 + 2] * r * ga[2], v[cch * 8 + 3] * r * ga[3]};
            *(f32x4*)(c.out + (size_t)row * D_ + cch * 512 + c.lane * 8 + 4) = (f32x4){v[cch * 8 + 4] * r * gb[0], v[cch * 8 + 5] * r * gb[1], v[cch * 8 + 6] * r * gb[2], v[cch * 8 + 7] * r * gb[3]}; }
    }
}

constexpr int NPHASE = 18;
__global__ void __launch_bounds__(NTHR, 2) mk_fwd(Args args) {
    extern __shared__ __attribute__((aligned(16))) unsigned char lds_raw[];
    Ctx c;
#pragma unroll
    for (int i = 0; i < 25; ++i) c.in[i] = args.in[i];
    c.out = args.out; c.ws = args.ws; c.lds = (LAS unsigned char*)lds_raw;
    c.wave = __builtin_amdgcn_readfirstlane((int)threadIdx.x >> 6); c.lane = lane_id(); c.tid = c.wave * 64 + c.lane;     c.G = gridDim.x; c.bid = blockIdx.x;
    const int lo = args.ph_lo, hi = args.ph_hi;
    volatile LAS unsigned* st = (volatile LAS unsigned*)(c.lds + MISC_OFF);
    if (c.tid < 4) st[c.tid] = 0u;
    __syncthreads();
    XcdBarrier bar; bar.bar = WSP(unsigned, WS_CTL) + CW_BAR; bar.x = 0; bar.st = st;
    if (hi - lo > 1) bar = xcd_barrier_post(WSP(unsigned, WS_CTL) + CW_BAR, st, c.tid == 0);
#define IN(k) (lo <= (k) && (k) < hi)
#define SEAM(k) do { c.lane = lane_id(); c.tid = c.wave * 64 + c.lane; if (IN(k) && IN((k) + 1)) { xcd_barrier(bar, c.tid == 0); if (PROBE_DUP & (1 << 30)) xcd_barrier(bar, c.tid == 0); } } while (0)
    if (IN(0)) { ph_prologue(c); if (PROBE_DUP & (1 << 0)) { __syncthreads(); ph_prologue(c); } }
    SEAM(0);
    if (IN(1)) { ph_inproj(c); if (PROBE_DUP & (1 << 1)) { __syncthreads(); ph_inproj(c); } }
    SEAM(1);
    if (IN(2)) { ph_conv_hglocal(c); if (HG_MFMA) ph_hgL(c); if (PROBE_DUP & (1 << 2)) { __syncthreads(); ph_conv_hglocal(c); if (HG_MFMA) ph_hgL(c); } }
    SEAM(2);
    if (IN(3)) { if (HG_MFMA) ph_hgS(c); else ph_hgscan(c); if (PROBE_DUP & (1 << 3)) { __syncthreads(); if (HG_MFMA) ph_hgS(c); else ph_hgscan(c); } }
    SEAM(3);
    if (IN(4)) { if (HG_MFMA) ph_hgO(c); else ph_hgout(c); if (PROBE_DUP & (1 << 4)) { __syncthreads(); if (HG_MFMA) ph_hgO(c); else ph_hgout(c); } }
    SEAM(4);
    if (IN(5)) { ph_outproj(c); if (PROBE_DUP & (1 << 5)) { __syncthreads(); ph_outproj(c); } }
    SEAM(5);
    if (IN(6)) { ph_router<0>(c, WSP(float, WS_XA)); if (PROBE_DUP & (1 << 6)) { __syncthreads(); ph_router<0, true>(c, WSP(float, WS_XA)); } }
    SEAM(6);
    if (IN(7)) { ph_moe_gu<0>(c); if (PROBE_DUP & (1 << 7)) { __syncthreads(); ph_moe_gu<0>(c); } }
    SEAM(7);
    if (IN(8)) { ph_moe_down<0>(c); if (PROBE_DUP & (1 << 8)) { __syncthreads(); ph_moe_down<0>(c); } }
    SEAM(8);
    if (IN(9)) { ph_res_norm<S5_MFMA != 0>(c, WSP(float, WS_XA), (SKIP_X2 && !(NAIVE_GEMM & 16)) ? (float*)nullptr : WSP(float, WS_XB), c.in[1] + 2048, WSP(bf16, WS_HB)); if (PROBE_DUP & (1 << 9)) { __syncthreads(); ph_res_norm<S5_MFMA != 0>(c, WSP(float, WS_XA), (SKIP_X2 && !(NAIVE_GEMM & 16)) ? (float*)nullptr : WSP(float, WS_XB), c.in[1] + 2048, WSP(bf16, WS_HB)); } }
    SEAM(9);
    if (IN(10)) { if (S5_MFMA) { ph_s5a(c); if (S5_MERGE && c.G == 256) { asm volatile("s_waitcnt vmcnt(0)" ::: "memory"); __syncthreads(); ph_s5b(c, true); } } else ph_s5_chunks<0>(c); if (PROBE_DUP & (1 << 10)) { __syncthreads(); if (S5_MFMA) ph_s5a(c); else ph_s5_chunks<0>(c); } }
    if (!(S5_MFMA && S5_MERGE && c.G == 256)) SEAM(10);
    if (IN(11)) { if (S5_MFMA) { if (!(S5_MERGE && c.G == 256)) ph_s5b(c, false); } else ph_s5_scan(c); if (PROBE_DUP & (1 << 11)) { __syncthreads(); if (S5_MFMA) ph_s5b(c, false); else ph_s5_scan(c); } }
    SEAM(11);
    if (IN(12)) { if (S5_MFMA) ph_s5c(c); else ph_s5_chunks<1>(c); if (PROBE_DUP & (1 << 12)) { __syncthreads(); if (S5_MFMA) ph_s5c(c); else ph_s5_chunks<1>(c); } }
    SEAM(12);
    if (IN(13)) { ph_glu(c); if (PROBE_DUP & (1 << 13)) { __syncthreads(); ph_glu(c); } }
    SEAM(13);
    if (IN(14)) { ph_router<1>(c, WSP(float, WS_XA)); if (PROBE_DUP & (1 << 14)) { __syncthreads(); ph_router<1, true>(c, WSP(float, WS_XA)); } }
    SEAM(14);
    if (IN(15)) { ph_moe_gu<1>(c); if (PROBE_DUP & (1 << 15)) { __syncthreads(); ph_moe_gu<1>(c); } }
    SEAM(15);
    if (IN(16)) { ph_moe_down<1>(c); if (PROBE_DUP & (1 << 16)) { __syncthreads(); ph_moe_down<1>(c); } }
    SEAM(16);
    if (IN(17)) { ph_final(c); if (PROBE_DUP & (1 << 17)) { __syncthreads(); ph_final(c); } }
#undef IN
#undef SEAM
}

extern "C" void kernel_launch(void* const* d_in, const int* in_sizes, int n_in, void* d_out, int out_size, void* d_ws, size_t ws_size, hipStream_t stream) {
    static int grid = 0;
    if (grid == 0) {
        if (n_in != 25 || out_size != T_ * D_ || ws_size < WS_END) { fprintf(stderr, "kernel_launch: unexpected shapes (n_in %d out %d ws %zu)\n", n_in, out_size, ws_size); grid = -1; return; }
        int dev = 0, cus = 0, per_cu = 0;
        if (hipGetDevice(&dev) != hipSuccess || hipDeviceGetAttribute(&cus, hipDeviceAttributeMultiprocessorCount, dev) != hipSuccess) { grid = -1; return; }
        if (hipFuncSetAttribute((const void*)mk_fwd, hipFuncAttributeMaxDynamicSharedMemorySize, LDS_BYTES) != hipSuccess) { fprintf(stderr, "kernel_launch: hipFuncSetAttribute failed\n"); grid = -1; return; }
        if (hipOccupancyMaxActiveBlocksPerMultiprocessor(&per_cu, (const void*)mk_fwd, NTHR, LDS_BYTES) != hipSuccess || per_cu < 1) fprintf(stderr, "kernel_launch: occupancy query says %d\n", per_cu);
        (void)hipGetLastError();
        grid = cus;
    }
    if (grid < 0) return;
    (void)hipMemsetAsync((char*)d_ws + WS_CTL, 0, CTL_BYTES, stream);
    Args a{};
    for (int i = 0; i < 25; ++i) a.in[i] = (const float*)d_in[i];
    a.out = (float*)d_out; a.ws = (unsigned char*)d_ws;
#if N_LAUNCH_MODE == 1
    a.ph_lo = 0; a.ph_hi = NPHASE;
    hipLaunchKernelGGL(mk_fwd, dim3(grid), dim3(NTHR), LDS_BYTES, stream, a);
#else
    for (int p = 0; p < NPHASE; ++p) { a.ph_lo = p; a.ph_hi = p + 1; hipLaunchKernelGGL(mk_fwd, dim3(grid), dim3(NTHR), LDS_BYTES, stream, a); }
#endif
}
```
